# Optimizing an MI355X kernel written in HIP

```python
import jax, jax.numpy as jnp
from jax import lax
import numpy as np

D_MODEL = 1024
BATCH = 4
SEQ = 8192
DEPTH = 2

PLE_DIM = 256
D_MIX = D_MODEL
MLA_HEADS = 8
MLA_NOPE = 64
MLA_ROPE = 32
MLA_V = 64
Q_LORA = 256
KV_LORA = 128
DIL_HEADS = 8
DIL_HEAD_DIM = 64
DIL_CONFIGS = ((128, 1), (512, 4), (2048, 16))
D_FF = 2816
MACARON = 0.5
ROPE_THETA = 10000.0
EPS = 1e-6
Q_BLOCK = 128
NEG = -1e30
N_NORMS = 8

MLA_WIDTH = MLA_HEADS * MLA_V
DIL_WIDTH = DIL_HEADS * DIL_HEAD_DIM
N_IN = Q_LORA + KV_LORA + MLA_ROPE + 3 * DIL_WIDTH

kernel_name = "hybrid_mla_dilated_macaron_block"


def rmsnorm(x, g):
    xf = x.astype(jnp.float32)
    y = xf * lax.rsqrt(jnp.mean(xf * xf, axis=-1, keepdims=True) + EPS)
    return (y * g.astype(jnp.float32)).astype(x.dtype)


def rope_tables(positions, dim, dtype):
    inv = ROPE_THETA ** (-jnp.arange(0, dim, 2, dtype=jnp.float32) / dim)
    ang = positions.astype(jnp.float32)[..., None] * inv
    return jnp.cos(ang)[:, :, None, :].astype(dtype), jnp.sin(ang)[:, :, None, :].astype(dtype)


def apply_rope(x, cos, sin):
    x1, x2 = jnp.split(x, 2, axis=-1)
    return jnp.concatenate([x1 * cos - x2 * sin, x2 * cos + x1 * sin], axis=-1)


def swiglu(x, w_gate, w_up, w_down):
    return (jax.nn.silu(x @ w_gate) * (x @ w_up)) @ w_down


def mla_attention(q_nope, q_rope, k_nope, k_rope, v):
    B, S, H, _ = q_nope.shape
    nb = S // Q_BLOCK
    scale = (MLA_NOPE + MLA_ROPE) ** -0.5
    key_pos = jnp.arange(S)

    def block(n):
        start = n * Q_BLOCK
        qn = lax.dynamic_slice_in_dim(q_nope, start, Q_BLOCK, axis=1)
        qr = lax.dynamic_slice_in_dim(q_rope, start, Q_BLOCK, axis=1)
        s = (jnp.einsum('bqhd,bkhd->bhqk', qn, k_nope)
             + jnp.einsum('bqhd,bkd->bhqk', qr, k_rope)).astype(jnp.float32) * scale
        q_pos = start + jnp.arange(Q_BLOCK)
        causal = key_pos[None, :] <= q_pos[:, None]
        s = jnp.where(causal[None, None], s, NEG)
        w = jax.nn.softmax(s, axis=-1).astype(v.dtype)
        return jnp.einsum('bhqk,bkhd->bqhd', w, v)

    out = lax.map(block, jnp.arange(nb))
    return out.transpose(1, 0, 2, 3, 4).reshape(B, S, H * v.shape[-1])


def dilated_branch(q, k, v, window, dilation):
    B, S, H, dh = q.shape
    L = S // dilation
    w_sub = window // dilation
    nb = -(-L // Q_BLOCK)
    Lp = nb * Q_BLOCK

    def to_sub(t):
        t = t.reshape(B, L, dilation, H, dh).transpose(0, 2, 1, 3, 4).reshape(B * dilation, L, H, dh)
        t = jnp.pad(t, ((0, 0), (0, Lp - L), (0, 0), (0, 0)))
        return t.reshape(B * dilation, nb, Q_BLOCK, H, dh)

    def with_prev(t):
        prev = jnp.pad(t, ((0, 0), (1, 0), (0, 0), (0, 0), (0, 0)))[:, :-1]
        return jnp.concatenate([prev, t], axis=2)

    qs, ks, vs = to_sub(q), to_sub(k), to_sub(v)
    kk, vv = with_prev(ks), with_prev(vs)
    s = jnp.einsum('gnqhd,gnkhd->gnhqk', qs, kk).astype(jnp.float32) * (dh ** -0.5)
    qi = jnp.arange(Q_BLOCK)[:, None]
    ki = jnp.arange(2 * Q_BLOCK)[None, :]
    dist = qi + Q_BLOCK - ki
    key_sub = jnp.arange(nb)[:, None, None] * Q_BLOCK + ki[None] - Q_BLOCK
    valid = (dist >= 0)[None] & (dist <= w_sub)[None] & (key_sub >= 0)
    s = jnp.where(valid[None, :, None], s, NEG)
    m = jnp.max(s, axis=-1, keepdims=True)
    e = jnp.exp(s - m)
    den = jnp.sum(e, axis=-1, keepdims=True)
    lse = (m + jnp.log(den))[..., 0]
    o = jnp.einsum('gnhqk,gnkhd->gnqhd', (e / den).astype(v.dtype), vv)
    o = (o.reshape(B * dilation, Lp, H, dh)[:, :L]
         .reshape(B, dilation, L, H, dh).transpose(0, 2, 1, 3, 4).reshape(B, S, H, dh))
    lse = (lse.transpose(0, 1, 3, 2).reshape(B * dilation, Lp, H)[:, :L]
           .reshape(B, dilation, L, H).transpose(0, 2, 1, 3).reshape(B, S, H))
    return o, lse


def dilated_attention(q, k, v):
    outs, lses = [], []
    for window, dilation in DIL_CONFIGS:
        o, l = dilated_branch(q, k, v, window, dilation)
        outs.append(o)
        lses.append(l)
    wts = jax.nn.softmax(jnp.stack(lses, axis=0), axis=0).astype(q.dtype)
    return jnp.einsum('kbsh,kbshd->bshd', wts, jnp.stack(outs, axis=0))


def hybrid_mixer(h, cos_m, sin_m, cos_d, sin_d, w_in, q_norm, w_q_up, kv_norm, w_kv_up, grp_gain, w_out):
    B, S, _ = h.shape
    z = h @ w_in
    c0 = Q_LORA
    c1 = c0 + KV_LORA
    c2 = c1 + MLA_ROPE
    q_lat, kv_lat, k_rope, qkv_d = jnp.split(z, [c0, c1, c2], axis=-1)
    q = (rmsnorm(q_lat, q_norm) @ w_q_up).reshape(B, S, MLA_HEADS, MLA_NOPE + MLA_ROPE)
    q_nope = q[..., :MLA_NOPE]
    q_rope = apply_rope(q[..., MLA_NOPE:], cos_m, sin_m)
    kv = (rmsnorm(kv_lat, kv_norm) @ w_kv_up).reshape(B, S, MLA_HEADS, MLA_NOPE + MLA_V)
    k_nope, v_mla = kv[..., :MLA_NOPE], kv[..., MLA_NOPE:]
    k_rope = apply_rope(k_rope[:, :, None, :], cos_m, sin_m)[:, :, 0]
    o_mla = mla_attention(q_nope, q_rope, k_nope, k_rope, v_mla)
    qd, kd, vd = [t.reshape(B, S, DIL_HEADS, DIL_HEAD_DIM) for t in jnp.split(qkv_d, 3, axis=-1)]
    qd = apply_rope(qd, cos_d, sin_d)
    kd = apply_rope(kd, cos_d, sin_d)
    o_dil = dilated_attention(qd, kd, vd).reshape(B, S, DIL_WIDTH)
    merged = jnp.concatenate([rmsnorm(o_mla, grp_gain[:MLA_WIDTH]),
                              rmsnorm(o_dil, grp_gain[MLA_WIDTH:])], axis=-1)
    return merged @ w_out


def setup_inputs(seed: int = 0) -> dict:
    key = jax.random.key(seed)
    ks = jax.random.split(key, 16)
    f32 = jnp.float32

    def w(k, shape, fan_in):
        return jax.random.normal(k, shape, f32) * (fan_in ** -0.5)

    def gain(k, shape):
        return 1.0 + 0.02 * jax.random.normal(k, shape, f32)

    return {
        "x": jax.random.normal(ks[0], (BATCH, SEQ, D_MODEL), f32),
        "p": jax.random.normal(ks[1], (DEPTH, BATCH, SEQ, PLE_DIM), f32),
        "positions": jnp.broadcast_to(jnp.arange(SEQ, dtype=jnp.int32), (BATCH, SEQ)),
        "norm_gains": gain(ks[2], (DEPTH, N_NORMS, D_MODEL)),
        "w_in": w(ks[3], (DEPTH, D_MODEL, N_IN), D_MODEL),
        "q_norm": gain(ks[4], (DEPTH, Q_LORA)),
        "w_q_up": w(ks[5], (DEPTH, Q_LORA, MLA_HEADS * (MLA_NOPE + MLA_ROPE)), Q_LORA),
        "kv_norm": gain(ks[6], (DEPTH, KV_LORA)),
        "w_kv_up": w(ks[7], (DEPTH, KV_LORA, MLA_HEADS * (MLA_NOPE + MLA_V)), KV_LORA),
        "group_out_norm": gain(ks[8], (DEPTH, D_MIX)),
        "w_out": w(ks[9], (DEPTH, D_MIX, D_MODEL), D_MIX),
        "ffn_gate": w(ks[10], (DEPTH, 2, D_MODEL, D_FF), D_MODEL),
        "ffn_up": w(ks[11], (DEPTH, 2, D_MODEL, D_FF), D_MODEL),
        "ffn_down": w(ks[12], (DEPTH, 2, D_FF, D_MODEL), D_FF),
        "w_ple": w(ks[13], (DEPTH, PLE_DIM, D_MODEL), PLE_DIM),
        "w_ple_gate": w(ks[14], (DEPTH, D_MODEL, D_MODEL), D_MODEL),
    }


def reference(x, p, positions, norm_gains, w_in, q_norm, w_q_up, kv_norm, w_kv_up,
              group_out_norm, w_out, ffn_gate, ffn_up, ffn_down, w_ple, w_ple_gate):
    cos_m, sin_m = rope_tables(positions, MLA_ROPE, x.dtype)
    cos_d, sin_d = rope_tables(positions, DIL_HEAD_DIM, x.dtype)
    h = x
    for i in range(DEPTH):
        g = norm_gains[i]
        f = swiglu(rmsnorm(h, g[0]), ffn_gate[i, 0], ffn_up[i, 0], ffn_down[i, 0])
        h = h + MACARON * rmsnorm(f, g[1])
        mix = hybrid_mixer(rmsnorm(h, g[2]), cos_m, sin_m, cos_d, sin_d, w_in[i], q_norm[i],
                           w_q_up[i], kv_norm[i], w_kv_up[i], group_out_norm[i], w_out[i])
        h = h + rmsnorm(mix, g[3])
        f = swiglu(rmsnorm(h, g[4]), ffn_gate[i, 1], ffn_up[i, 1], ffn_down[i, 1])
        h = h + MACARON * rmsnorm(f, g[5])
        gate = jax.nn.sigmoid(rmsnorm(h, g[6]) @ w_ple_gate[i])
        h = h + rmsnorm((p[i].astype(h.dtype) @ w_ple[i]) * gate, g[7])
    return h
```

```cpp
#include <hip/hip_runtime.h>
#include <hip/hip_cooperative_groups.h>
#include <cstdio>
#include <cstdint>
#include <cmath>
namespace cg = cooperative_groups;
namespace pg8 {
#define PG8_LAS __attribute__((address_space(3)))
typedef unsigned short bf16_t;
typedef short bf16x8 __attribute__((ext_vector_type(8)));
typedef float f32x4 __attribute__((ext_vector_type(4)));
typedef unsigned u32x4 __attribute__((ext_vector_type(4)));
constexpr int BM = 256, BK = 64, HALF = 128, HTB = HALF * BK * 2  , STAGE_BYTES = 8 * HTB, NXCD = 8, WGM = 8;

__host__ __device__ __forceinline__ int lds_byte(int r, int c) { const int st = (r >> 4) * 2 + (c >> 5), rr = r & 15, cc = c & 31, ob = rr * 64 + cc * 2; return st * 1024 + (ob ^ (((ob >> 9) & 1) << 5)); }
__host__ __device__ __forceinline__ void stage_rc(int b, int& R, int& C) { const int st = b / 1024, sb = b % 1024, swz = sb ^ (((sb >> 9) & 1) << 5); R = (st >> 1) * 16 + swz / 64; C = (st & 1) * 32 + (swz % 64) / 2; }
__host__ __device__ __forceinline__ int perm32(int rho) { const int n = rho >> 4, i = rho & 15; return 8 * (i >> 2) + 4 * n + (i & 3); }

struct Unit { int pm, pn; };
struct Gemm { const bf16_t* A; const bf16_t* Bt; int M, N, K; };

struct StaticOrder {
    int nM, nN, nwg, G, c;
    __host__ __device__ void init(int M, int N, int G_, int c_) { nM = M / BM; nN = N / BM; nwg = nM * nN; G = G_; c = c_; }
    __host__ __device__ bool next(int i, Unit& u) const {
        const long L = (long)i * G + c; if (L >= nwg) return false;
        int wgid = (int)L; { const int q = nwg / NXCD, r = nwg % NXCD, xcd = wgid % NXCD, off = wgid / NXCD; wgid = (xcd < r ? xcd * (q + 1) : r * (q + 1) + (xcd - r) * q) + off; }
        const int nig = WGM * nN, gid = wgid / nig, fm = gid * WGM, gsz = (nM - fm) < WGM ? (nM - fm) : WGM;
        u.pm = fm + ((wgid % nig) % gsz); u.pn = (wgid % nig) / gsz; return true;
    }
    __device__ __forceinline__ void a_ready(const Unit&) const {}
    __device__ __forceinline__ void done(const Unit&) const {}
};

__device__ __forceinline__ unsigned cvt_pk_bf16(float lo, float hi) { unsigned r; asm volatile("v_cvt_pk_bf16_f32 %0, %1, %2" : "=v"(r) : "v"(lo), "v"(hi)); return r; }
typedef float f32x2 __attribute__((ext_vector_type(2)));
__device__ __forceinline__ f32x2 gelu_pk(f32x2 v) {
    const f32x2 av = __builtin_elementwise_abs(v), d = av * 0.2316418882f + 1.0f;
    f32x2 t; t.x = __builtin_amdgcn_rcpf(d.x); t.y = __builtin_amdgcn_rcpf(d.y);
    f32x2 q = t * 0.5307027145f + (-0.7265760135f); q = q * t + 0.7107068705f; q = q * t + (-0.142248368f); q = q * t + 0.127414796f; q = q * t;
    const f32x2 s = (v * v) * (-0.72134752044f);
    f32x2 e; e.x = __builtin_amdgcn_exp2f(s.x); e.y = __builtin_amdgcn_exp2f(s.y);
    const f32x2 m = v * (q * e), r = v - m;
    f32x2 o; o.x = v.x < 0.f ? m.x : r.x; o.y = v.y < 0.f ? m.y : r.y; return o;
}

template <int ACT  > struct EpiBf16 {
    static constexpr bool PERM = true, AFTER_DRAIN = false; static_assert(ACT == 0 || ACT == 1, "EpiBf16: ACT is 0 (none) or 1 (gelu_pk)");
    bf16_t* O; int ldc; const float* bias; int split_cols; size_t split_stride; float scale0;
    __device__ __forceinline__ void operator()(const f32x4 (&acc)[2][2][4][2], const Unit& u, int wr, int wc, int fr, int fq) const {
        const int row0 = u.pm * BM + wr * 64 + fr; int colt = u.pn * BM; bf16_t* base = O;
        float sc = 1.f; if (split_cols) { const int t = colt / split_cols; base += (size_t)t * split_stride; colt -= t * split_cols; if (t == 0) sc = scale0; }
        const int col0 = colt + wc * 32 + 8 * fq, bcol0 = u.pn * BM + wc * 32 + 8 * fq;
        f32x4 bv[2][2];
#pragma unroll
        for (int bj = 0; bj < 2; ++bj)
#pragma unroll
            for (int n = 0; n < 2; ++n) bv[bj][n] = bias ? *(const f32x4*)(bias + bcol0 + bj * HALF + 4 * n) : (f32x4){0.f, 0.f, 0.f, 0.f};
#pragma unroll
        for (int ai = 0; ai < 2; ++ai)
#pragma unroll
            for (int m = 0; m < 4; ++m) { bf16_t* rowp = base + (size_t)(row0 + ai * HALF + m * 16) * ldc + col0;
#pragma unroll
                for (int bj = 0; bj < 2; ++bj) { f32x4 v0 = acc[ai][bj][m][0] + bv[bj][0], v1 = acc[ai][bj][m][1] + bv[bj][1];
                    if (ACT == 1) { f32x2 a = gelu_pk((f32x2){v0[0], v0[1]}), b = gelu_pk((f32x2){v0[2], v0[3]}), c = gelu_pk((f32x2){v1[0], v1[1]}), d = gelu_pk((f32x2){v1[2], v1[3]});
                        v0 = (f32x4){a.x, a.y, b.x, b.y}; v1 = (f32x4){c.x, c.y, d.x, d.y}; }
                    v0 = v0 * sc; v1 = v1 * sc; u32x4 w; w.x = cvt_pk_bf16(v0[0], v0[1]); w.y = cvt_pk_bf16(v0[2], v0[3]); w.z = cvt_pk_bf16(v1[0], v1[1]); w.w = cvt_pk_bf16(v1[2], v1[3]);
                    *(u32x4*)(rowp + bj * HALF) = w; } }
    }
};

template <class Epi, class Sched, bool ALIGN_EPI = false, bool SP2 = false>
__device__ __forceinline__ void gemm_phase(PG8_LAS unsigned char* lds, const Gemm g, const Sched& S, const Epi& E) {
    int tid_ = threadIdx.x; asm volatile("" : "+v"(tid_));
    const int tid = tid_, wid = __builtin_amdgcn_readfirstlane(tid >> 6), lane = tid & 63, wr = wid >> 2, wc = wid & 3, fr = lane & 15, fq = lane >> 4;
    const int K = g.K, nt = K / BK;
    unsigned voffA[2], voffB[2];
#pragma unroll
    for (int i = 0; i < 2; ++i) { int R, C; stage_rc(tid * 16 + i * 8192, R, C); const int Rb = Epi::PERM ? ((R & ~31) + perm32(R & 31)) : R;
        voffA[i] = (unsigned)(R * K + C) * 2u; voffB[i] = (unsigned)(Rb * K + C) * 2u; }
    const size_t kstep = (size_t)(BK * 2);
    const size_t hstep = (size_t)HALF * K * 2;
    const size_t tstep = 2 * hstep;
    const unsigned ldsw = (unsigned)wid * 1024u;
    const int aoff = lds_byte(wr * 64 + fr, fq * 8), boff = lds_byte(wc * 32 + fr, fq * 8);
#define PG8_SA(b, h) (((b) * 2 + (h)) * HTB)
#define PG8_SB(b, h) ((4 + (b) * 2 + (h)) * HTB)
#define PG8_STAGE(bufoff, gbase, voff) do { _Pragma("unroll") for (int _i = 0; _i < 2; ++_i) \
        __builtin_amdgcn_global_load_lds((const unsigned*)((const char*)(gbase) + (voff)[_i]), (PG8_LAS unsigned*)(lds + (bufoff) + ldsw + _i * 8192), 16, 0, 0); } while (0)
#define PG8_LDA(dst, b, h) do { _Pragma("unroll") for (int m = 0; m < 4; ++m) _Pragma("unroll") for (int k = 0; k < 2; ++k) dst[m][k] = *(const PG8_LAS bf16x8*)(lds + PG8_SA(b, h) + aoff + m * 2048 + k * 1024); } while (0)
#define PG8_LDB(dst, b, h) do { _Pragma("unroll") for (int n = 0; n < 2; ++n) _Pragma("unroll") for (int k = 0; k < 2; ++k) dst[n][k] = *(const PG8_LAS bf16x8*)(lds + PG8_SB(b, h) + boff + n * 2048 + k * 1024); } while (0)
#define PG8_MMA(ai, bj, At, Bt) do { __builtin_amdgcn_s_setprio(1); _Pragma("unroll") for (int m = 0; m < 4; ++m) _Pragma("unroll") for (int n = 0; n < 2; ++n) _Pragma("unroll") for (int k = 0; k < 2; ++k) \
        acc[ai][bj][m][n] = __builtin_amdgcn_mfma_f32_16x16x32_bf16(Bt[n][k], At[m][k], acc[ai][bj][m][n], 0, 0, 0); __builtin_amdgcn_s_setprio(0); } while (0)
#define PG8_WAIT_V(n) asm volatile("s_waitcnt vmcnt(" #n ")" ::: "memory")
#define PG8_WAIT_L(n) asm volatile("s_waitcnt lgkmcnt(" #n ")" ::: "memory")
#define PG8_BAR __builtin_amdgcn_s_barrier()
#define PG8_SCHED __builtin_amdgcn_sched_barrier(0)
    float zf_ = 0.f; asm volatile("" : "+v"(zf_)); const f32x4 zero4_ = {zf_, zf_, zf_, zf_};
    Unit cur, nxt; int ui = 0;
    if (!S.next(0, cur)) return;
    f32x4 acc[2][2][4][2];
#pragma unroll
    for (int a = 0; a < 2; ++a)
#pragma unroll
        for (int b = 0; b < 2; ++b)
#pragma unroll
            for (int m = 0; m < 4; ++m)
#pragma unroll
                for (int n = 0; n < 2; ++n) acc[a][b][m][n] = zero4_;
    bf16x8 At[4][2], B0[2][2], B1[2][2];
    const char* cA = (const char*)g.A + (size_t)cur.pm * tstep; const char* cB = (const char*)g.Bt + (size_t)cur.pn * tstep;
    S.a_ready(cur);
    if constexpr (SP2) {
        PG8_STAGE(PG8_SB(0, 0), cB, voffB); PG8_STAGE(PG8_SB(0, 1), cB + hstep, voffB); PG8_STAGE(PG8_SA(0, 0), cA, voffA); PG8_STAGE(PG8_SA(0, 1), cA + hstep, voffA);
        if (wr == 1) PG8_BAR;
        PG8_WAIT_V(2); PG8_BAR;
        PG8_STAGE(PG8_SB(1, 0), cB + kstep, voffB); PG8_STAGE(PG8_SA(1, 0), cA + kstep, voffA); PG8_STAGE(PG8_SB(1, 1), cB + hstep + kstep, voffB);
        PG8_WAIT_V(6); PG8_BAR;
    } else {
        PG8_STAGE(PG8_SB(0, 0), cB, voffB); PG8_STAGE(PG8_SA(0, 0), cA, voffA); PG8_STAGE(PG8_SB(0, 1), cB + hstep, voffB); PG8_STAGE(PG8_SA(0, 1), cA + hstep, voffA);
        if (wr == 1) PG8_BAR;
        PG8_WAIT_V(4); PG8_BAR;
        PG8_STAGE(PG8_SB(1, 0), cB + kstep, voffB); PG8_STAGE(PG8_SA(1, 0), cA + kstep, voffA); PG8_STAGE(PG8_SB(1, 1), cB + hstep + kstep, voffB);
        PG8_WAIT_V(6); PG8_BAR;
    }
    for (;;) {
        const bool has_next = S.next(ui + 1, nxt);
        const char* nA = has_next ? (const char*)g.A + (size_t)nxt.pm * tstep : cA; const char* nB = has_next ? (const char*)g.Bt + (size_t)nxt.pn * tstep : cB;
        for (int t = 0; t < nt; t += 2) {
            const bool last = (t == nt - 2);
            const char* a1 = cA + (size_t)(t + 1) * kstep;
            const char* a2 = last ? nA : cA + (size_t)(t + 2) * kstep; const char* b2 = last ? nB : cB + (size_t)(t + 2) * kstep;
            const char* a3 = a2 + kstep; const char* b3 = b2 + kstep;
            if (last && has_next) S.a_ready(nxt);
            if constexpr (SP2) {
            PG8_LDB(B0, 0, 0); PG8_LDB(B1, 0, 1); PG8_SCHED; PG8_LDA(At, 0, 0); PG8_STAGE(PG8_SA(1, 1), a1 + hstep, voffA);
            PG8_WAIT_V(8); PG8_WAIT_L(0); PG8_BAR; PG8_MMA(0, 0, At, B0); PG8_MMA(0, 1, At, B1); PG8_BAR; PG8_SCHED;
            PG8_LDA(At, 0, 1); PG8_STAGE(PG8_SB(0, 0), b2, voffB); PG8_STAGE(PG8_SB(0, 1), b2 + hstep, voffB); PG8_STAGE(PG8_SA(0, 0), a2, voffA);
            PG8_WAIT_V(8); PG8_WAIT_L(0); PG8_BAR; PG8_MMA(1, 0, At, B0); PG8_MMA(1, 1, At, B1); PG8_BAR; PG8_SCHED;
            PG8_LDB(B0, 1, 0); PG8_LDB(B1, 1, 1); PG8_SCHED; PG8_LDA(At, 1, 0); PG8_STAGE(PG8_SA(0, 1), a2 + hstep, voffA);
            PG8_WAIT_V(8); PG8_WAIT_L(0); PG8_BAR; PG8_MMA(0, 0, At, B0); PG8_MMA(0, 1, At, B1); PG8_BAR; PG8_SCHED;
            PG8_LDA(At, 1, 1); PG8_STAGE(PG8_SB(1, 0), b3, voffB); PG8_STAGE(PG8_SB(1, 1), b3 + hstep, voffB); PG8_STAGE(PG8_SA(1, 0), a3, voffA);
            PG8_WAIT_V(8); PG8_WAIT_L(0); PG8_BAR; PG8_MMA(1, 0, At, B0); PG8_MMA(1, 1, At, B1); PG8_BAR; PG8_SCHED;
            } else {
            PG8_LDB(B0, 0, 0); PG8_SCHED; PG8_LDA(At, 0, 0); PG8_STAGE(PG8_SA(1, 1), a1 + hstep, voffA);
            PG8_WAIT_L(8); PG8_BAR; PG8_WAIT_L(0); PG8_MMA(0, 0, At, B0); PG8_BAR; PG8_SCHED;
            PG8_LDB(B1, 0, 1); PG8_STAGE(PG8_SB(0, 0), b2, voffB);
            PG8_BAR; PG8_WAIT_L(0); PG8_MMA(0, 1, At, B1); PG8_BAR;
            PG8_LDA(At, 0, 1); PG8_STAGE(PG8_SA(0, 0), a2, voffA);
            PG8_BAR; PG8_WAIT_L(0); PG8_MMA(1, 0, At, B0); PG8_BAR; PG8_SCHED;
            PG8_STAGE(PG8_SB(0, 1), b2 + hstep, voffB);
            PG8_WAIT_V(6); PG8_BAR; PG8_MMA(1, 1, At, B1); PG8_BAR;
            PG8_LDB(B0, 1, 0); PG8_SCHED; PG8_LDA(At, 1, 0); PG8_STAGE(PG8_SA(0, 1), a2 + hstep, voffA);
            PG8_WAIT_L(8); PG8_BAR; PG8_WAIT_L(0); PG8_MMA(0, 0, At, B0); PG8_BAR; PG8_SCHED;
            PG8_LDB(B1, 1, 1); PG8_STAGE(PG8_SB(1, 0), b3, voffB);
            PG8_BAR; PG8_WAIT_L(0); PG8_MMA(0, 1, At, B1); PG8_BAR;
            PG8_LDA(At, 1, 1); PG8_STAGE(PG8_SA(1, 0), a3, voffA);
            PG8_BAR; PG8_WAIT_L(0); PG8_MMA(1, 0, At, B0); PG8_BAR; PG8_SCHED;
            PG8_STAGE(PG8_SB(1, 1), b3 + hstep, voffB);
            PG8_WAIT_V(6); PG8_BAR; PG8_MMA(1, 1, At, B1); PG8_BAR;
            }
        }
        if constexpr (ALIGN_EPI) { if (wr == 0) PG8_BAR; }
        if constexpr (!Epi::AFTER_DRAIN) { E(acc, cur, wr, wc, fr, fq); S.done(cur); }
        if (!has_next) break;
#pragma unroll
        for (int a = 0; a < 2; ++a)
#pragma unroll
            for (int b = 0; b < 2; ++b)
#pragma unroll
                for (int m = 0; m < 4; ++m)
#pragma unroll
                    for (int n = 0; n < 2; ++n) acc[a][b][m][n] = zero4_;
        cur = nxt; cA = nA; cB = nB; ++ui;
        if constexpr (ALIGN_EPI) { if (wr == 1) PG8_BAR; }
    }
    PG8_WAIT_V(0);
    if constexpr (!ALIGN_EPI) { if (wr == 0) PG8_BAR; }
    PG8_BAR;
    if constexpr (Epi::AFTER_DRAIN) { E.fused(acc, cur, wr, wc, fr, fq, lds, wid, lane); S.done(cur); }
#undef PG8_SA
#undef PG8_SB
#undef PG8_STAGE
#undef PG8_LDA
#undef PG8_LDB
#undef PG8_MMA
#undef PG8_WAIT_V
#undef PG8_WAIT_L
#undef PG8_BAR
#undef PG8_SCHED
}
}

#define LAS __attribute__((address_space(3)))
typedef unsigned short bf16;
typedef unsigned v4u __attribute__((ext_vector_type(4)));
typedef unsigned v2u __attribute__((ext_vector_type(2)));
typedef float fx4 __attribute__((ext_vector_type(4)));
typedef float fx2 __attribute__((ext_vector_type(2)));
typedef float fx16 __attribute__((ext_vector_type(16)));
typedef short hx8 __attribute__((ext_vector_type(8)));
typedef short hx4 __attribute__((ext_vector_type(4)));
typedef __bf16 bfx2_t __attribute__((ext_vector_type(2)));

constexpr int NB = 4, SEQ = 8192, T = NB * SEQ, D = 1024, FF = 2816, NIN = 1952, NINP = 2048, PLE = 256;
constexpr int QL = 256, KVL = 128;
constexpr float EPS = 1e-6f;
constexpr int NTHREADS = 512;
constexpr int LDS_BYTES = 131072 + 1024;

constexpr size_t MiB = 1u << 20;
constexpr size_t OFF_WB = 0;
constexpr size_t OFF_TAB = 48 * MiB;
constexpr size_t OFF_LSE = 60 * MiB;
constexpr size_t OFF_XN = 64 * MiB;
constexpr size_t OFF_F = 128 * MiB;
constexpr size_t OFF_HID = 192 * MiB;
constexpr size_t OFF_Q = OFF_HID + 128 * MiB;
constexpr size_t OFF_KCAT = 368 * MiB;
constexpr size_t OFF_V = 416 * MiB;
constexpr size_t OFF_QLN = 448 * MiB;
constexpr size_t OFF_KVLN = 464 * MiB;
constexpr size_t WS_NEED = 472 * MiB;
constexpr size_t WE_FIN_A = 0;
constexpr size_t WE_FDN_A = WE_FIN_A + (size_t)2 * FF * D;
constexpr size_t WE_FIN_B = WE_FDN_A + (size_t)D * FF;
constexpr size_t WE_FDN_B = WE_FIN_B + (size_t)2 * FF * D;
constexpr size_t WE_IN = WE_FDN_B + (size_t)D * FF;
constexpr size_t WE_QUP = WE_IN + (size_t)NINP * D;
constexpr size_t WE_OUT = WE_QUP + (size_t)1792 * 384;
constexpr size_t WE_PLE = WE_OUT + (size_t)D * D;
constexpr size_t WE_PG = WE_PLE + (size_t)D * PLE;
constexpr size_t WE_END = WE_PG + (size_t)D * D;
static_assert(WE_END * 2 <= 48 * MiB, "weights fit");

__device__ const float INV_M[16] = {1.000000000e+00f, 5.623413324e-01f, 3.162277639e-01f, 1.778279394e-01f, 1.000000015e-01f, 5.623413250e-02f, 3.162277490e-02f, 1.778279431e-02f, 9.999999776e-03f, 5.623413250e-03f, 3.162277630e-03f, 1.778279431e-03f, 1.000000047e-03f, 5.623413017e-04f, 3.162277571e-04f, 1.778279402e-04f};
__device__ const float INV_D[32] = {1.000000000e+00f, 7.498942614e-01f, 5.623413324e-01f, 4.216965139e-01f, 3.162277639e-01f, 2.371373773e-01f, 1.778279394e-01f, 1.333521307e-01f, 1.000000015e-01f, 7.498941571e-02f, 5.623413250e-02f, 4.216965288e-02f, 3.162277490e-02f, 2.371373773e-02f, 1.778279431e-02f, 1.333521493e-02f, 9.999999776e-03f, 7.498941850e-03f, 5.623413250e-03f, 4.216964822e-03f, 3.162277630e-03f, 2.371373586e-03f, 1.778279431e-03f, 1.333521446e-03f, 1.000000047e-03f, 7.498942432e-04f, 5.623413017e-04f, 4.216965172e-04f, 3.162277571e-04f, 2.371373703e-04f, 1.778279402e-04f, 1.333521504e-04f};

struct Params { const float* in[16]; float* out; unsigned char* ws; };

__device__ __forceinline__ unsigned pk2(float lo, float hi) { fx2 v = {lo, hi}; bfx2_t b = __builtin_convertvector(v, bfx2_t); return __builtin_bit_cast(unsigned, b); }
__device__ __forceinline__ float bflo(unsigned u) { return __uint_as_float(u << 16); }
__device__ __forceinline__ float bfhi(unsigned u) { return __uint_as_float(u & 0xffff0000u); }
__device__ __forceinline__ float wave_sum(float v) {
#pragma unroll
    for (int o = 1; o < 64; o <<= 1) v += __shfl_xor(v, o);
    return v;
}
__device__ __forceinline__ float fast_rcp(float x) { return __builtin_amdgcn_rcpf(x); }
__device__ __forceinline__ float fast_exp2(float x) { return __builtin_amdgcn_exp2f(x); }
__device__ __forceinline__ float fast_rsq(float x) { return __builtin_amdgcn_rsqf(x); }

namespace pg8 {
struct EpiSwiglu {
    static constexpr bool PERM = true, AFTER_DRAIN = false;
    bf16_t* O; int ldc;
    __device__ __forceinline__ void operator()(const f32x4 (&acc)[2][2][4][2], const Unit& u, int wr, int wc, int fr, int fq) const {
        const int row0 = u.pm * BM + wr * 64 + fr; const int col0 = u.pn * 128 + wc * 32 + 8 * fq;
#pragma unroll
        for (int ai = 0; ai < 2; ++ai)
#pragma unroll
            for (int m = 0; m < 4; ++m) {
                bf16_t* rowp = O + (size_t)(row0 + ai * HALF + m * 16) * ldc + col0;
                float h[8];
#pragma unroll
                for (int n = 0; n < 2; ++n)
#pragma unroll
                    for (int e = 0; e < 4; ++e) {
                        const float g = acc[ai][0][m][n][e], up = acc[ai][1][m][n][e];
                        const float sg = g * __builtin_amdgcn_rcpf(1.0f + __builtin_amdgcn_exp2f(-1.4426950408889634f * g));
                        h[n * 4 + e] = sg * up;
                    }
                u32x4 w; w.x = ::pk2(h[0], h[1]); w.y = ::pk2(h[2], h[3]); w.z = ::pk2(h[4], h[5]); w.w = ::pk2(h[6], h[7]);
                *(u32x4*)rowp = w;
            }
    }
};
struct EpiQKV {
    static constexpr bool PERM = true, AFTER_DRAIN = false;
    bf16_t* Q; bf16_t* Kc; bf16_t* V;
    __device__ __forceinline__ void operator()(const f32x4 (&acc)[2][2][4][2], const Unit& u, int wr, int wc, int fr, int fq) const {
        const int row0 = u.pm * BM + wr * 64 + fr;
#pragma unroll
        for (int bj = 0; bj < 2; ++bj) {
            bf16_t* ub; int rs;
            if (u.pn < 3) { ub = Q + u.pn * 256 + bj * 128 + wc * 32; rs = 768; }
            else { const int head = 2 * (u.pn - 3) + bj; if (wc < 2) { ub = Kc + head * 96 + wc * 32; rs = 768; } else { ub = V + head * 64 + (wc * 32 - 64); rs = 512; } }
            const unsigned loff = (unsigned)row0 * (unsigned)rs + 8u * (unsigned)fq;
#pragma unroll
            for (int ai = 0; ai < 2; ++ai)
#pragma unroll
                for (int m = 0; m < 4; ++m) {
                    bf16_t* dst = ub + (loff + (unsigned)((ai * HALF + m * 16) * rs));
                    const f32x4 v0 = acc[ai][bj][m][0], v1 = acc[ai][bj][m][1];
                    u32x4 w; w.x = ::pk2(v0[0], v0[1]); w.y = ::pk2(v0[2], v0[3]); w.z = ::pk2(v1[0], v1[1]); w.w = ::pk2(v1[2], v1[3]);
                    *(u32x4*)dst = w;
                }
        }
    }
};
struct EpiGate {
    static constexpr bool PERM = true, AFTER_DRAIN = false;
    bf16_t* O; const bf16_t* PP; int ldc;
    __device__ __forceinline__ void operator()(const f32x4 (&acc)[2][2][4][2], const Unit& u, int wr, int wc, int fr, int fq) const {
        const int row0 = u.pm * BM + wr * 64 + fr; const int col0 = u.pn * BM + wc * 32 + 8 * fq;
#pragma unroll
        for (int ai = 0; ai < 2; ++ai)
#pragma unroll
            for (int m = 0; m < 4; ++m)
#pragma unroll
                for (int bj = 0; bj < 2; ++bj) {
                    const size_t off = (size_t)(row0 + ai * HALF + m * 16) * ldc + col0 + bj * HALF;
                    const u32x4 pv = *(const u32x4*)(PP + off);
                    float pp[8] = {::bflo(pv.x), ::bfhi(pv.x), ::bflo(pv.y), ::bfhi(pv.y), ::bflo(pv.z), ::bfhi(pv.z), ::bflo(pv.w), ::bfhi(pv.w)};
                    float o[8];
#pragma unroll
                    for (int n = 0; n < 2; ++n)
#pragma unroll
                        for (int e = 0; e < 4; ++e) {
                            const float g = acc[ai][bj][m][n][e];
                            o[n * 4 + e] = pp[n * 4 + e] * __builtin_amdgcn_rcpf(1.0f + __builtin_amdgcn_exp2f(-1.4426950408889634f * g));
                        }
                    u32x4 w; w.x = ::pk2(o[0], o[1]); w.y = ::pk2(o[2], o[3]); w.z = ::pk2(o[4], o[5]); w.w = ::pk2(o[6], o[7]);
                    *(u32x4*)(O + off) = w;
                }
    }
};
}

__device__ __forceinline__ void tr_item(const float* W, int K, int N, int k0, int n0, bf16* WT, int drow0, int ldk, int dk, LAS float* scr, int lane) {
#pragma unroll 8
    for (int i = 0; i < 32; ++i) { const int kk = 2 * i + (lane >> 5); scr[kk * 33 + (lane & 31)] = W[(size_t)(k0 + kk) * N + n0 + (lane & 31)]; }
    asm volatile("s_waitcnt lgkmcnt(0)" ::: "memory");
    const int c = lane & 7;
#pragma unroll
    for (int j = 0; j < 4; ++j) { const int n = (lane >> 3) + 8 * j; const LAS float* s = scr + (8 * c) * 33 + n;
        v4u o; o.x = pk2(s[0 * 33], s[1 * 33]); o.y = pk2(s[2 * 33], s[3 * 33]); o.z = pk2(s[4 * 33], s[5 * 33]); o.w = pk2(s[6 * 33], s[7 * 33]);
        *(v4u*)(WT + (size_t)(drow0 + n) * ldk + dk + k0 + 8 * c) = o; }
    asm volatile("s_waitcnt lgkmcnt(0)" ::: "memory");
}
__device__ __forceinline__ void tr_matrix_item(const float* W, int K, int N, bf16* WT, int mode, int item, LAS float* scr, int lane, int ldk = 0, int dk = 0) {
    const int nblk = N / 32, kb = item / nblk, nb = item % nblk, k0 = 64 * kb, n0 = 32 * nb;
    int drow0 = n0;
    if (mode != 0) drow0 = 256 * (n0 >> 7) + (n0 & 127) + (mode == 2 ? 128 : 0);
    tr_item(W, K, N, k0, n0, WT, drow0, ldk ? ldk : K, dk, scr, lane);
}
__device__ __forceinline__ void convert_weights(const Params& P, unsigned char* ws, int layer, LAS unsigned char* lds, int gw, int NGW, int wave, int lane) {
    LAS float* scr = (LAS float*)(lds + wave * 16384);
    bf16* WB = (bf16*)(ws + OFF_WB);
    const float* w_in = P.in[4] + (size_t)layer * D * NIN;
    const float* w_qup = P.in[6] + (size_t)layer * QL * 768;
    const float* w_kvup = P.in[8] + (size_t)layer * KVL * 1024;
    const float* w_out = P.in[10] + (size_t)layer * D * D;
    const float* fg = P.in[11] + (size_t)layer * 2 * D * FF;
    const float* fu = P.in[12] + (size_t)layer * 2 * D * FF;
    const float* fd = P.in[13] + (size_t)layer * 2 * FF * D;
    const float* w_ple = P.in[14] + (size_t)layer * PLE * D;
    const float* w_pg = P.in[15] + (size_t)layer * D * D;
    constexpr int I_FIN = (D / 64) * (FF / 32);
    constexpr int I_FDN = (FF / 64) * (D / 32);
    constexpr int I_IN = (D / 64) * (NIN / 32);
    constexpr int I_QUP = (QL / 64) * (768 / 32);
    constexpr int I_KVUP = (KVL / 64) * (1024 / 32);
    constexpr int I_DD = (D / 64) * (D / 32);
    constexpr int I_PLE = (PLE / 64) * (D / 32);
    constexpr int NITEMS = 4 * I_FIN + 2 * I_FDN + I_IN + I_QUP + I_KVUP + 2 * I_DD + I_PLE;
    for (int it = gw; it < NITEMS; it += NGW) {
        int r = it;
        if (r < I_FIN) { tr_matrix_item(fg, D, FF, WB + WE_FIN_A, 1, r, scr, lane); continue; } r -= I_FIN;
        if (r < I_FIN) { tr_matrix_item(fu, D, FF, WB + WE_FIN_A, 2, r, scr, lane); continue; } r -= I_FIN;
        if (r < I_FIN) { tr_matrix_item(fg + (size_t)D * FF, D, FF, WB + WE_FIN_B, 1, r, scr, lane); continue; } r -= I_FIN;
        if (r < I_FIN) { tr_matrix_item(fu + (size_t)D * FF, D, FF, WB + WE_FIN_B, 2, r, scr, lane); continue; } r -= I_FIN;
        if (r < I_FDN) { tr_matrix_item(fd, FF, D, WB + WE_FDN_A, 0, r, scr, lane); continue; } r -= I_FDN;
        if (r < I_FDN) { tr_matrix_item(fd + (size_t)FF * D, FF, D, WB + WE_FDN_B, 0, r, scr, lane); continue; } r -= I_FDN;
        if (r < I_IN) { tr_matrix_item(w_in, D, NIN, WB + WE_IN, 0, r, scr, lane); continue; } r -= I_IN;
        if (r < I_QUP) { tr_matrix_item(w_qup, QL, 768, WB + WE_QUP, 0, r, scr, lane, 384, 0); continue; } r -= I_QUP;
        if (r < I_KVUP) { tr_matrix_item(w_kvup, KVL, 1024, WB + WE_QUP + (size_t)768 * 384, 0, r, scr, lane, 384, 256); continue; } r -= I_KVUP;
        if (r < I_DD) { tr_matrix_item(w_out, D, D, WB + WE_OUT, 0, r, scr, lane); continue; } r -= I_DD;
        if (r < I_PLE) { tr_matrix_item(w_ple, PLE, D, WB + WE_PLE, 0, r, scr, lane); continue; } r -= I_PLE;
        tr_matrix_item(w_pg, D, D, WB + WE_PG, 0, r, scr, lane);
    }
    {
        v4u* qk = (v4u*)(WB + WE_QUP); unsigned z0_ = 0u; asm volatile("" : "+v"(z0_)); const v4u z = {z0_, z0_, z0_, z0_};
        const int gt = gw * 64 + lane, NTT = NGW * 64;
        for (int i = gt; i < 768 * 16; i += NTT) { const int row = i >> 4, ch = i & 15; qk[(size_t)row * 48 + 32 + ch] = z; }
        for (int i = gt; i < 1024 * 32; i += NTT) { const int row = 768 + (i >> 5), ch = i & 31; qk[(size_t)row * 48 + ch] = z; }
    }
}

__device__ __forceinline__ void rope_tables(const Params& P, unsigned char* ws, int gtid, int NT) {
    const int* pos = (const int*)P.in[2];
    float* cosM = (float*)(ws + OFF_TAB); float* sinM = cosM + (size_t)T * 16; float* cosD = sinM + (size_t)T * 16; float* sinD = cosD + (size_t)T * 32;
    for (int e = gtid; e < T * 48; e += NT) {
        const int tok = e / 48, i = e % 48;
        const float inv = (i < 16) ? INV_M[i] : INV_D[i - 16];
        const float ang = (float)pos[tok] * inv;
        double tt = (double)ang * 0.15915494309189535; tt -= __builtin_rint(tt);
        const float rev = (float)tt;
        const float c = __builtin_amdgcn_cosf(rev), s = __builtin_amdgcn_sinf(rev);
        if (i < 16) { cosM[(size_t)tok * 16 + i] = c; sinM[(size_t)tok * 16 + i] = s; }
        else { cosD[(size_t)tok * 32 + i - 16] = c; sinD[(size_t)tok * 32 + i - 16] = s; }
    }
}

template <bool HAS_F>
__device__ __forceinline__ void resnorm_rows(const float* hin, float* hout, const bf16* f, float alpha, const float* ga, const float* gb, bf16* xn, int gw, int NGW, int lane) {
    for (int m = gw; m < T; m += NGW) {
        const fx4* hr = (const fx4*)(hin + (size_t)m * D) + lane;
        fx4 hv[4];
#pragma unroll
        for (int j = 0; j < 4; ++j) hv[j] = hr[64 * j];
        if (HAS_F) {
            const v2u* fr = (const v2u*)(f + (size_t)m * D) + lane;
            fx4 fv[4]; float ss = 0.f;
#pragma unroll
            for (int j = 0; j < 4; ++j) { const v2u w = fr[64 * j]; fv[j] = (fx4){bflo(w.x), bfhi(w.x), bflo(w.y), bfhi(w.y)}; ss += (fv[j].x * fv[j].x + fv[j].y * fv[j].y) + (fv[j].z * fv[j].z + fv[j].w * fv[j].w); }
            const float rstd = fast_rsq(wave_sum(ss) * (1.0f / D) + EPS) * alpha;
            fx4* ho = (fx4*)(hout + (size_t)m * D) + lane;
#pragma unroll
            for (int j = 0; j < 4; ++j) { const fx4 g = ((const fx4*)ga)[lane + 64 * j]; hv[j] = hv[j] + fv[j] * g * rstd; ho[64 * j] = hv[j]; }
        } else {
            fx4* ho = (fx4*)(hout + (size_t)m * D) + lane;
#pragma unroll
            for (int j = 0; j < 4; ++j) ho[64 * j] = hv[j];
        }
        float s2 = 0.f;
#pragma unroll
        for (int j = 0; j < 4; ++j) s2 += (hv[j].x * hv[j].x + hv[j].y * hv[j].y) + (hv[j].z * hv[j].z + hv[j].w * hv[j].w);
        const float rstd2 = fast_rsq(wave_sum(s2) * (1.0f / D) + EPS);
        v2u* xo = (v2u*)(xn + (size_t)m * D) + lane;
#pragma unroll
        for (int j = 0; j < 4; ++j) { const fx4 g = ((const fx4*)gb)[lane + 64 * j]; const fx4 y = hv[j] * g * rstd2; xo[64 * j] = (v2u){pk2(y.x, y.y), pk2(y.z, y.w)}; }
    }
}

__device__ __forceinline__ void mixer_prep_rows(const Params& P, unsigned char* ws, int layer, int gw, int NGW, int lane) {
    bf16* Z = (bf16*)(ws + OFF_HID); bf16* qkv = (bf16*)(ws + OFF_QLN); bf16* Kc = (bf16*)(ws + OFF_KCAT);
    const float* cosM = (const float*)(ws + OFF_TAB); const float* sinM = cosM + (size_t)T * 16; const float* cosD = sinM + (size_t)T * 16; const float* sinD = cosD + (size_t)T * 32;
    const float* qn = P.in[5] + (size_t)layer * QL; const float* kvn = P.in[7] + (size_t)layer * KVL;
    for (int m = gw; m < T; m += NGW) {
        bf16* z = Z + (size_t)m * NINP;
        {
            const v2u w = ((const v2u*)z)[lane]; const fx4 v = {bflo(w.x), bfhi(w.x), bflo(w.y), bfhi(w.y)};
            const float ss = (v.x * v.x + v.y * v.y) + (v.z * v.z + v.w * v.w);
            const float rstd = fast_rsq(wave_sum(ss) * (1.0f / QL) + EPS);
            const fx4 g = ((const fx4*)qn)[lane]; const fx4 y = v * g * rstd;
            ((v2u*)(qkv + (size_t)m * 384))[lane] = (v2u){pk2(y.x, y.y), pk2(y.z, y.w)};
        }
        {
            const unsigned w = ((const unsigned*)(z + 256))[lane]; const float a = bflo(w), b = bfhi(w);
            const float rstd = fast_rsq(wave_sum(a * a + b * b) * (1.0f / KVL) + EPS);
            const fx2 g = ((const fx2*)kvn)[lane];
            ((unsigned*)(qkv + (size_t)m * 384 + 256))[lane] = pk2(a * g.x * rstd, b * g.y * rstd);
        }
        if (lane < 16) {
            const float x1 = __uint_as_float((unsigned)z[384 + lane] << 16), x2 = __uint_as_float((unsigned)z[400 + lane] << 16);
            const float c = cosM[(size_t)m * 16 + lane], s = sinM[(size_t)m * 16 + lane];
            const unsigned o = pk2(x1 * c - x2 * s, x2 * c + x1 * s);
            bf16* kr = Kc + (size_t)m * 768 + 64 + lane;
#pragma unroll
            for (int h = 0; h < 8; ++h) { kr[h * 96] = (bf16)(o & 0xffffu); kr[h * 96 + 16] = (bf16)(o >> 16); }
        }
        {
            const int head = lane >> 3, c4 = lane & 7;
            const fx4 cs = ((const fx4*)(cosD + (size_t)m * 32))[c4], sn = ((const fx4*)(sinD + (size_t)m * 32))[c4];
#pragma unroll
            for (int w = 0; w < 2; ++w) {
                bf16* base = z + (w == 0 ? 416 : 928) + head * 64 + 4 * c4;
                const v2u a = *(const v2u*)base, b = *(const v2u*)(base + 32);
                const fx4 x1 = {bflo(a.x), bfhi(a.x), bflo(a.y), bfhi(a.y)}, x2 = {bflo(b.x), bfhi(b.x), bflo(b.y), bfhi(b.y)};
                const fx4 o1 = x1 * cs - x2 * sn, o2 = x2 * cs + x1 * sn;
                *(v2u*)base = (v2u){pk2(o1.x, o1.y), pk2(o1.z, o1.w)};
                *(v2u*)(base + 32) = (v2u){pk2(o2.x, o2.y), pk2(o2.z, o2.w)};
            }
        }
    }
}

__device__ __forceinline__ void merge_rows(const Params& P, unsigned char* ws, int layer, int gw, int NGW, int lane) {
    bf16* XN = (bf16*)(ws + OFF_XN); const bf16* Fb = (const bf16*)(ws + OFF_F); const float* LSE = (const float*)(ws + OFF_LSE);
    const float* gg = P.in[9] + (size_t)layer * D;
    const int head = lane >> 3;
    for (int m = gw; m < T; m += NGW) {
        const v4u wm = *(const v4u*)(XN + (size_t)m * D + 8 * lane);
        const v4u w2 = *(const v4u*)(XN + (size_t)m * D + 512 + 8 * lane);
        const v4u w0 = *(const v4u*)(Fb + (size_t)m * 512 + 8 * lane);
        const v4u w1 = *(const v4u*)(Fb + (size_t)T * 512 + (size_t)m * 512 + 8 * lane);
        const float L0 = LSE[(size_t)m * 8 + head], L1 = LSE[(size_t)T * 8 + (size_t)m * 8 + head], L2 = LSE[(size_t)2 * T * 8 + (size_t)m * 8 + head];
        const float mx = fmaxf(L0, fmaxf(L1, L2));
        float e0 = fast_exp2(L0 - mx), e1 = fast_exp2(L1 - mx), e2 = fast_exp2(L2 - mx);
        const float inv = fast_rcp(e0 + e1 + e2); e0 *= inv; e1 *= inv; e2 *= inv;
        float om[8] = {bflo(wm.x), bfhi(wm.x), bflo(wm.y), bfhi(wm.y), bflo(wm.z), bfhi(wm.z), bflo(wm.w), bfhi(wm.w)};
        float a0[8] = {bflo(w0.x), bfhi(w0.x), bflo(w0.y), bfhi(w0.y), bflo(w0.z), bfhi(w0.z), bflo(w0.w), bfhi(w0.w)};
        float a1[8] = {bflo(w1.x), bfhi(w1.x), bflo(w1.y), bfhi(w1.y), bflo(w1.z), bfhi(w1.z), bflo(w1.w), bfhi(w1.w)};
        float a2[8] = {bflo(w2.x), bfhi(w2.x), bflo(w2.y), bfhi(w2.y), bflo(w2.z), bfhi(w2.z), bflo(w2.w), bfhi(w2.w)};
        float od[8]; float ssm = 0.f, ssd = 0.f;
#pragma unroll
        for (int e = 0; e < 8; ++e) { od[e] = e0 * a0[e] + e1 * a1[e] + e2 * a2[e]; ssm += om[e] * om[e]; ssd += od[e] * od[e]; }
        const float rm = fast_rsq(wave_sum(ssm) * (1.0f / 512) + EPS), rd = fast_rsq(wave_sum(ssd) * (1.0f / 512) + EPS);
        const fx4 gm0 = ((const fx4*)gg)[2 * lane], gm1 = ((const fx4*)gg)[2 * lane + 1], gd0 = ((const fx4*)(gg + 512))[2 * lane], gd1 = ((const fx4*)(gg + 512))[2 * lane + 1];
        v4u o;
        o.x = pk2(om[0] * gm0.x * rm, om[1] * gm0.y * rm); o.y = pk2(om[2] * gm0.z * rm, om[3] * gm0.w * rm); o.z = pk2(om[4] * gm1.x * rm, om[5] * gm1.y * rm); o.w = pk2(om[6] * gm1.z * rm, om[7] * gm1.w * rm);
        *(v4u*)(XN + (size_t)m * D + 8 * lane) = o;
        o.x = pk2(od[0] * gd0.x * rd, od[1] * gd0.y * rd); o.y = pk2(od[2] * gd0.z * rd, od[3] * gd0.w * rd); o.z = pk2(od[4] * gd1.x * rd, od[5] * gd1.y * rd); o.w = pk2(od[6] * gd1.z * rd, od[7] * gd1.w * rd);
        *(v4u*)(XN + (size_t)m * D + 512 + 8 * lane) = o;
    }
}

__device__ __forceinline__ void convert_p(const Params& P, unsigned char* ws, int layer, int gtid, int NT) {
    const fx4* src = (const fx4*)(P.in[1] + (size_t)layer * T * PLE); v4u* dst = (v4u*)(ws + OFF_QLN);
    for (int i = gtid; i < T * PLE / 8; i += NT) { const fx4 a = src[2 * i], b = src[2 * i + 1]; dst[i] = (v4u){pk2(a.x, a.y), pk2(a.z, a.w), pk2(b.x, b.y), pk2(b.z, b.w)}; }
}

struct AttnArgs {
    const bf16* Q; int qs;
    const bf16* K; int ks;
    const bf16* V; int vs;
    bf16* O; int os;
    float* L; int ls;
    const float* cosT; const float* sinT;
    int q0; float c;
};
template <int DQK, bool WIN>
__device__ __forceinline__ void attn_unit(LAS unsigned char* lds, const AttnArgs& a) {
    constexpr int KCH = DQK / 8, NKC = 64 * KCH, NC = NKC + 512, NIT = (NC + 511) / 512;
    constexpr int KRS = DQK * 2 + 16, KBYTES = 64 * KRS, BUFB = KBYTES + 8192;
    constexpr int NDS = DQK / 16;
    int tid_ = threadIdx.x; asm volatile("" : "+v"(tid_));
    const int tid = tid_, lane = tid & 63, wid = __builtin_amdgcn_readfirstlane(tid >> 6), r32 = lane & 31, hi = lane >> 5;
    const int qw0 = a.q0 + 32 * wid, qpos = qw0 + r32;
    const int t_hi = (a.q0 + 256) >> 6;
    const int t_lo = WIN ? (a.q0 >= 128 ? ((a.q0 - 128) >> 6) : 0) : 0;
    v4u st[NIT];
#pragma unroll
    for (int it = 0; it < NIT; ++it) { const int c = tid + 512 * it;
        if (c < NC) { if (c < NKC) { const int row = c / KCH, ch = c % KCH; st[it] = *(const v4u*)(a.K + (long)(64 * t_lo + row) * a.ks + ch * 8); }
                      else { const int c2 = c - NKC, row = c2 >> 3, ch = c2 & 7; st[it] = *(const v4u*)(a.V + (long)(64 * t_lo + row) * a.vs + ch * 8); } } }
    hx8 qf[NDS];
    { const bf16* qrow = a.Q + (long)qpos * a.qs + 8 * hi;
#pragma unroll
      for (int ds = 0; ds < NDS; ++ds) qf[ds] = *(const hx8*)(qrow + 16 * ds);
      if (DQK == 96) {
          const fx4* cp = (const fx4*)(a.cosT + (long)qpos * 16 + 8 * hi); const fx4* sp = (const fx4*)(a.sinT + (long)qpos * 16 + 8 * hi);
          const fx4 c0 = cp[0], c1 = cp[1], s0 = sp[0], s1 = sp[1];
          const float cc[8] = {c0.x, c0.y, c0.z, c0.w, c1.x, c1.y, c1.z, c1.w}, sn[8] = {s0.x, s0.y, s0.z, s0.w, s1.x, s1.y, s1.z, s1.w};
          float n1[8], n2[8];
#pragma unroll
          for (int j = 0; j < 8; ++j) { const float x1 = __uint_as_float((unsigned)(unsigned short)qf[NDS - 2][j] << 16), x2 = __uint_as_float((unsigned)(unsigned short)qf[NDS - 1][j] << 16);
              n1[j] = x1 * cc[j] - x2 * sn[j]; n2[j] = x2 * cc[j] + x1 * sn[j]; }
          qf[NDS - 2] = __builtin_bit_cast(hx8, (v4u){pk2(n1[0], n1[1]), pk2(n1[2], n1[3]), pk2(n1[4], n1[5]), pk2(n1[6], n1[7])});
          qf[NDS - 1] = __builtin_bit_cast(hx8, (v4u){pk2(n2[0], n2[1]), pk2(n2[2], n2[3]), pk2(n2[4], n2[5]), pk2(n2[6], n2[7])});
      } }
#pragma unroll
    for (int it = 0; it < NIT; ++it) { const int c = tid + 512 * it;
        if (c < NC) { if (c < NKC) { const int row = c / KCH, ch = c % KCH; *(LAS v4u*)(lds + row * KRS + ch * 16) = st[it]; }
                      else { const int c2 = c - NKC, row = c2 >> 3, ch = c2 & 7; *(LAS v4u*)(lds + KBYTES + (ch >> 2) * 4096 + row * 64 + (ch & 3) * 16) = st[it]; } } }
    __syncthreads();
    float m_run = -INFINITY, l_run = 0.f;
    fx16 o[2];
#pragma unroll
    for (int r = 0; r < 16; ++r) { o[0][r] = 0.f; o[1][r] = 0.f; }
    const int vlane = ((lane >> 4) & 1) * 32 + (lane & 3) * 8 + (4 * hi + ((lane & 15) >> 2)) * 64;
    int cur = 0;
    for (int t = t_lo; t < t_hi; ++t) {
        const bool more = (t + 1 < t_hi);
        if (more) {
#pragma unroll
            for (int it = 0; it < NIT; ++it) { const int c = tid + 512 * it;
                if (c < NC) { if (c < NKC) { const int row = c / KCH, ch = c % KCH; st[it] = *(const v4u*)(a.K + (long)(64 * (t + 1) + row) * a.ks + ch * 8); }
                              else { const int c2 = c - NKC, row = c2 >> 3, ch = c2 & 7; st[it] = *(const v4u*)(a.V + (long)(64 * (t + 1) + row) * a.vs + ch * 8); } } }
        }
        const bool need = (64 * t <= qw0 + 31) && (!WIN || (64 * t + 63 >= qw0 - 128));
        if (need) {
            const LAS unsigned char* kb_ = lds + cur * BUFB; const LAS unsigned char* vb_ = kb_ + KBYTES + vlane;
            fx16 p[2];
#pragma unroll
            for (int kb = 0; kb < 2; ++kb) {
#pragma unroll
                for (int r = 0; r < 16; ++r) p[kb][r] = 0.f;
#pragma unroll
                for (int ds = 0; ds < NDS; ++ds) {
                    const hx8 kf = *(const LAS hx8*)(kb_ + (32 * kb + r32) * KRS + (16 * ds + 8 * hi) * 2);
                    p[kb] = __builtin_amdgcn_mfma_f32_32x32x16_bf16(kf, qf[ds], p[kb], 0, 0, 0);
                }
            }
            const bool domask = WIN || (64 * t + 63 > qw0);
            float mx = -INFINITY;
            if (domask) {
#pragma unroll
                for (int kb = 0; kb < 2; ++kb)
#pragma unroll
                    for (int r = 0; r < 16; ++r) {
                        const int kv = 64 * t + 32 * kb + (r & 3) + 8 * (r >> 2) + 4 * hi;
                        const bool ok = (kv <= qpos) && (!WIN || (qpos - kv <= 128));
                        const float v = ok ? p[kb][r] : -INFINITY; p[kb][r] = v; mx = fmaxf(mx, v);
                    }
            } else {
#pragma unroll
                for (int kb = 0; kb < 2; ++kb)
#pragma unroll
                    for (int r = 0; r < 16; ++r) mx = fmaxf(mx, p[kb][r]);
            }
            mx = fmaxf(mx, __shfl_xor(mx, 32));
            const float mnew = fmaxf(m_run, mx * a.c);
            const float muse = (mnew == -INFINITY) ? 0.f : mnew;
            const float alpha = fast_exp2(m_run - muse);
            m_run = mnew;
            float rs = 0.f;
#pragma unroll
            for (int kb = 0; kb < 2; ++kb)
#pragma unroll
                for (int r = 0; r < 16; ++r) { const float e = fast_exp2(__builtin_fmaf(p[kb][r], a.c, -muse)); p[kb][r] = e; rs += e; }
            l_run = l_run * alpha + rs;
#pragma unroll
            for (int r = 0; r < 16; ++r) { o[0][r] *= alpha; o[1][r] *= alpha; }
            hx8 pb[4];
#pragma unroll
            for (int ks = 0; ks < 4; ++ks) { const int kb = ks >> 1, s8 = (ks & 1) * 8;
                pb[ks] = __builtin_bit_cast(hx8, (v4u){pk2(p[kb][s8 + 0], p[kb][s8 + 1]), pk2(p[kb][s8 + 2], p[kb][s8 + 3]), pk2(p[kb][s8 + 4], p[kb][s8 + 5]), pk2(p[kb][s8 + 6], p[kb][s8 + 7])}); }
#pragma unroll
            for (int db = 0; db < 2; ++db)
#pragma unroll
                for (int ks = 0; ks < 4; ++ks) {
                    const hx4 lo = __builtin_bit_cast(hx4, __builtin_amdgcn_ds_read_tr16_b64_v4i16((LAS hx4*)(vb_ + db * 4096 + ks * 1024)));
                    const hx4 hh = __builtin_bit_cast(hx4, __builtin_amdgcn_ds_read_tr16_b64_v4i16((LAS hx4*)(vb_ + db * 4096 + ks * 1024 + 512)));
                    const hx8 vf = {lo[0], lo[1], lo[2], lo[3], hh[0], hh[1], hh[2], hh[3]};
                    o[db] = __builtin_amdgcn_mfma_f32_32x32x16_bf16(vf, pb[ks], o[db], 0, 0, 0);
                }
        }
        if (more) {
            LAS unsigned char* nb_ = lds + (cur ^ 1) * BUFB;
#pragma unroll
            for (int it = 0; it < NIT; ++it) { const int c = tid + 512 * it;
                if (c < NC) { if (c < NKC) { const int row = c / KCH, ch = c % KCH; *(LAS v4u*)(nb_ + row * KRS + ch * 16) = st[it]; }
                              else { const int c2 = c - NKC, row = c2 >> 3, ch = c2 & 7; *(LAS v4u*)(nb_ + KBYTES + (ch >> 2) * 4096 + row * 64 + (ch & 3) * 16) = st[it]; } } }
        }
        __syncthreads();
        cur ^= 1;
    }
    const float lt = l_run + __shfl_xor(l_run, 32);
    const float inv = fast_rcp(lt);
    bf16* orow = a.O + (long)qpos * a.os;
#pragma unroll
    for (int db = 0; db < 2; ++db)
#pragma unroll
        for (int g = 0; g < 4; ++g) {
            const v2u w = {pk2(o[db][4 * g] * inv, o[db][4 * g + 1] * inv), pk2(o[db][4 * g + 2] * inv, o[db][4 * g + 3] * inv)};
            *(v2u*)(orow + 32 * db + 8 * g + 4 * hi) = w;
        }
    if (WIN) { if (hi == 0) a.L[(long)qpos * a.ls] = m_run + __builtin_amdgcn_logf(lt); }
}

__device__ __forceinline__ void attention_phase(unsigned char* ws, LAS unsigned char* lds) {
    int bx_ = blockIdx.x; asm volatile("" : "+s"(bx_));
    const int G = gridDim.x, c = bx_;
    const float* cosM = (const float*)(ws + OFF_TAB); const float* sinM = cosM + (size_t)T * 16;
    bf16* XN = (bf16*)(ws + OFF_XN); bf16* Fb = (bf16*)(ws + OFF_F); float* LSE = (float*)(ws + OFF_LSE);
    const bf16* Z = (const bf16*)(ws + OFF_HID); const bf16* Qb = (const bf16*)(ws + OFF_Q);
    const bf16* Kc = (const bf16*)(ws + OFF_KCAT); const bf16* Vm = (const bf16*)(ws + OFF_V);
    for (int pi = c; pi < 512; pi += G) {
        const int bh = pi >> 4, s = pi & 15, b = bh >> 3, h = bh & 7;
        const size_t tok0 = (size_t)b * SEQ;
        AttnArgs a;
        a.Q = Qb + tok0 * 768 + h * 96; a.qs = 768; a.K = Kc + tok0 * 768 + h * 96; a.ks = 768; a.V = Vm + tok0 * 512 + h * 64; a.vs = 512;
        a.O = XN + tok0 * D + h * 64; a.os = D; a.L = nullptr; a.ls = 0; a.cosT = cosM + tok0 * 16; a.sinT = sinM + tok0 * 16;
        a.c = 0.10206207261596577f * 1.4426950408889634f;
        for (int half = 0; half < 2; ++half) { a.q0 = half ? 256 * s : 256 * (31 - s); attn_unit<96, false>(lds, a); }
    }
    for (int u = c; u < 3072; u += G) {
        const int br = u >> 10, rem = u & 1023, b = rem >> 8, h = (rem >> 5) & 7, idx = rem & 31;
        const int dil = (br == 0) ? 1 : (br == 1 ? 4 : 16); const int nsub = 32 / dil; const int r = idx / nsub, n = idx % nsub;
        const size_t tok0 = (size_t)b * SEQ + r;
        AttnArgs a;
        a.Q = Z + tok0 * NINP + 416 + h * 64; a.qs = NINP * dil; a.K = Z + tok0 * NINP + 928 + h * 64; a.ks = a.qs; a.V = Z + tok0 * NINP + 1440 + h * 64; a.vs = a.qs;
        if (br < 2) { a.O = Fb + (size_t)br * T * 512 + tok0 * 512 + h * 64; a.os = 512 * dil; }
        else { a.O = XN + tok0 * D + 512 + h * 64; a.os = D * dil; }
        a.L = LSE + (size_t)br * T * 8 + tok0 * 8 + h; a.ls = 8 * dil; a.cosT = nullptr; a.sinT = nullptr;
        a.c = 0.125f * 1.4426950408889634f; a.q0 = 256 * n;
        attn_unit<64, true>(lds, a);
    }
}

#ifdef NO_GEMM
#define GEMM_PHASE(EPI, Aptr, Bptr, Nn, Kk, Eobj) do { (void)(Eobj); } while (0)
#else
#define GEMM_PHASE(EPI, Aptr, Bptr, Nn, Kk, Eobj) do { int bx_ = blockIdx.x; asm volatile("" : "+s"(bx_)); pg8::Gemm g_{(const pg8::bf16_t*)(Aptr), (const pg8::bf16_t*)(Bptr), T, (Nn), (Kk)}; pg8::StaticOrder S_; S_.init(T, (Nn), (int)gridDim.x, bx_); \
    pg8::gemm_phase<EPI, pg8::StaticOrder, true, true>(lds, g_, S_, (Eobj)); } while (0)
#endif
#define PH_IDS int tid = threadIdx.x; asm volatile("" : "+v"(tid)); const int lane = tid & 63, wave = __builtin_amdgcn_readfirstlane(tid >> 6); int bxp = blockIdx.x; asm volatile("" : "+s"(bxp)); \
    const int gw = bxp * 8 + wave, NGW = gridDim.x * 8, gtid = bxp * NTHREADS + tid, NT = gridDim.x * NTHREADS; (void)lane; (void)gw; (void)NGW; (void)gtid; (void)NT;
#define GASP(T_, p_) ((T_*)(__attribute__((address_space(1))) T_*)(p_))
#define PH_WS unsigned char* ws = P.ws;
#define WP(off) ((bf16*)(ws + (off)))
#define WBP(eoff) ((bf16*)(ws + OFF_WB) + (eoff))

__global__ void __launch_bounds__(NTHREADS, 2) mega_fwd(Params Pk) {
    Params P;
#pragma unroll
    for (int i = 0; i < 16; ++i) P.in[i] = GASP(const float, Pk.in[i]);
    P.out = GASP(float, Pk.out); P.ws = GASP(unsigned char, Pk.ws);
    extern __shared__ __attribute__((aligned(16))) unsigned char lds_raw[];
    LAS unsigned char* lds = (LAS unsigned char*)lds_raw;
    cg::grid_group grid = cg::this_grid();

    { PH_IDS PH_WS
      convert_weights(P, ws, 0, lds, gw, NGW, wave, lane);
      rope_tables(P, ws, gtid, NT);
      resnorm_rows<false>(P.in[0], P.out, nullptr, 0.f, nullptr, P.in[3], WP(OFF_XN), gw, NGW, lane); }
    grid.sync();

    { const int layer = 0;
        { PH_WS pg8::EpiSwiglu E{WP(OFF_HID), FF}; GEMM_PHASE(pg8::EpiSwiglu, WP(OFF_XN), WBP(WE_FIN_A), 2 * FF, D, E); }
        grid.sync();
        { PH_WS pg8::EpiBf16<0> E{WP(OFF_F), D, nullptr, 0, 0, 1.f}; GEMM_PHASE(pg8::EpiBf16<0>, WP(OFF_HID), WBP(WE_FDN_A), D, FF, E); }
        grid.sync();
        { PH_IDS PH_WS const float* gains = P.in[3] + (size_t)layer * 8 * D;
          resnorm_rows<true>(P.out, P.out, WP(OFF_F), 0.5f, gains + 1 * D, gains + 2 * D, WP(OFF_XN), gw, NGW, lane); }
        grid.sync();
        { PH_WS pg8::EpiBf16<0> E{WP(OFF_HID), NINP, nullptr, 0, 0, 1.f}; GEMM_PHASE(pg8::EpiBf16<0>, WP(OFF_XN), WBP(WE_IN), NINP, D, E); }
        grid.sync();
        { PH_IDS PH_WS mixer_prep_rows(P, ws, layer, gw, NGW, lane); }
        grid.sync();
        { PH_WS pg8::EpiQKV E{WP(OFF_Q), WP(OFF_KCAT), WP(OFF_V)}; int kq_ = 384; asm volatile("" : "+s"(kq_)); GEMM_PHASE(pg8::EpiQKV, WP(OFF_QLN), WBP(WE_QUP), 1792, kq_, E); }
        grid.sync();
#ifndef NO_ATTN
        { PH_WS attention_phase(ws, lds); }
#endif
        grid.sync();
        { PH_IDS PH_WS merge_rows(P, ws, layer, gw, NGW, lane); }
        grid.sync();
        { PH_WS pg8::EpiBf16<0> E{WP(OFF_F), D, nullptr, 0, 0, 1.f}; GEMM_PHASE(pg8::EpiBf16<0>, WP(OFF_XN), WBP(WE_OUT), D, D, E); }
        grid.sync();
        { PH_IDS PH_WS const float* gains = P.in[3] + (size_t)layer * 8 * D;
          resnorm_rows<true>(P.out, P.out, WP(OFF_F), 1.0f, gains + 3 * D, gains + 4 * D, WP(OFF_XN), gw, NGW, lane);
          convert_p(P, ws, layer, gtid, NT); }
        grid.sync();
        { PH_WS pg8::EpiSwiglu E{WP(OFF_HID), FF}; GEMM_PHASE(pg8::EpiSwiglu, WP(OFF_XN), WBP(WE_FIN_B), 2 * FF, D, E); }
        grid.sync();
        { PH_WS pg8::EpiBf16<0> E{WP(OFF_F), D, nullptr, 0, 0, 1.f}; GEMM_PHASE(pg8::EpiBf16<0>, WP(OFF_HID), WBP(WE_FDN_B), D, FF, E); }
        grid.sync();
        { PH_IDS PH_WS const float* gains = P.in[3] + (size_t)layer * 8 * D;
          resnorm_rows<true>(P.out, P.out, WP(OFF_F), 0.5f, gains + 5 * D, gains + 6 * D, WP(OFF_XN), gw, NGW, lane); }
        { PH_WS pg8::EpiBf16<0> E{WP(OFF_HID), D, nullptr, 0, 0, 1.f}; GEMM_PHASE(pg8::EpiBf16<0>, WP(OFF_QLN), WBP(WE_PLE), D, PLE, E); }
        grid.sync();
        { PH_WS pg8::EpiGate E{WP(OFF_F), WP(OFF_HID), D}; GEMM_PHASE(pg8::EpiGate, WP(OFF_XN), WBP(WE_PG), D, D, E); }
        grid.sync();
        { PH_IDS PH_WS const float* gains = P.in[3] + (size_t)layer * 8 * D;
          resnorm_rows<true>(P.out, P.out, WP(OFF_F), 1.0f, gains + 7 * D, P.in[3] + (size_t)((layer + 1) & 1) * 8 * D, WP(OFF_XN), gw, NGW, lane);
          if (layer == 0) convert_weights(P, ws, 1, lds, gw, NGW, wave, lane); }
        if (layer == 0) grid.sync();
    }
    { const int layer = 1;
        { PH_WS pg8::EpiSwiglu E{WP(OFF_HID), FF}; GEMM_PHASE(pg8::EpiSwiglu, WP(OFF_XN), WBP(WE_FIN_A), 2 * FF, D, E); }
        grid.sync();
        { PH_WS pg8::EpiBf16<0> E{WP(OFF_F), D, nullptr, 0, 0, 1.f}; GEMM_PHASE(pg8::EpiBf16<0>, WP(OFF_HID), WBP(WE_FDN_A), D, FF, E); }
        grid.sync();
        { PH_IDS PH_WS const float* gains = P.in[3] + (size_t)layer * 8 * D;
          resnorm_rows<true>(P.out, P.out, WP(OFF_F), 0.5f, gains + 1 * D, gains + 2 * D, WP(OFF_XN), gw, NGW, lane); }
        grid.sync();
        { PH_WS pg8::EpiBf16<0> E{WP(OFF_HID), NINP, nullptr, 0, 0, 1.f}; GEMM_PHASE(pg8::EpiBf16<0>, WP(OFF_XN), WBP(WE_IN), NINP, D, E); }
        grid.sync();
        { PH_IDS PH_WS mixer_prep_rows(P, ws, layer, gw, NGW, lane); }
        grid.sync();
        { PH_WS pg8::EpiQKV E{WP(OFF_Q), WP(OFF_KCAT), WP(OFF_V)}; int kq_ = 384; asm volatile("" : "+s"(kq_)); GEMM_PHASE(pg8::EpiQKV, WP(OFF_QLN), WBP(WE_QUP), 1792, kq_, E); }
        grid.sync();
#ifndef NO_ATTN
        { PH_WS attention_phase(ws, lds); }
#endif
        grid.sync();
        { PH_IDS PH_WS merge_rows(P, ws, layer, gw, NGW, lane); }
        grid.sync();
        { PH_WS pg8::EpiBf16<0> E{WP(OFF_F), D, nullptr, 0, 0, 1.f}; GEMM_PHASE(pg8::EpiBf16<0>, WP(OFF_XN), WBP(WE_OUT), D, D, E); }
        grid.sync();
        { PH_IDS PH_WS const float* gains = P.in[3] + (size_t)layer * 8 * D;
          resnorm_rows<true>(P.out, P.out, WP(OFF_F), 1.0f, gains + 3 * D, gains + 4 * D, WP(OFF_XN), gw, NGW, lane);
          convert_p(P, ws, layer, gtid, NT); }
        grid.sync();
        { PH_WS pg8::EpiSwiglu E{WP(OFF_HID), FF}; GEMM_PHASE(pg8::EpiSwiglu, WP(OFF_XN), WBP(WE_FIN_B), 2 * FF, D, E); }
        grid.sync();
        { PH_WS pg8::EpiBf16<0> E{WP(OFF_F), D, nullptr, 0, 0, 1.f}; GEMM_PHASE(pg8::EpiBf16<0>, WP(OFF_HID), WBP(WE_FDN_B), D, FF, E); }
        grid.sync();
        { PH_IDS PH_WS const float* gains = P.in[3] + (size_t)layer * 8 * D;
          resnorm_rows<true>(P.out, P.out, WP(OFF_F), 0.5f, gains + 5 * D, gains + 6 * D, WP(OFF_XN), gw, NGW, lane); }
        { PH_WS pg8::EpiBf16<0> E{WP(OFF_HID), D, nullptr, 0, 0, 1.f}; GEMM_PHASE(pg8::EpiBf16<0>, WP(OFF_QLN), WBP(WE_PLE), D, PLE, E); }
        grid.sync();
        { PH_WS pg8::EpiGate E{WP(OFF_F), WP(OFF_HID), D}; GEMM_PHASE(pg8::EpiGate, WP(OFF_XN), WBP(WE_PG), D, D, E); }
        grid.sync();
        { PH_IDS PH_WS const float* gains = P.in[3] + (size_t)layer * 8 * D;
          resnorm_rows<true>(P.out, P.out, WP(OFF_F), 1.0f, gains + 7 * D, P.in[3] + (size_t)((layer + 1) & 1) * 8 * D, WP(OFF_XN), gw, NGW, lane);
          if (layer == 0) convert_weights(P, ws, 1, lds, gw, NGW, wave, lane); }
        if (layer == 0) grid.sync();
    }
}

extern "C" void kernel_launch(void* const* d_in, const int* in_sizes, int n_in, void* d_out, int out_size, void* d_ws, size_t ws_size, hipStream_t stream) {
    static int grid = 0;
    if (grid == 0) {
        if (n_in != 16 || out_size != T * D || ws_size < WS_NEED) { fprintf(stderr, "kernel_launch: unexpected shapes (n_in %d out %d ws %zu)\n", n_in, out_size, ws_size); grid = -1; return; }
        int dev = 0, cus = 0, per_cu = 0;
        hipGetDevice(&dev); hipDeviceGetAttribute(&cus, hipDeviceAttributeMultiprocessorCount, dev);
        hipFuncSetAttribute((const void*)mega_fwd, hipFuncAttributeMaxDynamicSharedMemorySize, LDS_BYTES);
        hipOccupancyMaxActiveBlocksPerMultiprocessor(&per_cu, (const void*)mega_fwd, NTHREADS, LDS_BYTES);
        (void)hipGetLastError();
        if (per_cu < 1) fprintf(stderr, "kernel_launch: occupancy query says %d\n", per_cu);
        grid = cus;
    }
    if (grid < 0) return;
    Params p{};
    for (int i = 0; i < 16; ++i) p.in[i] = (const float*)d_in[i];
    p.out = (float*)d_out; p.ws = (unsigned char*)d_ws;
    void* args[] = {&p};
    hipError_t e = hipLaunchCooperativeKernel((const void*)mega_fwd, dim3(grid), dim3(NTHREADS), args, LDS_BYTES, stream);
    if (e != hipSuccess) fprintf(stderr, "cooperative launch failed: %s (grid %d)\n", hipGetErrorString(e), grid);
}
```

```cpp
#include <hip/hip_runtime.h>
#include <hip/hip_cooperative_groups.h>
#include <cstdio>
#include <cstdint>
#include <cmath>
namespace cg = cooperative_groups;
namespace pg8 {
#define PG8_LAS __attribute__((address_space(3)))
typedef unsigned short bf16_t;
typedef short bf16x8 __attribute__((ext_vector_type(8)));
typedef float f32x4 __attribute__((ext_vector_type(4)));
typedef unsigned u32x4 __attribute__((ext_vector_type(4)));
constexpr int BM = 256, BK = 64, HALF = 128, HTB = HALF * BK * 2  , STAGE_BYTES = 8 * HTB, NXCD = 8, WGM = 8;

__host__ __device__ __forceinline__ int lds_byte(int r, int c) { const int st = (r >> 4) * 2 + (c >> 5), rr = r & 15, cc = c & 31, ob = rr * 64 + cc * 2; return st * 1024 + (ob ^ (((ob >> 9) & 1) << 5)); }
__host__ __device__ __forceinline__ void stage_rc(int b, int& R, int& C) { const int st = b / 1024, sb = b % 1024, swz = sb ^ (((sb >> 9) & 1) << 5); R = (st >> 1) * 16 + swz / 64; C = (st & 1) * 32 + (swz % 64) / 2; }
__host__ __device__ __forceinline__ int perm32(int rho) { const int n = rho >> 4, i = rho & 15; return 8 * (i >> 2) + 4 * n + (i & 3); }

struct Unit { int pm, pn; };
struct Gemm { const bf16_t* A; const bf16_t* Bt; int M, N, K; };

struct StaticOrder {
    int nM, nN, nwg, G, c;
    __host__ __device__ void init(int M, int N, int G_, int c_) { nM = M / BM; nN = N / BM; nwg = nM * nN; G = G_; c = c_; }
    __host__ __device__ bool next(int i, Unit& u) const {
        const long L = (long)i * G + c; if (L >= nwg) return false;
        int wgid = (int)L; { const int q = nwg / NXCD, r = nwg % NXCD, xcd = wgid % NXCD, off = wgid / NXCD; wgid = (xcd < r ? xcd * (q + 1) : r * (q + 1) + (xcd - r) * q) + off; }
        const int nig = WGM * nN, gid = wgid / nig, fm = gid * WGM, gsz = (nM - fm) < WGM ? (nM - fm) : WGM;
        u.pm = fm + ((wgid % nig) % gsz); u.pn = (wgid % nig) / gsz; return true;
    }
    __device__ __forceinline__ void a_ready(const Unit&) const {}
    __device__ __forceinline__ void done(const Unit&) const {}
};

__device__ __forceinline__ unsigned cvt_pk_bf16(float lo, float hi) { unsigned r; asm volatile("v_cvt_pk_bf16_f32 %0, %1, %2" : "=v"(r) : "v"(lo), "v"(hi)); return r; }
typedef float f32x2 __attribute__((ext_vector_type(2)));
__device__ __forceinline__ f32x2 gelu_pk(f32x2 v) {
    const f32x2 av = __builtin_elementwise_abs(v), d = av * 0.2316418882f + 1.0f;
    f32x2 t; t.x = __builtin_amdgcn_rcpf(d.x); t.y = __builtin_amdgcn_rcpf(d.y);
    f32x2 q = t * 0.5307027145f + (-0.7265760135f); q = q * t + 0.7107068705f; q = q * t + (-0.142248368f); q = q * t + 0.127414796f; q = q * t;
    const f32x2 s = (v * v) * (-0.72134752044f);
    f32x2 e; e.x = __builtin_amdgcn_exp2f(s.x); e.y = __builtin_amdgcn_exp2f(s.y);
    const f32x2 m = v * (q * e), r = v - m;
    f32x2 o; o.x = v.x < 0.f ? m.x : r.x; o.y = v.y < 0.f ? m.y : r.y; return o;
}

template <int ACT  > struct EpiBf16 {
    static constexpr bool PERM = true, AFTER_DRAIN = false; static_assert(ACT == 0 || ACT == 1, "EpiBf16: ACT is 0 (none) or 1 (gelu_pk)");
    bf16_t* O; int ldc; const float* bias; int split_cols; size_t split_stride; float scale0;
    __device__ __forceinline__ void operator()(const f32x4 (&acc)[2][2][4][2], const Unit& u, int wr, int wc, int fr, int fq) const {
        const int row0 = u.pm * BM + wr * 64 + fr; int colt = u.pn * BM; bf16_t* base = O;
        float sc = 1.f; if (split_cols) { const int t = colt / split_cols; base += (size_t)t * split_stride; colt -= t * split_cols; if (t == 0) sc = scale0; }
        const int col0 = colt + wc * 32 + 8 * fq, bcol0 = u.pn * BM + wc * 32 + 8 * fq;
        f32x4 bv[2][2];
#pragma unroll
        for (int bj = 0; bj < 2; ++bj)
#pragma unroll
            for (int n = 0; n < 2; ++n) bv[bj][n] = bias ? *(const f32x4*)(bias + bcol0 + bj * HALF + 4 * n) : (f32x4){0.f, 0.f, 0.f, 0.f};
#pragma unroll
        for (int ai = 0; ai < 2; ++ai)
#pragma unroll
            for (int m = 0; m < 4; ++m) { bf16_t* rowp = base + (size_t)(row0 + ai * HALF + m * 16) * ldc + col0;
#pragma unroll
                for (int bj = 0; bj < 2; ++bj) { f32x4 v0 = acc[ai][bj][m][0] + bv[bj][0], v1 = acc[ai][bj][m][1] + bv[bj][1];
                    if (ACT == 1) { f32x2 a = gelu_pk((f32x2){v0[0], v0[1]}), b = gelu_pk((f32x2){v0[2], v0[3]}), c = gelu_pk((f32x2){v1[0], v1[1]}), d = gelu_pk((f32x2){v1[2], v1[3]});
                        v0 = (f32x4){a.x, a.y, b.x, b.y}; v1 = (f32x4){c.x, c.y, d.x, d.y}; }
                    v0 = v0 * sc; v1 = v1 * sc; u32x4 w; w.x = cvt_pk_bf16(v0[0], v0[1]); w.y = cvt_pk_bf16(v0[2], v0[3]); w.z = cvt_pk_bf16(v1[0], v1[1]); w.w = cvt_pk_bf16(v1[2], v1[3]);
                    *(u32x4*)(rowp + bj * HALF) = w; } }
    }
};

template <class Epi, class Sched, bool ALIGN_EPI = false, bool SP2 = false>
__device__ __forceinline__ void gemm_phase(PG8_LAS unsigned char* lds, const Gemm g, const Sched& S, const Epi& E) {
    int tid_ = threadIdx.x; asm volatile("" : "+v"(tid_));
    const int tid = tid_, wid = __builtin_amdgcn_readfirstlane(tid >> 6), lane = tid & 63, wr = wid >> 2, wc = wid & 3, fr = lane & 15, fq = lane >> 4;
    const int K = g.K, nt = K / BK;
    unsigned voffA[2], voffB[2];
#pragma unroll
    for (int i = 0; i < 2; ++i) { int R, C; stage_rc(tid * 16 + i * 8192, R, C); const int Rb = Epi::PERM ? ((R & ~31) + perm32(R & 31)) : R;
        voffA[i] = (unsigned)(R * K + C) * 2u; voffB[i] = (unsigned)(Rb * K + C) * 2u; }
    const size_t kstep = (size_t)(BK * 2);
    const size_t hstep = (size_t)HALF * K * 2;
    const size_t tstep = 2 * hstep;
    const unsigned ldsw = (unsigned)wid * 1024u;
    const int aoff = lds_byte(wr * 64 + fr, fq * 8), boff = lds_byte(wc * 32 + fr, fq * 8);
#define PG8_SA(b, h) (((b) * 2 + (h)) * HTB)
#define PG8_SB(b, h) ((4 + (b) * 2 + (h)) * HTB)
#define PG8_STAGE(bufoff, gbase, voff) do { _Pragma("unroll") for (int _i = 0; _i < 2; ++_i) \
        __builtin_amdgcn_global_load_lds((const unsigned*)((const char*)(gbase) + (voff)[_i]), (PG8_LAS unsigned*)(lds + (bufoff) + ldsw + _i * 8192), 16, 0, 0); } while (0)
#define PG8_LDA(dst, b, h) do { _Pragma("unroll") for (int m = 0; m < 4; ++m) _Pragma("unroll") for (int k = 0; k < 2; ++k) dst[m][k] = *(const PG8_LAS bf16x8*)(lds + PG8_SA(b, h) + aoff + m * 2048 + k * 1024); } while (0)
#define PG8_LDB(dst, b, h) do { _Pragma("unroll") for (int n = 0; n < 2; ++n) _Pragma("unroll") for (int k = 0; k < 2; ++k) dst[n][k] = *(const PG8_LAS bf16x8*)(lds + PG8_SB(b, h) + boff + n * 2048 + k * 1024); } while (0)
#define PG8_MMA(ai, bj, At, Bt) do { __builtin_amdgcn_s_setprio(1); _Pragma("unroll") for (int m = 0; m < 4; ++m) _Pragma("unroll") for (int n = 0; n < 2; ++n) _Pragma("unroll") for (int k = 0; k < 2; ++k) \
        acc[ai][bj][m][n] = __builtin_amdgcn_mfma_f32_16x16x32_bf16(Bt[n][k], At[m][k], acc[ai][bj][m][n], 0, 0, 0); __builtin_amdgcn_s_setprio(0); } while (0)
#define PG8_WAIT_V(n) asm volatile("s_waitcnt vmcnt(" #n ")" ::: "memory")
#define PG8_WAIT_L(n) asm volatile("s_waitcnt lgkmcnt(" #n ")" ::: "memory")
#define PG8_BAR __builtin_amdgcn_s_barrier()
#define PG8_SCHED __builtin_amdgcn_sched_barrier(0)
    float zf_ = 0.f; asm volatile("" : "+v"(zf_)); const f32x4 zero4_ = {zf_, zf_, zf_, zf_};
    Unit cur, nxt; int ui = 0;
    if (!S.next(0, cur)) return;
    f32x4 acc[2][2][4][2];
#pragma unroll
    for (int a = 0; a < 2; ++a)
#pragma unroll
        for (int b = 0; b < 2; ++b)
#pragma unroll
            for (int m = 0; m < 4; ++m)
#pragma unroll
                for (int n = 0; n < 2; ++n) acc[a][b][m][n] = zero4_;
    bf16x8 At[4][2], B0[2][2], B1[2][2];
    const char* cA = (const char*)g.A + (size_t)cur.pm * tstep; const char* cB = (const char*)g.Bt + (size_t)cur.pn * tstep;
    S.a_ready(cur);
    if constexpr (SP2) {
        PG8_STAGE(PG8_SB(0, 0), cB, voffB); PG8_STAGE(PG8_SB(0, 1), cB + hstep, voffB); PG8_STAGE(PG8_SA(0, 0), cA, voffA); PG8_STAGE(PG8_SA(0, 1), cA + hstep, voffA);
        if (wr == 1) PG8_BAR;
        PG8_WAIT_V(2); PG8_BAR;
        PG8_STAGE(PG8_SB(1, 0), cB + kstep, voffB); PG8_STAGE(PG8_SA(1, 0), cA + kstep, voffA); PG8_STAGE(PG8_SB(1, 1), cB + hstep + kstep, voffB);
        PG8_WAIT_V(6); PG8_BAR;
    } else {
        PG8_STAGE(PG8_SB(0, 0), cB, voffB); PG8_STAGE(PG8_SA(0, 0), cA, voffA); PG8_STAGE(PG8_SB(0, 1), cB + hstep, voffB); PG8_STAGE(PG8_SA(0, 1), cA + hstep, voffA);
        if (wr == 1) PG8_BAR;
        PG8_WAIT_V(4); PG8_BAR;
        PG8_STAGE(PG8_SB(1, 0), cB + kstep, voffB); PG8_STAGE(PG8_SA(1, 0), cA + kstep, voffA); PG8_STAGE(PG8_SB(1, 1), cB + hstep + kstep, voffB);
        PG8_WAIT_V(6); PG8_BAR;
    }
    for (;;) {
        const bool has_next = S.next(ui + 1, nxt);
        const char* nA = has_next ? (const char*)g.A + (size_t)nxt.pm * tstep : cA; const char* nB = has_next ? (const char*)g.Bt + (size_t)nxt.pn * tstep : cB;
        for (int t = 0; t < nt; t += 2) {
            const bool last = (t == nt - 2);
            const char* a1 = cA + (size_t)(t + 1) * kstep;
            const char* a2 = last ? nA : cA + (size_t)(t + 2) * kstep; const char* b2 = last ? nB : cB + (size_t)(t + 2) * kstep;
            const char* a3 = a2 + kstep; const char* b3 = b2 + kstep;
            if (last && has_next) S.a_ready(nxt);
            if constexpr (SP2) {
            PG8_LDB(B0, 0, 0); PG8_LDB(B1, 0, 1); PG8_SCHED; PG8_LDA(At, 0, 0); PG8_STAGE(PG8_SA(1, 1), a1 + hstep, voffA);
            PG8_WAIT_V(8); PG8_WAIT_L(0); PG8_BAR; PG8_MMA(0, 0, At, B0); PG8_MMA(0, 1, At, B1); PG8_BAR; PG8_SCHED;
            PG8_LDA(At, 0, 1); PG8_STAGE(PG8_SB(0, 0), b2, voffB); PG8_STAGE(PG8_SB(0, 1), b2 + hstep, voffB); PG8_STAGE(PG8_SA(0, 0), a2, voffA);
            PG8_WAIT_V(8); PG8_WAIT_L(0); PG8_BAR; PG8_MMA(1, 0, At, B0); PG8_MMA(1, 1, At, B1); PG8_BAR; PG8_SCHED;
            PG8_LDB(B0, 1, 0); PG8_LDB(B1, 1, 1); PG8_SCHED; PG8_LDA(At, 1, 0); PG8_STAGE(PG8_SA(0, 1), a2 + hstep, voffA);
            PG8_WAIT_V(8); PG8_WAIT_L(0); PG8_BAR; PG8_MMA(0, 0, At, B0); PG8_MMA(0, 1, At, B1); PG8_BAR; PG8_SCHED;
            PG8_LDA(At, 1, 1); PG8_STAGE(PG8_SB(1, 0), b3, voffB); PG8_STAGE(PG8_SB(1, 1), b3 + hstep, voffB); PG8_STAGE(PG8_SA(1, 0), a3, voffA);
            PG8_WAIT_V(8); PG8_WAIT_L(0); PG8_BAR; PG8_MMA(1, 0, At, B0); PG8_MMA(1, 1, At, B1); PG8_BAR; PG8_SCHED;
            } else {
            PG8_LDB(B0, 0, 0); PG8_SCHED; PG8_LDA(At, 0, 0); PG8_STAGE(PG8_SA(1, 1), a1 + hstep, voffA);
            PG8_WAIT_L(8); PG8_BAR; PG8_WAIT_L(0); PG8_MMA(0, 0, At, B0); PG8_BAR; PG8_SCHED;
            PG8_LDB(B1, 0, 1); PG8_STAGE(PG8_SB(0, 0), b2, voffB);
            PG8_BAR; PG8_WAIT_L(0); PG8_MMA(0, 1, At, B1); PG8_BAR;
            PG8_LDA(At, 0, 1); PG8_STAGE(PG8_SA(0, 0), a2, voffA);
            PG8_BAR; PG8_WAIT_L(0); PG8_MMA(1, 0, At, B0); PG8_BAR; PG8_SCHED;
            PG8_STAGE(PG8_SB(0, 1), b2 + hstep, voffB);
            PG8_WAIT_V(6); PG8_BAR; PG8_MMA(1, 1, At, B1); PG8_BAR;
            PG8_LDB(B0, 1, 0); PG8_SCHED; PG8_LDA(At, 1, 0); PG8_STAGE(PG8_SA(0, 1), a2 + hstep, voffA);
            PG8_WAIT_L(8); PG8_BAR; PG8_WAIT_L(0); PG8_MMA(0, 0, At, B0); PG8_BAR; PG8_SCHED;
            PG8_LDB(B1, 1, 1); PG8_STAGE(PG8_SB(1, 0), b3, voffB);
            PG8_BAR; PG8_WAIT_L(0); PG8_MMA(0, 1, At, B1); PG8_BAR;
            PG8_LDA(At, 1, 1); PG8_STAGE(PG8_SA(1, 0), a3, voffA);
            PG8_BAR; PG8_WAIT_L(0); PG8_MMA(1, 0, At, B0); PG8_BAR; PG8_SCHED;
            PG8_STAGE(PG8_SB(1, 1), b3 + hstep, voffB);
            PG8_WAIT_V(6); PG8_BAR; PG8_MMA(1, 1, At, B1); PG8_BAR;
            }
        }
        if constexpr (ALIGN_EPI) { if (wr == 0) PG8_BAR; }
        if constexpr (!Epi::AFTER_DRAIN) { E(acc, cur, wr, wc, fr, fq); S.done(cur); }
        if (!has_next) break;
#pragma unroll
        for (int a = 0; a < 2; ++a)
#pragma unroll
            for (int b = 0; b < 2; ++b)
#pragma unroll
                for (int m = 0; m < 4; ++m)
#pragma unroll
                    for (int n = 0; n < 2; ++n) acc[a][b][m][n] = zero4_;
        cur = nxt; cA = nA; cB = nB; ++ui;
        if constexpr (ALIGN_EPI) { if (wr == 1) PG8_BAR; }
    }
    PG8_WAIT_V(0);
    if constexpr (!ALIGN_EPI) { if (wr == 0) PG8_BAR; }
    PG8_BAR;
    if constexpr (Epi::AFTER_DRAIN) { E.fused(acc, cur, wr, wc, fr, fq, lds, wid, lane); S.done(cur); }
#undef PG8_SA
#undef PG8_SB
#undef PG8_STAGE
#undef PG8_LDA
#undef PG8_LDB
#undef PG8_MMA
#undef PG8_WAIT_V
#undef PG8_WAIT_L
#undef PG8_BAR
#undef PG8_SCHED
}
}

#define LAS __attribute__((address_space(3)))
typedef unsigned short bf16;
typedef unsigned v4u __attribute__((ext_vector_type(4)));
typedef unsigned v2u __attribute__((ext_vector_type(2)));
typedef float fx4 __attribute__((ext_vector_type(4)));
typedef float fx2 __attribute__((ext_vector_type(2)));
typedef float fx16 __attribute__((ext_vector_type(16)));
typedef short hx8 __attribute__((ext_vector_type(8)));
typedef short hx4 __attribute__((ext_vector_type(4)));
typedef __bf16 bfx2_t __attribute__((ext_vector_type(2)));

constexpr int NB = 4, SEQ = 8192, T = NB * SEQ, D = 1024, FF = 2816, NIN = 1952, NINP = 2048, PLE = 256;
constexpr int QL = 256, KVL = 128;
constexpr float EPS = 1e-6f;
constexpr int NTHREADS = 512;
constexpr int LDS_BYTES = 131072 + 1024;

constexpr size_t MiB = 1u << 20;
constexpr size_t OFF_WB = 0;
constexpr size_t OFF_TAB = 48 * MiB;
constexpr size_t OFF_LSE = 60 * MiB;
constexpr size_t OFF_XN = 64 * MiB;
constexpr size_t OFF_F = 128 * MiB;
constexpr size_t OFF_HID = 192 * MiB;
constexpr size_t OFF_Q = OFF_HID + 128 * MiB;
constexpr size_t OFF_KCAT = 368 * MiB;
constexpr size_t OFF_V = 416 * MiB;
constexpr size_t OFF_QLN = 448 * MiB;
constexpr size_t OFF_KVLN = 464 * MiB;
constexpr size_t OFF_BAR = 472 * MiB;
constexpr size_t BAR_BYTES = 16384;
constexpr size_t WS_NEED = 473 * MiB;
constexpr size_t WE_FIN_A = 0;
constexpr size_t WE_FDN_A = WE_FIN_A + (size_t)2 * FF * D;
constexpr size_t WE_FIN_B = WE_FDN_A + (size_t)D * FF;
constexpr size_t WE_FDN_B = WE_FIN_B + (size_t)2 * FF * D;
constexpr size_t WE_IN = WE_FDN_B + (size_t)D * FF;
constexpr size_t WE_QUP = WE_IN + (size_t)NINP * D;
constexpr size_t WE_OUT = WE_QUP + (size_t)1792 * 384;
constexpr size_t WE_PLE = WE_OUT + (size_t)D * D;
constexpr size_t WE_PG = WE_PLE + (size_t)D * PLE;
constexpr size_t WE_END = WE_PG + (size_t)D * D;
static_assert(WE_END * 2 <= 48 * MiB, "weights fit");

__device__ const float INV_M[16] = {1.000000000e+00f, 5.623413324e-01f, 3.162277639e-01f, 1.778279394e-01f, 1.000000015e-01f, 5.623413250e-02f, 3.162277490e-02f, 1.778279431e-02f, 9.999999776e-03f, 5.623413250e-03f, 3.162277630e-03f, 1.778279431e-03f, 1.000000047e-03f, 5.623413017e-04f, 3.162277571e-04f, 1.778279402e-04f};
__device__ const float INV_D[32] = {1.000000000e+00f, 7.498942614e-01f, 5.623413324e-01f, 4.216965139e-01f, 3.162277639e-01f, 2.371373773e-01f, 1.778279394e-01f, 1.333521307e-01f, 1.000000015e-01f, 7.498941571e-02f, 5.623413250e-02f, 4.216965288e-02f, 3.162277490e-02f, 2.371373773e-02f, 1.778279431e-02f, 1.333521493e-02f, 9.999999776e-03f, 7.498941850e-03f, 5.623413250e-03f, 4.216964822e-03f, 3.162277630e-03f, 2.371373586e-03f, 1.778279431e-03f, 1.333521446e-03f, 1.000000047e-03f, 7.498942432e-04f, 5.623413017e-04f, 4.216965172e-04f, 3.162277571e-04f, 2.371373703e-04f, 1.778279402e-04f, 1.333521504e-04f};

struct Params { const float* in[16]; float* out; unsigned char* ws; };

__device__ __forceinline__ unsigned pk2(float lo, float hi) { fx2 v = {lo, hi}; bfx2_t b = __builtin_convertvector(v, bfx2_t); return __builtin_bit_cast(unsigned, b); }
__device__ __forceinline__ float bflo(unsigned u) { return __uint_as_float(u << 16); }
__device__ __forceinline__ float bfhi(unsigned u) { return __uint_as_float(u & 0xffff0000u); }
__device__ __forceinline__ float wave_sum(float v) {
#pragma unroll
    for (int o = 1; o < 64; o <<= 1) v += __shfl_xor(v, o);
    return v;
}
__device__ __forceinline__ float fast_rcp(float x) { return __builtin_amdgcn_rcpf(x); }
__device__ __forceinline__ float fast_exp2(float x) { return __builtin_amdgcn_exp2f(x); }
__device__ __forceinline__ float fast_rsq(float x) { return __builtin_amdgcn_rsqf(x); }

namespace pg8 {
struct EpiSwiglu {
    static constexpr bool PERM = true, AFTER_DRAIN = false;
    bf16_t* O; int ldc;
    __device__ __forceinline__ void operator()(const f32x4 (&acc)[2][2][4][2], const Unit& u, int wr, int wc, int fr, int fq) const {
        const int row0 = u.pm * BM + wr * 64 + fr; const int col0 = u.pn * 128 + wc * 32 + 8 * fq;
#pragma unroll
        for (int ai = 0; ai < 2; ++ai)
#pragma unroll
            for (int m = 0; m < 4; ++m) {
                bf16_t* rowp = O + (size_t)(row0 + ai * HALF + m * 16) * ldc + col0;
                float h[8];
#pragma unroll
                for (int n = 0; n < 2; ++n)
#pragma unroll
                    for (int e = 0; e < 4; ++e) {
                        const float g = acc[ai][0][m][n][e], up = acc[ai][1][m][n][e];
                        const float sg = g * __builtin_amdgcn_rcpf(1.0f + __builtin_amdgcn_exp2f(-1.4426950408889634f * g));
                        h[n * 4 + e] = sg * up;
                    }
                u32x4 w; w.x = ::pk2(h[0], h[1]); w.y = ::pk2(h[2], h[3]); w.z = ::pk2(h[4], h[5]); w.w = ::pk2(h[6], h[7]);
                *(u32x4*)rowp = w;
            }
    }
};
struct EpiQKV {
    static constexpr bool PERM = true, AFTER_DRAIN = false;
    bf16_t* Q; bf16_t* Kc; bf16_t* V;
    __device__ __forceinline__ void operator()(const f32x4 (&acc)[2][2][4][2], const Unit& u, int wr, int wc, int fr, int fq) const {
        const int row0 = u.pm * BM + wr * 64 + fr;
#pragma unroll
        for (int bj = 0; bj < 2; ++bj) {
            bf16_t* ub; int rs;
            if (u.pn < 3) { ub = Q + u.pn * 256 + bj * 128 + wc * 32; rs = 768; }
            else { const int head = 2 * (u.pn - 3) + bj; if (wc < 2) { ub = Kc + head * 96 + wc * 32; rs = 768; } else { ub = V + head * 64 + (wc * 32 - 64); rs = 512; } }
            const unsigned loff = (unsigned)row0 * (unsigned)rs + 8u * (unsigned)fq;
#pragma unroll
            for (int ai = 0; ai < 2; ++ai)
#pragma unroll
                for (int m = 0; m < 4; ++m) {
                    bf16_t* dst = ub + (loff + (unsigned)((ai * HALF + m * 16) * rs));
                    const f32x4 v0 = acc[ai][bj][m][0], v1 = acc[ai][bj][m][1];
                    u32x4 w; w.x = ::pk2(v0[0], v0[1]); w.y = ::pk2(v0[2], v0[3]); w.z = ::pk2(v1[0], v1[1]); w.w = ::pk2(v1[2], v1[3]);
                    *(u32x4*)dst = w;
                }
        }
    }
};
struct EpiGate {
    static constexpr bool PERM = true, AFTER_DRAIN = false;
    bf16_t* O; const bf16_t* PP; int ldc;
    __device__ __forceinline__ void operator()(const f32x4 (&acc)[2][2][4][2], const Unit& u, int wr, int wc, int fr, int fq) const {
        const int row0 = u.pm * BM + wr * 64 + fr; const int col0 = u.pn * BM + wc * 32 + 8 * fq;
#pragma unroll
        for (int ai = 0; ai < 2; ++ai)
#pragma unroll
            for (int m = 0; m < 4; ++m)
#pragma unroll
                for (int bj = 0; bj < 2; ++bj) {
                    const size_t off = (size_t)(row0 + ai * HALF + m * 16) * ldc + col0 + bj * HALF;
                    const u32x4 pv = *(const u32x4*)(PP + off);
                    float pp[8] = {::bflo(pv.x), ::bfhi(pv.x), ::bflo(pv.y), ::bfhi(pv.y), ::bflo(pv.z), ::bfhi(pv.z), ::bflo(pv.w), ::bfhi(pv.w)};
                    float o[8];
#pragma unroll
                    for (int n = 0; n < 2; ++n)
#pragma unroll
                        for (int e = 0; e < 4; ++e) {
                            const float g = acc[ai][bj][m][n][e];
                            o[n * 4 + e] = pp[n * 4 + e] * __builtin_amdgcn_rcpf(1.0f + __builtin_amdgcn_exp2f(-1.4426950408889634f * g));
                        }
                    u32x4 w; w.x = ::pk2(o[0], o[1]); w.y = ::pk2(o[2], o[3]); w.z = ::pk2(o[4], o[5]); w.w = ::pk2(o[6], o[7]);
                    *(u32x4*)(O + off) = w;
                }
    }
};
}

__device__ __forceinline__ void tr_item(const float* W, int K, int N, int k0, int n0, bf16* WT, int drow0, int ldk, int dk, LAS float* scr, int lane) {
#pragma unroll 8
    for (int i = 0; i < 32; ++i) { const int kk = 2 * i + (lane >> 5); scr[kk * 33 + (lane & 31)] = W[(size_t)(k0 + kk) * N + n0 + (lane & 31)]; }
    asm volatile("s_waitcnt lgkmcnt(0)" ::: "memory");
    const int c = lane & 7;
#pragma unroll
    for (int j = 0; j < 4; ++j) { const int n = (lane >> 3) + 8 * j; const LAS float* s = scr + (8 * c) * 33 + n;
        v4u o; o.x = pk2(s[0 * 33], s[1 * 33]); o.y = pk2(s[2 * 33], s[3 * 33]); o.z = pk2(s[4 * 33], s[5 * 33]); o.w = pk2(s[6 * 33], s[7 * 33]);
        *(v4u*)(WT + (size_t)(drow0 + n) * ldk + dk + k0 + 8 * c) = o; }
    asm volatile("s_waitcnt lgkmcnt(0)" ::: "memory");
}
__device__ __forceinline__ void tr_matrix_item(const float* W, int K, int N, bf16* WT, int mode, int item, LAS float* scr, int lane, int ldk = 0, int dk = 0) {
    const int nblk = N / 32, kb = item / nblk, nb = item % nblk, k0 = 64 * kb, n0 = 32 * nb;
    int drow0 = n0;
    if (mode != 0) drow0 = 256 * (n0 >> 7) + (n0 & 127) + (mode == 2 ? 128 : 0);
    tr_item(W, K, N, k0, n0, WT, drow0, ldk ? ldk : K, dk, scr, lane);
}
__device__ __forceinline__ void convert_weights(const Params& P, unsigned char* ws, int layer, LAS unsigned char* lds, int gw, int NGW, int wave, int lane) {
    LAS float* scr = (LAS float*)(lds + wave * 16384);
    bf16* WB = (bf16*)(ws + OFF_WB);
    const float* w_in = P.in[4] + (size_t)layer * D * NIN;
    const float* w_qup = P.in[6] + (size_t)layer * QL * 768;
    const float* w_kvup = P.in[8] + (size_t)layer * KVL * 1024;
    const float* w_out = P.in[10] + (size_t)layer * D * D;
    const float* fg = P.in[11] + (size_t)layer * 2 * D * FF;
    const float* fu = P.in[12] + (size_t)layer * 2 * D * FF;
    const float* fd = P.in[13] + (size_t)layer * 2 * FF * D;
    const float* w_ple = P.in[14] + (size_t)layer * PLE * D;
    const float* w_pg = P.in[15] + (size_t)layer * D * D;
    constexpr int I_FIN = (D / 64) * (FF / 32);
    constexpr int I_FDN = (FF / 64) * (D / 32);
    constexpr int I_IN = (D / 64) * (NIN / 32);
    constexpr int I_QUP = (QL / 64) * (768 / 32);
    constexpr int I_KVUP = (KVL / 64) * (1024 / 32);
    constexpr int I_DD = (D / 64) * (D / 32);
    constexpr int I_PLE = (PLE / 64) * (D / 32);
    constexpr int NITEMS = 4 * I_FIN + 2 * I_FDN + I_IN + I_QUP + I_KVUP + 2 * I_DD + I_PLE;
    for (int it = gw; it < NITEMS; it += NGW) {
        int r = it;
        if (r < I_FIN) { tr_matrix_item(fg, D, FF, WB + WE_FIN_A, 1, r, scr, lane); continue; } r -= I_FIN;
        if (r < I_FIN) { tr_matrix_item(fu, D, FF, WB + WE_FIN_A, 2, r, scr, lane); continue; } r -= I_FIN;
        if (r < I_FIN) { tr_matrix_item(fg + (size_t)D * FF, D, FF, WB + WE_FIN_B, 1, r, scr, lane); continue; } r -= I_FIN;
        if (r < I_FIN) { tr_matrix_item(fu + (size_t)D * FF, D, FF, WB + WE_FIN_B, 2, r, scr, lane); continue; } r -= I_FIN;
        if (r < I_FDN) { tr_matrix_item(fd, FF, D, WB + WE_FDN_A, 0, r, scr, lane); continue; } r -= I_FDN;
        if (r < I_FDN) { tr_matrix_item(fd + (size_t)FF * D, FF, D, WB + WE_FDN_B, 0, r, scr, lane); continue; } r -= I_FDN;
        if (r < I_IN) { tr_matrix_item(w_in, D, NIN, WB + WE_IN, 0, r, scr, lane); continue; } r -= I_IN;
        if (r < I_QUP) { tr_matrix_item(w_qup, QL, 768, WB + WE_QUP, 0, r, scr, lane, 384, 0); continue; } r -= I_QUP;
        if (r < I_KVUP) { tr_matrix_item(w_kvup, KVL, 1024, WB + WE_QUP + (size_t)768 * 384, 0, r, scr, lane, 384, 256); continue; } r -= I_KVUP;
        if (r < I_DD) { tr_matrix_item(w_out, D, D, WB + WE_OUT, 0, r, scr, lane); continue; } r -= I_DD;
        if (r < I_PLE) { tr_matrix_item(w_ple, PLE, D, WB + WE_PLE, 0, r, scr, lane); continue; } r -= I_PLE;
        tr_matrix_item(w_pg, D, D, WB + WE_PG, 0, r, scr, lane);
    }
    {
        v4u* qk = (v4u*)(WB + WE_QUP); unsigned z0_ = 0u; asm volatile("" : "+v"(z0_)); const v4u z = {z0_, z0_, z0_, z0_};
        const int gt = gw * 64 + lane, NTT = NGW * 64;
        for (int i = gt; i < 768 * 16; i += NTT) { const int row = i >> 4, ch = i & 15; qk[(size_t)row * 48 + 32 + ch] = z; }
        for (int i = gt; i < 1024 * 32; i += NTT) { const int row = 768 + (i >> 5), ch = i & 31; qk[(size_t)row * 48 + ch] = z; }
    }
}

__device__ __forceinline__ void rope_tables(const Params& P, unsigned char* ws, int gtid, int NT) {
    const int* pos = (const int*)P.in[2];
    float* cosM = (float*)(ws + OFF_TAB); float* sinM = cosM + (size_t)T * 16; float* cosD = sinM + (size_t)T * 16; float* sinD = cosD + (size_t)T * 32;
    for (int e = gtid; e < T * 48; e += NT) {
        const int tok = e / 48, i = e % 48;
        const float inv = (i < 16) ? INV_M[i] : INV_D[i - 16];
        const float ang = (float)pos[tok] * inv;
        double tt = (double)ang * 0.15915494309189535; tt -= __builtin_rint(tt);
        const float rev = (float)tt;
        const float c = __builtin_amdgcn_cosf(rev), s = __builtin_amdgcn_sinf(rev);
        if (i < 16) { cosM[(size_t)tok * 16 + i] = c; sinM[(size_t)tok * 16 + i] = s; }
        else { cosD[(size_t)tok * 32 + i - 16] = c; sinD[(size_t)tok * 32 + i - 16] = s; }
    }
}

template <bool HAS_F>
__device__ __forceinline__ void resnorm_rows(const float* hin, float* hout, const bf16* f, float alpha, const float* ga, const float* gb, bf16* xn, int gw, int NGW, int lane) {
    for (int m = gw; m < T; m += NGW) {
        const fx4* hr = (const fx4*)(hin + (size_t)m * D) + lane;
        fx4 hv[4];
#pragma unroll
        for (int j = 0; j < 4; ++j) hv[j] = hr[64 * j];
        if (HAS_F) {
            const v2u* fr = (const v2u*)(f + (size_t)m * D) + lane;
            fx4 fv[4]; float ss = 0.f;
#pragma unroll
            for (int j = 0; j < 4; ++j) { const v2u w = fr[64 * j]; fv[j] = (fx4){bflo(w.x), bfhi(w.x), bflo(w.y), bfhi(w.y)}; ss += (fv[j].x * fv[j].x + fv[j].y * fv[j].y) + (fv[j].z * fv[j].z + fv[j].w * fv[j].w); }
            const float rstd = fast_rsq(wave_sum(ss) * (1.0f / D) + EPS) * alpha;
            fx4* ho = (fx4*)(hout + (size_t)m * D) + lane;
#pragma unroll
            for (int j = 0; j < 4; ++j) { const fx4 g = ((const fx4*)ga)[lane + 64 * j]; hv[j] = hv[j] + fv[j] * g * rstd; ho[64 * j] = hv[j]; }
        } else {
            fx4* ho = (fx4*)(hout + (size_t)m * D) + lane;
#pragma unroll
            for (int j = 0; j < 4; ++j) ho[64 * j] = hv[j];
        }
        float s2 = 0.f;
#pragma unroll
        for (int j = 0; j < 4; ++j) s2 += (hv[j].x * hv[j].x + hv[j].y * hv[j].y) + (hv[j].z * hv[j].z + hv[j].w * hv[j].w);
        const float rstd2 = fast_rsq(wave_sum(s2) * (1.0f / D) + EPS);
        v2u* xo = (v2u*)(xn + (size_t)m * D) + lane;
#pragma unroll
        for (int j = 0; j < 4; ++j) { const fx4 g = ((const fx4*)gb)[lane + 64 * j]; const fx4 y = hv[j] * g * rstd2; xo[64 * j] = (v2u){pk2(y.x, y.y), pk2(y.z, y.w)}; }
    }
}

__device__ __forceinline__ void mixer_prep_rows(const Params& P, unsigned char* ws, int layer, int gw, int NGW, int lane) {
    bf16* Z = (bf16*)(ws + OFF_HID); bf16* qkv = (bf16*)(ws + OFF_QLN); bf16* Kc = (bf16*)(ws + OFF_KCAT);
    const float* cosM = (const float*)(ws + OFF_TAB); const float* sinM = cosM + (size_t)T * 16; const float* cosD = sinM + (size_t)T * 16; const float* sinD = cosD + (size_t)T * 32;
    const float* qn = P.in[5] + (size_t)layer * QL; const float* kvn = P.in[7] + (size_t)layer * KVL;
    for (int m = gw; m < T; m += NGW) {
        bf16* z = Z + (size_t)m * NINP;
        {
            const v2u w = ((const v2u*)z)[lane]; const fx4 v = {bflo(w.x), bfhi(w.x), bflo(w.y), bfhi(w.y)};
            const float ss = (v.x * v.x + v.y * v.y) + (v.z * v.z + v.w * v.w);
            const float rstd = fast_rsq(wave_sum(ss) * (1.0f / QL) + EPS);
            const fx4 g = ((const fx4*)qn)[lane]; const fx4 y = v * g * rstd;
            ((v2u*)(qkv + (size_t)m * 384))[lane] = (v2u){pk2(y.x, y.y), pk2(y.z, y.w)};
        }
        {
            const unsigned w = ((const unsigned*)(z + 256))[lane]; const float a = bflo(w), b = bfhi(w);
            const float rstd = fast_rsq(wave_sum(a * a + b * b) * (1.0f / KVL) + EPS);
            const fx2 g = ((const fx2*)kvn)[lane];
            ((unsigned*)(qkv + (size_t)m * 384 + 256))[lane] = pk2(a * g.x * rstd, b * g.y * rstd);
        }
        if (lane < 16) {
            const float x1 = __uint_as_float((unsigned)z[384 + lane] << 16), x2 = __uint_as_float((unsigned)z[400 + lane] << 16);
            const float c = cosM[(size_t)m * 16 + lane], s = sinM[(size_t)m * 16 + lane];
            const unsigned o = pk2(x1 * c - x2 * s, x2 * c + x1 * s);
            bf16* kr = Kc + (size_t)m * 768 + 64 + lane;
#pragma unroll
            for (int h = 0; h < 8; ++h) { kr[h * 96] = (bf16)(o & 0xffffu); kr[h * 96 + 16] = (bf16)(o >> 16); }
        }
        {
            const int head = lane >> 3, c4 = lane & 7;
            const fx4 cs = ((const fx4*)(cosD + (size_t)m * 32))[c4], sn = ((const fx4*)(sinD + (size_t)m * 32))[c4];
#pragma unroll
            for (int w = 0; w < 2; ++w) {
                bf16* base = z + (w == 0 ? 416 : 928) + head * 64 + 4 * c4;
                const v2u a = *(const v2u*)base, b = *(const v2u*)(base + 32);
                const fx4 x1 = {bflo(a.x), bfhi(a.x), bflo(a.y), bfhi(a.y)}, x2 = {bflo(b.x), bfhi(b.x), bflo(b.y), bfhi(b.y)};
                const fx4 o1 = x1 * cs - x2 * sn, o2 = x2 * cs + x1 * sn;
                *(v2u*)base = (v2u){pk2(o1.x, o1.y), pk2(o1.z, o1.w)};
                *(v2u*)(base + 32) = (v2u){pk2(o2.x, o2.y), pk2(o2.z, o2.w)};
            }
        }
    }
}

__device__ __forceinline__ void merge_rows(const Params& P, unsigned char* ws, int layer, int gw, int NGW, int lane) {
    bf16* XN = (bf16*)(ws + OFF_XN); const bf16* Fb = (const bf16*)(ws + OFF_F); const float* LSE = (const float*)(ws + OFF_LSE);
    const float* gg = P.in[9] + (size_t)layer * D;
    const int head = lane >> 3;
    for (int m = gw; m < T; m += NGW) {
        const v4u wm = *(const v4u*)(XN + (size_t)m * D + 8 * lane);
        const v4u w2 = *(const v4u*)(XN + (size_t)m * D + 512 + 8 * lane);
        const v4u w0 = *(const v4u*)(Fb + (size_t)m * 512 + 8 * lane);
        const v4u w1 = *(const v4u*)(Fb + (size_t)T * 512 + (size_t)m * 512 + 8 * lane);
        const float L0 = LSE[(size_t)m * 8 + head], L1 = LSE[(size_t)T * 8 + (size_t)m * 8 + head], L2 = LSE[(size_t)2 * T * 8 + (size_t)m * 8 + head];
        const float mx = fmaxf(L0, fmaxf(L1, L2));
        float e0 = fast_exp2(L0 - mx), e1 = fast_exp2(L1 - mx), e2 = fast_exp2(L2 - mx);
        const float inv = fast_rcp(e0 + e1 + e2); e0 *= inv; e1 *= inv; e2 *= inv;
        float om[8] = {bflo(wm.x), bfhi(wm.x), bflo(wm.y), bfhi(wm.y), bflo(wm.z), bfhi(wm.z), bflo(wm.w), bfhi(wm.w)};
        float a0[8] = {bflo(w0.x), bfhi(w0.x), bflo(w0.y), bfhi(w0.y), bflo(w0.z), bfhi(w0.z), bflo(w0.w), bfhi(w0.w)};
        float a1[8] = {bflo(w1.x), bfhi(w1.x), bflo(w1.y), bfhi(w1.y), bflo(w1.z), bfhi(w1.z), bflo(w1.w), bfhi(w1.w)};
        float a2[8] = {bflo(w2.x), bfhi(w2.x), bflo(w2.y), bfhi(w2.y), bflo(w2.z), bfhi(w2.z), bflo(w2.w), bfhi(w2.w)};
        float od[8]; float ssm = 0.f, ssd = 0.f;
#pragma unroll
        for (int e = 0; e < 8; ++e) { od[e] = e0 * a0[e] + e1 * a1[e] + e2 * a2[e]; ssm += om[e] * om[e]; ssd += od[e] * od[e]; }
        const float rm = fast_rsq(wave_sum(ssm) * (1.0f / 512) + EPS), rd = fast_rsq(wave_sum(ssd) * (1.0f / 512) + EPS);
        const fx4 gm0 = ((const fx4*)gg)[2 * lane], gm1 = ((const fx4*)gg)[2 * lane + 1], gd0 = ((const fx4*)(gg + 512))[2 * lane], gd1 = ((const fx4*)(gg + 512))[2 * lane + 1];
        v4u o;
        o.x = pk2(om[0] * gm0.x * rm, om[1] * gm0.y * rm); o.y = pk2(om[2] * gm0.z * rm, om[3] * gm0.w * rm); o.z = pk2(om[4] * gm1.x * rm, om[5] * gm1.y * rm); o.w = pk2(om[6] * gm1.z * rm, om[7] * gm1.w * rm);
        *(v4u*)(XN + (size_t)m * D + 8 * lane) = o;
        o.x = pk2(od[0] * gd0.x * rd, od[1] * gd0.y * rd); o.y = pk2(od[2] * gd0.z * rd, od[3] * gd0.w * rd); o.z = pk2(od[4] * gd1.x * rd, od[5] * gd1.y * rd); o.w = pk2(od[6] * gd1.z * rd, od[7] * gd1.w * rd);
        *(v4u*)(XN + (size_t)m * D + 512 + 8 * lane) = o;
    }
}

__device__ __forceinline__ void convert_p(const Params& P, unsigned char* ws, int layer, int gtid, int NT) {
    const fx4* src = (const fx4*)(P.in[1] + (size_t)layer * T * PLE); v4u* dst = (v4u*)(ws + OFF_QLN);
    for (int i = gtid; i < T * PLE / 8; i += NT) { const fx4 a = src[2 * i], b = src[2 * i + 1]; dst[i] = (v4u){pk2(a.x, a.y), pk2(a.z, a.w), pk2(b.x, b.y), pk2(b.z, b.w)}; }
}

struct AttnArgs {
    const bf16* Q; int qs;
    const bf16* K; int ks;
    const bf16* V; int vs;
    bf16* O; int os;
    float* L; int ls;
    const float* cosT; const float* sinT;
    int q0; float c;
};
template <int DQK, bool WIN>
__device__ __forceinline__ void attn_unit(LAS unsigned char* lds, const AttnArgs& a) {
    constexpr int KCH = DQK / 8, NKC = 64 * KCH, NC = NKC + 512, NIT = (NC + 511) / 512;
    constexpr int KRS = DQK * 2 + 16, KBYTES = 64 * KRS, BUFB = KBYTES + 8192;
    constexpr int NDS = DQK / 16;
    int tid_ = threadIdx.x; asm volatile("" : "+v"(tid_));
    const int tid = tid_, lane = tid & 63, wid = __builtin_amdgcn_readfirstlane(tid >> 6), r32 = lane & 31, hi = lane >> 5;
    const int qw0 = a.q0 + 32 * wid, qpos = qw0 + r32;
    const int t_hi = (a.q0 + 256) >> 6;
    const int t_lo = WIN ? (a.q0 >= 128 ? ((a.q0 - 128) >> 6) : 0) : 0;
    v4u st[NIT];
#pragma unroll
    for (int it = 0; it < NIT; ++it) { const int c = tid + 512 * it;
        if (c < NC) { if (c < NKC) { const int row = c / KCH, ch = c % KCH; st[it] = *(const v4u*)(a.K + (long)(64 * t_lo + row) * a.ks + ch * 8); }
                      else { const int c2 = c - NKC, row = c2 >> 3, ch = c2 & 7; st[it] = *(const v4u*)(a.V + (long)(64 * t_lo + row) * a.vs + ch * 8); } } }
    hx8 qf[NDS];
    { const bf16* qrow = a.Q + (long)qpos * a.qs + 8 * hi;
#pragma unroll
      for (int ds = 0; ds < NDS; ++ds) qf[ds] = *(const hx8*)(qrow + 16 * ds);
      if (DQK == 96) {
          const fx4* cp = (const fx4*)(a.cosT + (long)qpos * 16 + 8 * hi); const fx4* sp = (const fx4*)(a.sinT + (long)qpos * 16 + 8 * hi);
          const fx4 c0 = cp[0], c1 = cp[1], s0 = sp[0], s1 = sp[1];
          const float cc[8] = {c0.x, c0.y, c0.z, c0.w, c1.x, c1.y, c1.z, c1.w}, sn[8] = {s0.x, s0.y, s0.z, s0.w, s1.x, s1.y, s1.z, s1.w};
          float n1[8], n2[8];
#pragma unroll
          for (int j = 0; j < 8; ++j) { const float x1 = __uint_as_float((unsigned)(unsigned short)qf[NDS - 2][j] << 16), x2 = __uint_as_float((unsigned)(unsigned short)qf[NDS - 1][j] << 16);
              n1[j] = x1 * cc[j] - x2 * sn[j]; n2[j] = x2 * cc[j] + x1 * sn[j]; }
          qf[NDS - 2] = __builtin_bit_cast(hx8, (v4u){pk2(n1[0], n1[1]), pk2(n1[2], n1[3]), pk2(n1[4], n1[5]), pk2(n1[6], n1[7])});
          qf[NDS - 1] = __builtin_bit_cast(hx8, (v4u){pk2(n2[0], n2[1]), pk2(n2[2], n2[3]), pk2(n2[4], n2[5]), pk2(n2[6], n2[7])});
      } }
#pragma unroll
    for (int it = 0; it < NIT; ++it) { const int c = tid + 512 * it;
        if (c < NC) { if (c < NKC) { const int row = c / KCH, ch = c % KCH; *(LAS v4u*)(lds + row * KRS + ch * 16) = st[it]; }
                      else { const int c2 = c - NKC, row = c2 >> 3, ch = c2 & 7; *(LAS v4u*)(lds + KBYTES + (ch >> 2) * 4096 + row * 64 + (ch & 3) * 16) = st[it]; } } }
    __syncthreads();
    float m_run = -INFINITY, l_run = 0.f;
    fx16 o[2];
#pragma unroll
    for (int r = 0; r < 16; ++r) { o[0][r] = 0.f; o[1][r] = 0.f; }
    const int vlane = ((lane >> 4) & 1) * 32 + (lane & 3) * 8 + (4 * hi + ((lane & 15) >> 2)) * 64;
    int cur = 0;
    for (int t = t_lo; t < t_hi; ++t) {
        const bool more = (t + 1 < t_hi);
        if (more) {
#pragma unroll
            for (int it = 0; it < NIT; ++it) { const int c = tid + 512 * it;
                if (c < NC) { if (c < NKC) { const int row = c / KCH, ch = c % KCH; st[it] = *(const v4u*)(a.K + (long)(64 * (t + 1) + row) * a.ks + ch * 8); }
                              else { const int c2 = c - NKC, row = c2 >> 3, ch = c2 & 7; st[it] = *(const v4u*)(a.V + (long)(64 * (t + 1) + row) * a.vs + ch * 8); } } }
        }
        const bool need = (64 * t <= qw0 + 31) && (!WIN || (64 * t + 63 >= qw0 - 128));
        if (need) {
            const LAS unsigned char* kb_ = lds + cur * BUFB; const LAS unsigned char* vb_ = kb_ + KBYTES + vlane;
            fx16 p[2];
#pragma unroll
            for (int kb = 0; kb < 2; ++kb) {
#pragma unroll
                for (int r = 0; r < 16; ++r) p[kb][r] = 0.f;
#pragma unroll
                for (int ds = 0; ds < NDS; ++ds) {
                    const hx8 kf = *(const LAS hx8*)(kb_ + (32 * kb + r32) * KRS + (16 * ds + 8 * hi) * 2);
                    p[kb] = __builtin_amdgcn_mfma_f32_32x32x16_bf16(kf, qf[ds], p[kb], 0, 0, 0);
                }
            }
            const bool domask = WIN || (64 * t + 63 > qw0);
            float mx = -INFINITY;
            if (domask) {
#pragma unroll
                for (int kb = 0; kb < 2; ++kb)
#pragma unroll
                    for (int r = 0; r < 16; ++r) {
                        const int kv = 64 * t + 32 * kb + (r & 3) + 8 * (r >> 2) + 4 * hi;
                        const bool ok = (kv <= qpos) && (!WIN || (qpos - kv <= 128));
                        const float v = ok ? p[kb][r] : -INFINITY; p[kb][r] = v; mx = fmaxf(mx, v);
                    }
            } else {
#pragma unroll
                for (int kb = 0; kb < 2; ++kb)
#pragma unroll
                    for (int r = 0; r < 16; ++r) mx = fmaxf(mx, p[kb][r]);
            }
            mx = fmaxf(mx, __shfl_xor(mx, 32));
            const float mnew = fmaxf(m_run, mx * a.c);
            const float muse = (mnew == -INFINITY) ? 0.f : mnew;
            const float alpha = fast_exp2(m_run - muse);
            m_run = mnew;
            float rs = 0.f;
#pragma unroll
            for (int kb = 0; kb < 2; ++kb)
#pragma unroll
                for (int r = 0; r < 16; ++r) { const float e = fast_exp2(__builtin_fmaf(p[kb][r], a.c, -muse)); p[kb][r] = e; rs += e; }
            l_run = l_run * alpha + rs;
#pragma unroll
            for (int r = 0; r < 16; ++r) { o[0][r] *= alpha; o[1][r] *= alpha; }
            hx8 pb[4];
#pragma unroll
            for (int ks = 0; ks < 4; ++ks) { const int kb = ks >> 1, s8 = (ks & 1) * 8;
                pb[ks] = __builtin_bit_cast(hx8, (v4u){pk2(p[kb][s8 + 0], p[kb][s8 + 1]), pk2(p[kb][s8 + 2], p[kb][s8 + 3]), pk2(p[kb][s8 + 4], p[kb][s8 + 5]), pk2(p[kb][s8 + 6], p[kb][s8 + 7])}); }
#pragma unroll
            for (int db = 0; db < 2; ++db)
#pragma unroll
                for (int ks = 0; ks < 4; ++ks) {
                    const hx4 lo = __builtin_bit_cast(hx4, __builtin_amdgcn_ds_read_tr16_b64_v4i16((LAS hx4*)(vb_ + db * 4096 + ks * 1024)));
                    const hx4 hh = __builtin_bit_cast(hx4, __builtin_amdgcn_ds_read_tr16_b64_v4i16((LAS hx4*)(vb_ + db * 4096 + ks * 1024 + 512)));
                    const hx8 vf = {lo[0], lo[1], lo[2], lo[3], hh[0], hh[1], hh[2], hh[3]};
                    o[db] = __builtin_amdgcn_mfma_f32_32x32x16_bf16(vf, pb[ks], o[db], 0, 0, 0);
                }
        }
        if (more) {
            LAS unsigned char* nb_ = lds + (cur ^ 1) * BUFB;
#pragma unroll
            for (int it = 0; it < NIT; ++it) { const int c = tid + 512 * it;
                if (c < NC) { if (c < NKC) { const int row = c / KCH, ch = c % KCH; *(LAS v4u*)(nb_ + row * KRS + ch * 16) = st[it]; }
                              else { const int c2 = c - NKC, row = c2 >> 3, ch = c2 & 7; *(LAS v4u*)(nb_ + KBYTES + (ch >> 2) * 4096 + row * 64 + (ch & 3) * 16) = st[it]; } } }
        }
        __syncthreads();
        cur ^= 1;
    }
    const float lt = l_run + __shfl_xor(l_run, 32);
    const float inv = fast_rcp(lt);
    bf16* orow = a.O + (long)qpos * a.os;
#pragma unroll
    for (int db = 0; db < 2; ++db)
#pragma unroll
        for (int g = 0; g < 4; ++g) {
            const v2u w = {pk2(o[db][4 * g] * inv, o[db][4 * g + 1] * inv), pk2(o[db][4 * g + 2] * inv, o[db][4 * g + 3] * inv)};
            *(v2u*)(orow + 32 * db + 8 * g + 4 * hi) = w;
        }
    if (WIN) { if (hi == 0) a.L[(long)qpos * a.ls] = m_run + __builtin_amdgcn_logf(lt); }
}

__device__ __forceinline__ void attention_phase(unsigned char* ws, LAS unsigned char* lds) {
    int bx_ = blockIdx.x; asm volatile("" : "+s"(bx_));
    const int G = gridDim.x, c = bx_;
    const float* cosM = (const float*)(ws + OFF_TAB); const float* sinM = cosM + (size_t)T * 16;
    bf16* XN = (bf16*)(ws + OFF_XN); bf16* Fb = (bf16*)(ws + OFF_F); float* LSE = (float*)(ws + OFF_LSE);
    const bf16* Z = (const bf16*)(ws + OFF_HID); const bf16* Qb = (const bf16*)(ws + OFF_Q);
    const bf16* Kc = (const bf16*)(ws + OFF_KCAT); const bf16* Vm = (const bf16*)(ws + OFF_V);
#ifdef EXP_MLA2
    for (int rep_ = 0; rep_ < 2; ++rep_)
#endif
    for (int pi = c; pi < 512; pi += G) {
        const int bh = pi >> 4, s = pi & 15, b = bh >> 3, h = bh & 7;
        const size_t tok0 = (size_t)b * SEQ;
        AttnArgs a;
        a.Q = Qb + tok0 * 768 + h * 96; a.qs = 768; a.K = Kc + tok0 * 768 + h * 96; a.ks = 768; a.V = Vm + tok0 * 512 + h * 64; a.vs = 512;
        a.O = XN + tok0 * D + h * 64; a.os = D; a.L = nullptr; a.ls = 0; a.cosT = cosM + tok0 * 16; a.sinT = sinM + tok0 * 16;
        a.c = 0.10206207261596577f * 1.4426950408889634f;
        for (int half = 0; half < 2; ++half) { a.q0 = half ? 256 * s : 256 * (31 - s); attn_unit<96, false>(lds, a); }
    }
#ifdef EXP_DIL2
    for (int rep_ = 0; rep_ < 2; ++rep_)
#endif
    for (int u = c; u < 3072; u += G) {
        const int br = u >> 10, rem = u & 1023, b = rem >> 8, h = (rem >> 5) & 7, idx = rem & 31;
        const int dil = (br == 0) ? 1 : (br == 1 ? 4 : 16); const int nsub = 32 / dil; const int r = idx / nsub, n = idx % nsub;
        const size_t tok0 = (size_t)b * SEQ + r;
        AttnArgs a;
        a.Q = Z + tok0 * NINP + 416 + h * 64; a.qs = NINP * dil; a.K = Z + tok0 * NINP + 928 + h * 64; a.ks = a.qs; a.V = Z + tok0 * NINP + 1440 + h * 64; a.vs = a.qs;
        if (br < 2) { a.O = Fb + (size_t)br * T * 512 + tok0 * 512 + h * 64; a.os = 512 * dil; }
        else { a.O = XN + tok0 * D + 512 + h * 64; a.os = D * dil; }
        a.L = LSE + (size_t)br * T * 8 + tok0 * 8 + h; a.ls = 8 * dil; a.cosT = nullptr; a.sinT = nullptr;
        a.c = 0.125f * 1.4426950408889634f; a.q0 = 256 * n;
        attn_unit<64, true>(lds, a);
    }
}

#define XB_TMO      128
#define XB_XCNT(j)  (256  + 64 * (j))
#define XB_XSUB(j)  (1280 + 64 * (j))
#define XB_XGEN(j)  (2304 + 64 * (j))
#define XB_TOP      3328
#define XB_TOPGEN   3392
#define XCD_BAR_WORDS 3456
#define XB_SPIN_CAP (1u << 18)

__device__ __forceinline__ unsigned xb_ld(unsigned* p)              { return __hip_atomic_load(p, __ATOMIC_RELAXED, __HIP_MEMORY_SCOPE_AGENT); }
__device__ __forceinline__ unsigned xb_add(unsigned* p, unsigned v) { return __hip_atomic_fetch_add(p, v, __ATOMIC_RELAXED, __HIP_MEMORY_SCOPE_AGENT); }
__device__ __forceinline__ unsigned xb_xcc_id() { return (unsigned)__builtin_amdgcn_s_getreg((3 << 11) | 20) & 0xFu; }
#define XB_SPIN(cond, bar) do { unsigned _sp = 0; while (cond) { __builtin_amdgcn_s_sleep(1); \
    if ((++_sp & 255u) == 0u) { if (xb_ld(&(bar)[XB_TMO])) break; if (_sp > XB_SPIN_CAP) { atomicAdd(&(bar)[XB_TMO], 1u); break; } } } } while (0)

struct XcdBarrier {
    unsigned* bar; unsigned x;
    volatile LAS unsigned* st;
};

__device__ __forceinline__ XcdBarrier xcd_barrier_post(unsigned* bar, volatile LAS unsigned* st) {
    XcdBarrier b; b.bar = bar; b.x = xb_xcc_id(); b.st = st;
    if (threadIdx.x == 0) (void)xb_add(&bar[XB_XCNT(b.x)], 1u);
    return b;
}
__device__ __forceinline__ void xcd_barrier_complete(unsigned* bar, unsigned x, unsigned& nloc, unsigned& nx) {
    const unsigned G = gridDim.x * gridDim.y * gridDim.z;
    unsigned sum, cnt, mine, sp = 0u;
    for (;;) {
        sum = 0u; cnt = 0u; mine = 0u;
#pragma unroll
        for (unsigned j = 0; j < 16; ++j) { const unsigned c = xb_ld(&bar[XB_XCNT(j)]); sum += c; cnt += (c > 0u) ? 1u : 0u; mine = (j == x) ? c : mine; }
        if (sum == G) break;
        __builtin_amdgcn_s_sleep(1);
        if ((++sp & 255u) == 0u) { if (xb_ld(&bar[XB_TMO])) break; if (sp > XB_SPIN_CAP) { atomicAdd(&bar[XB_TMO], 1u); break; } }
    }
    nloc = mine > 0u ? mine : 1u; nx = cnt > 0u ? cnt : 1u;
}

__device__ __forceinline__ void xcd_barrier(const XcdBarrier& b) {
    asm volatile("s_waitcnt vmcnt(0)" ::: "memory");
    __syncthreads();
    if (threadIdx.x == 0) {
        unsigned* bar = b.bar;
        __builtin_amdgcn_s_waitcnt(0);
        unsigned nloc = b.st[0], nx = b.st[1];
        if (nloc == 0u) { xcd_barrier_complete(bar, b.x, nloc, nx); b.st[0] = nloc; b.st[1] = nx; }
        const unsigned old = xb_add(&bar[XB_XSUB(b.x)], 1u);
        const unsigned gen = old / nloc;
        if (old + 1u == (gen + 1u) * nloc) {
            __builtin_amdgcn_fence(__ATOMIC_RELEASE, "agent");
            asm volatile("s_waitcnt vmcnt(0)" ::: "memory");
            const unsigned og = xb_add(&bar[XB_TOP], 1u);
            const unsigned tg = og / nx;
            if (og + 1u == (tg + 1u) * nx) xb_add(&bar[XB_TOPGEN], 1u);
            else XB_SPIN(xb_ld(&bar[XB_TOPGEN]) == tg, bar);
            __builtin_amdgcn_fence(__ATOMIC_ACQUIRE, "agent");
            xb_add(&bar[XB_XGEN(b.x)], 1u);
            asm volatile("s_waitcnt vmcnt(0)" ::: "memory");
        } else {
            XB_SPIN(xb_ld(&bar[XB_XGEN(b.x)]) == gen, bar);
            __builtin_amdgcn_fence(__ATOMIC_ACQUIRE, "agent");
            asm volatile("s_waitcnt vmcnt(0)" ::: "memory");
        }
    }
    __syncthreads();
}


#ifdef NO_GEMM
#define GEMM_PHASE(EPI, Aptr, Bptr, Nn, Kk, Eobj) do { (void)(Eobj); } while (0)
#else
#define GEMM_PHASE(EPI, Aptr, Bptr, Nn, Kk, Eobj) do { int bx_ = blockIdx.x; asm volatile("" : "+s"(bx_)); pg8::Gemm g_{(const pg8::bf16_t*)(Aptr), (const pg8::bf16_t*)(Bptr), T, (Nn), (Kk)}; pg8::StaticOrder S_; S_.init(T, (Nn), (int)gridDim.x, bx_); \
    pg8::gemm_phase<EPI, pg8::StaticOrder, true, true>(lds, g_, S_, (Eobj)); } while (0)
#endif
#define PH_IDS int tid = threadIdx.x; asm volatile("" : "+v"(tid)); const int lane = tid & 63, wave = __builtin_amdgcn_readfirstlane(tid >> 6); int bxp = blockIdx.x; asm volatile("" : "+s"(bxp)); \
    const int gw = bxp * 8 + wave, NGW = gridDim.x * 8, gtid = bxp * NTHREADS + tid, NT = gridDim.x * NTHREADS; (void)lane; (void)gw; (void)NGW; (void)gtid; (void)NT;
#define GASP(T_, p_) ((T_*)(__attribute__((address_space(1))) T_*)(p_))
#define PH_WS unsigned char* ws = P.ws;
#define WP(off) ((bf16*)(ws + (off)))
#define WBP(eoff) ((bf16*)(ws + OFF_WB) + (eoff))

__global__ void __launch_bounds__(NTHREADS, 2) mega_fwd(Params Pk) {
    Params P;
#pragma unroll
    for (int i = 0; i < 16; ++i) P.in[i] = GASP(const float, Pk.in[i]);
    P.out = GASP(float, Pk.out); P.ws = GASP(unsigned char, Pk.ws);
    extern __shared__ __attribute__((aligned(16))) unsigned char lds_raw[];
    LAS unsigned char* lds = (LAS unsigned char*)lds_raw;
    cg::grid_group grid = cg::this_grid();
    volatile LAS unsigned* bst = (volatile LAS unsigned*)(lds + 131072);
    if (threadIdx.x < 2) bst[threadIdx.x] = 0u;
    __syncthreads();
    const XcdBarrier bar = xcd_barrier_post((unsigned*)(P.ws + OFF_BAR), bst);
#define GSYNC() xcd_barrier(bar)

    { PH_IDS PH_WS
      convert_weights(P, ws, 0, lds, gw, NGW, wave, lane);
      rope_tables(P, ws, gtid, NT);
      resnorm_rows<false>(P.in[0], P.out, nullptr, 0.f, nullptr, P.in[3], WP(OFF_XN), gw, NGW, lane); }
    grid.sync();

    { const int layer = 0;
        { PH_WS pg8::EpiSwiglu E{WP(OFF_HID), FF}; GEMM_PHASE(pg8::EpiSwiglu, WP(OFF_XN), WBP(WE_FIN_A), 2 * FF, D, E); }
        GSYNC();
        { PH_WS pg8::EpiBf16<0> E{WP(OFF_F), D, nullptr, 0, 0, 1.f}; GEMM_PHASE(pg8::EpiBf16<0>, WP(OFF_HID), WBP(WE_FDN_A), D, FF, E); }
        GSYNC();
        { PH_IDS PH_WS const float* gains = P.in[3] + (size_t)layer * 8 * D;
          resnorm_rows<true>(P.out, P.out, WP(OFF_F), 0.5f, gains + 1 * D, gains + 2 * D, WP(OFF_XN), gw, NGW, lane); }
        GSYNC();
        { PH_WS pg8::EpiBf16<0> E{WP(OFF_HID), NINP, nullptr, 0, 0, 1.f}; GEMM_PHASE(pg8::EpiBf16<0>, WP(OFF_XN), WBP(WE_IN), NINP, D, E); }
        GSYNC();
        { PH_IDS PH_WS mixer_prep_rows(P, ws, layer, gw, NGW, lane); }
        GSYNC();
        { PH_WS pg8::EpiQKV E{WP(OFF_Q), WP(OFF_KCAT), WP(OFF_V)}; int kq_ = 384; asm volatile("" : "+s"(kq_)); GEMM_PHASE(pg8::EpiQKV, WP(OFF_QLN), WBP(WE_QUP), 1792, kq_, E); }
        GSYNC();
#ifndef NO_ATTN
        { PH_WS attention_phase(ws, lds); }
#endif
        GSYNC();
#ifdef EXP_SYNC
        for (int rep_ = 0; rep_ < 16; ++rep_) GSYNC();
#endif
        { PH_IDS PH_WS merge_rows(P, ws, layer, gw, NGW, lane); }
        GSYNC();
        { PH_WS pg8::EpiBf16<0> E{WP(OFF_F), D, nullptr, 0, 0, 1.f}; GEMM_PHASE(pg8::EpiBf16<0>, WP(OFF_XN), WBP(WE_OUT), D, D, E); }
        GSYNC();
        { PH_IDS PH_WS const float* gains = P.in[3] + (size_t)layer * 8 * D;
          resnorm_rows<true>(P.out, P.out, WP(OFF_F), 1.0f, gains + 3 * D, gains + 4 * D, WP(OFF_XN), gw, NGW, lane);
          convert_p(P, ws, layer, gtid, NT); }
        GSYNC();
        { PH_WS pg8::EpiSwiglu E{WP(OFF_HID), FF}; GEMM_PHASE(pg8::EpiSwiglu, WP(OFF_XN), WBP(WE_FIN_B), 2 * FF, D, E); }
        GSYNC();
        { PH_WS pg8::EpiBf16<0> E{WP(OFF_F), D, nullptr, 0, 0, 1.f}; GEMM_PHASE(pg8::EpiBf16<0>, WP(OFF_HID), WBP(WE_FDN_B), D, FF, E); }
        GSYNC();
        { PH_IDS PH_WS const float* gains = P.in[3] + (size_t)layer * 8 * D;
          resnorm_rows<true>(P.out, P.out, WP(OFF_F), 0.5f, gains + 5 * D, gains + 6 * D, WP(OFF_XN), gw, NGW, lane); }
        { PH_WS pg8::EpiBf16<0> E{WP(OFF_HID), D, nullptr, 0, 0, 1.f}; GEMM_PHASE(pg8::EpiBf16<0>, WP(OFF_QLN), WBP(WE_PLE), D, PLE, E); }
        GSYNC();
        { PH_WS pg8::EpiGate E{WP(OFF_F), WP(OFF_HID), D}; GEMM_PHASE(pg8::EpiGate, WP(OFF_XN), WBP(WE_PG), D, D, E); }
        GSYNC();
        { PH_IDS PH_WS const float* gains = P.in[3] + (size_t)layer * 8 * D;
          resnorm_rows<true>(P.out, P.out, WP(OFF_F), 1.0f, gains + 7 * D, P.in[3] + (size_t)((layer + 1) & 1) * 8 * D, WP(OFF_XN), gw, NGW, lane);
          if (layer == 0) convert_weights(P, ws, 1, lds, gw, NGW, wave, lane); }
        if (layer == 0) GSYNC();
    }
    { const int layer = 1;
        { PH_WS pg8::EpiSwiglu E{WP(OFF_HID), FF}; GEMM_PHASE(pg8::EpiSwiglu, WP(OFF_XN), WBP(WE_FIN_A), 2 * FF, D, E); }
        GSYNC();
        { PH_WS pg8::EpiBf16<0> E{WP(OFF_F), D, nullptr, 0, 0, 1.f}; GEMM_PHASE(pg8::EpiBf16<0>, WP(OFF_HID), WBP(WE_FDN_A), D, FF, E); }
        GSYNC();
        { PH_IDS PH_WS const float* gains = P.in[3] + (size_t)layer * 8 * D;
          resnorm_rows<true>(P.out, P.out, WP(OFF_F), 0.5f, gains + 1 * D, gains + 2 * D, WP(OFF_XN), gw, NGW, lane); }
        GSYNC();
        { PH_WS pg8::EpiBf16<0> E{WP(OFF_HID), NINP, nullptr, 0, 0, 1.f}; GEMM_PHASE(pg8::EpiBf16<0>, WP(OFF_XN), WBP(WE_IN), NINP, D, E); }
        GSYNC();
        { PH_IDS PH_WS mixer_prep_rows(P, ws, layer, gw, NGW, lane); }
        GSYNC();
        { PH_WS pg8::EpiQKV E{WP(OFF_Q), WP(OFF_KCAT), WP(OFF_V)}; int kq_ = 384; asm volatile("" : "+s"(kq_)); GEMM_PHASE(pg8::EpiQKV, WP(OFF_QLN), WBP(WE_QUP), 1792, kq_, E); }
        GSYNC();
#ifndef NO_ATTN
        { PH_WS attention_phase(ws, lds); }
#endif
        GSYNC();
#ifdef EXP_SYNC
        for (int rep_ = 0; rep_ < 16; ++rep_) GSYNC();
#endif
        { PH_IDS PH_WS merge_rows(P, ws, layer, gw, NGW, lane); }
        GSYNC();
        { PH_WS pg8::EpiBf16<0> E{WP(OFF_F), D, nullptr, 0, 0, 1.f}; GEMM_PHASE(pg8::EpiBf16<0>, WP(OFF_XN), WBP(WE_OUT), D, D, E); }
        GSYNC();
        { PH_IDS PH_WS const float* gains = P.in[3] + (size_t)layer * 8 * D;
          resnorm_rows<true>(P.out, P.out, WP(OFF_F), 1.0f, gains + 3 * D, gains + 4 * D, WP(OFF_XN), gw, NGW, lane);
          convert_p(P, ws, layer, gtid, NT); }
        GSYNC();
        { PH_WS pg8::EpiSwiglu E{WP(OFF_HID), FF}; GEMM_PHASE(pg8::EpiSwiglu, WP(OFF_XN), WBP(WE_FIN_B), 2 * FF, D, E); }
        GSYNC();
        { PH_WS pg8::EpiBf16<0> E{WP(OFF_F), D, nullptr, 0, 0, 1.f}; GEMM_PHASE(pg8::EpiBf16<0>, WP(OFF_HID), WBP(WE_FDN_B), D, FF, E); }
        GSYNC();
        { PH_IDS PH_WS const float* gains = P.in[3] + (size_t)layer * 8 * D;
          resnorm_rows<true>(P.out, P.out, WP(OFF_F), 0.5f, gains + 5 * D, gains + 6 * D, WP(OFF_XN), gw, NGW, lane); }
        { PH_WS pg8::EpiBf16<0> E{WP(OFF_HID), D, nullptr, 0, 0, 1.f}; GEMM_PHASE(pg8::EpiBf16<0>, WP(OFF_QLN), WBP(WE_PLE), D, PLE, E); }
        GSYNC();
        { PH_WS pg8::EpiGate E{WP(OFF_F), WP(OFF_HID), D}; GEMM_PHASE(pg8::EpiGate, WP(OFF_XN), WBP(WE_PG), D, D, E); }
        GSYNC();
        { PH_IDS PH_WS const float* gains = P.in[3] + (size_t)layer * 8 * D;
          resnorm_rows<true>(P.out, P.out, WP(OFF_F), 1.0f, gains + 7 * D, P.in[3] + (size_t)((layer + 1) & 1) * 8 * D, WP(OFF_XN), gw, NGW, lane);
          if (layer == 0) convert_weights(P, ws, 1, lds, gw, NGW, wave, lane); }
        if (layer == 0) GSYNC();
    }
}

extern "C" void kernel_launch(void* const* d_in, const int* in_sizes, int n_in, void* d_out, int out_size, void* d_ws, size_t ws_size, hipStream_t stream) {
    static int grid = 0;
    if (grid == 0) {
        if (n_in != 16 || out_size != T * D || ws_size < WS_NEED) { fprintf(stderr, "kernel_launch: unexpected shapes (n_in %d out %d ws %zu)\n", n_in, out_size, ws_size); grid = -1; return; }
        int dev = 0, cus = 0, per_cu = 0;
        hipGetDevice(&dev); hipDeviceGetAttribute(&cus, hipDeviceAttributeMultiprocessorCount, dev);
        hipFuncSetAttribute((const void*)mega_fwd, hipFuncAttributeMaxDynamicSharedMemorySize, LDS_BYTES);
        hipOccupancyMaxActiveBlocksPerMultiprocessor(&per_cu, (const void*)mega_fwd, NTHREADS, LDS_BYTES);
        (void)hipGetLastError();
        if (per_cu < 1) fprintf(stderr, "kernel_launch: occupancy query says %d\n", per_cu);
        grid = cus;
    }
    if (grid < 0) return;
    if (hipMemsetAsync((char*)d_ws + OFF_BAR, 0, BAR_BYTES, stream) != hipSuccess) { fprintf(stderr, "kernel_launch: memset failed\n"); return; }
    Params p{};
    for (int i = 0; i < 16; ++i) p.in[i] = (const float*)d_in[i];
    p.out = (float*)d_out; p.ws = (unsigned char*)d_ws;
    void* args[] = {&p};
    hipError_t e = hipLaunchCooperativeKernel((const void*)mega_fwd, dim3(grid), dim3(NTHREADS), args, LDS_BYTES, stream);
    if (e != hipSuccess) fprintf(stderr, "cooperative launch failed: %s (grid %d)\n", hipGetErrorString(e), grid);
}
```

```cpp
#include <hip/hip_runtime.h>
#include <hip/hip_cooperative_groups.h>
#include <cstdio>
#include <cstdint>
#include <cmath>
namespace cg = cooperative_groups;
namespace pg8 {
#define PG8_LAS __attribute__((address_space(3)))
typedef unsigned short bf16_t;
typedef short bf16x8 __attribute__((ext_vector_type(8)));
typedef float f32x4 __attribute__((ext_vector_type(4)));
typedef unsigned u32x4 __attribute__((ext_vector_type(4)));
constexpr int BM = 256, BK = 64, HALF = 128, HTB = HALF * BK * 2  , STAGE_BYTES = 8 * HTB, NXCD = 8, WGM = 8;

__host__ __device__ __forceinline__ int lds_byte(int r, int c) { const int st = (r >> 4) * 2 + (c >> 5), rr = r & 15, cc = c & 31, ob = rr * 64 + cc * 2; return st * 1024 + (ob ^ (((ob >> 9) & 1) << 5)); }
__host__ __device__ __forceinline__ void stage_rc(int b, int& R, int& C) { const int st = b / 1024, sb = b % 1024, swz = sb ^ (((sb >> 9) & 1) << 5); R = (st >> 1) * 16 + swz / 64; C = (st & 1) * 32 + (swz % 64) / 2; }
__host__ __device__ __forceinline__ int perm32(int rho) { const int n = rho >> 4, i = rho & 15; return 8 * (i >> 2) + 4 * n + (i & 3); }

struct Unit { int pm, pn; };
struct Gemm { const bf16_t* A; const bf16_t* Bt; int M, N, K; };

struct StaticOrder {
    int nM, nN, nwg, G, c;
    __host__ __device__ void init(int M, int N, int G_, int c_) { nM = M / BM; nN = N / BM; nwg = nM * nN; G = G_; c = c_; }
    __host__ __device__ bool next(int i, Unit& u) const {
        const long L = (long)i * G + c; if (L >= nwg) return false;
        int wgid = (int)L; { const int q = nwg / NXCD, r = nwg % NXCD, xcd = wgid % NXCD, off = wgid / NXCD; wgid = (xcd < r ? xcd * (q + 1) : r * (q + 1) + (xcd - r) * q) + off; }
        const int nig = WGM * nN, gid = wgid / nig, fm = gid * WGM, gsz = (nM - fm) < WGM ? (nM - fm) : WGM;
        u.pm = fm + ((wgid % nig) % gsz); u.pn = (wgid % nig) / gsz; return true;
    }
    __device__ __forceinline__ void a_ready(const Unit&) const {}
    __device__ __forceinline__ void done(const Unit&) const {}
};

__device__ __forceinline__ unsigned cvt_pk_bf16(float lo, float hi) { unsigned r; asm volatile("v_cvt_pk_bf16_f32 %0, %1, %2" : "=v"(r) : "v"(lo), "v"(hi)); return r; }
typedef float f32x2 __attribute__((ext_vector_type(2)));
__device__ __forceinline__ f32x2 gelu_pk(f32x2 v) {
    const f32x2 av = __builtin_elementwise_abs(v), d = av * 0.2316418882f + 1.0f;
    f32x2 t; t.x = __builtin_amdgcn_rcpf(d.x); t.y = __builtin_amdgcn_rcpf(d.y);
    f32x2 q = t * 0.5307027145f + (-0.7265760135f); q = q * t + 0.7107068705f; q = q * t + (-0.142248368f); q = q * t + 0.127414796f; q = q * t;
    const f32x2 s = (v * v) * (-0.72134752044f);
    f32x2 e; e.x = __builtin_amdgcn_exp2f(s.x); e.y = __builtin_amdgcn_exp2f(s.y);
    const f32x2 m = v * (q * e), r = v - m;
    f32x2 o; o.x = v.x < 0.f ? m.x : r.x; o.y = v.y < 0.f ? m.y : r.y; return o;
}

template <int ACT  > struct EpiBf16 {
    static constexpr bool PERM = true, AFTER_DRAIN = false; static_assert(ACT == 0 || ACT == 1, "EpiBf16: ACT is 0 (none) or 1 (gelu_pk)");
    bf16_t* O; int ldc; const float* bias; int split_cols; size_t split_stride; float scale0;
    __device__ __forceinline__ void operator()(const f32x4 (&acc)[2][2][4][2], const Unit& u, int wr, int wc, int fr, int fq) const {
        const int row0 = u.pm * BM + wr * 64 + fr; int colt = u.pn * BM; bf16_t* base = O;
        float sc = 1.f; if (split_cols) { const int t = colt / split_cols; base += (size_t)t * split_stride; colt -= t * split_cols; if (t == 0) sc = scale0; }
        const int col0 = colt + wc * 32 + 8 * fq, bcol0 = u.pn * BM + wc * 32 + 8 * fq;
        f32x4 bv[2][2];
#pragma unroll
        for (int bj = 0; bj < 2; ++bj)
#pragma unroll
            for (int n = 0; n < 2; ++n) bv[bj][n] = bias ? *(const f32x4*)(bias + bcol0 + bj * HALF + 4 * n) : (f32x4){0.f, 0.f, 0.f, 0.f};
#pragma unroll
        for (int ai = 0; ai < 2; ++ai)
#pragma unroll
            for (int m = 0; m < 4; ++m) { bf16_t* rowp = base + (size_t)(row0 + ai * HALF + m * 16) * ldc + col0;
#pragma unroll
                for (int bj = 0; bj < 2; ++bj) { f32x4 v0 = acc[ai][bj][m][0] + bv[bj][0], v1 = acc[ai][bj][m][1] + bv[bj][1];
                    if (ACT == 1) { f32x2 a = gelu_pk((f32x2){v0[0], v0[1]}), b = gelu_pk((f32x2){v0[2], v0[3]}), c = gelu_pk((f32x2){v1[0], v1[1]}), d = gelu_pk((f32x2){v1[2], v1[3]});
                        v0 = (f32x4){a.x, a.y, b.x, b.y}; v1 = (f32x4){c.x, c.y, d.x, d.y}; }
                    v0 = v0 * sc; v1 = v1 * sc; u32x4 w; w.x = cvt_pk_bf16(v0[0], v0[1]); w.y = cvt_pk_bf16(v0[2], v0[3]); w.z = cvt_pk_bf16(v1[0], v1[1]); w.w = cvt_pk_bf16(v1[2], v1[3]);
                    *(u32x4*)(rowp + bj * HALF) = w; } }
    }
};

template <class Epi, class Sched, bool ALIGN_EPI = false, bool SP2 = false>
__device__ __forceinline__ void gemm_phase(PG8_LAS unsigned char* lds, const Gemm g, const Sched& S, const Epi& E) {
    int tid_ = threadIdx.x; asm volatile("" : "+v"(tid_));
    const int tid = tid_, wid = __builtin_amdgcn_readfirstlane(tid >> 6), lane = tid & 63, wr = wid >> 2, wc = wid & 3, fr = lane & 15, fq = lane >> 4;
    const int K = g.K, nt = K / BK;
    unsigned voffA[2], voffB[2];
#pragma unroll
    for (int i = 0; i < 2; ++i) { int R, C; stage_rc(tid * 16 + i * 8192, R, C); const int Rb = Epi::PERM ? ((R & ~31) + perm32(R & 31)) : R;
        voffA[i] = (unsigned)(R * K + C) * 2u; voffB[i] = (unsigned)(Rb * K + C) * 2u; }
    const size_t kstep = (size_t)(BK * 2);
    const size_t hstep = (size_t)HALF * K * 2;
    const size_t tstep = 2 * hstep;
    const unsigned ldsw = (unsigned)wid * 1024u;
    const int aoff = lds_byte(wr * 64 + fr, fq * 8), boff = lds_byte(wc * 32 + fr, fq * 8);
#define PG8_SA(b, h) (((b) * 2 + (h)) * HTB)
#define PG8_SB(b, h) ((4 + (b) * 2 + (h)) * HTB)
#define PG8_STAGE(bufoff, gbase, voff) do { _Pragma("unroll") for (int _i = 0; _i < 2; ++_i) \
        __builtin_amdgcn_global_load_lds((const unsigned*)((const char*)(gbase) + (voff)[_i]), (PG8_LAS unsigned*)(lds + (bufoff) + ldsw + _i * 8192), 16, 0, 0); } while (0)
#define PG8_LDA(dst, b, h) do { _Pragma("unroll") for (int m = 0; m < 4; ++m) _Pragma("unroll") for (int k = 0; k < 2; ++k) dst[m][k] = *(const PG8_LAS bf16x8*)(lds + PG8_SA(b, h) + aoff + m * 2048 + k * 1024); } while (0)
#define PG8_LDB(dst, b, h) do { _Pragma("unroll") for (int n = 0; n < 2; ++n) _Pragma("unroll") for (int k = 0; k < 2; ++k) dst[n][k] = *(const PG8_LAS bf16x8*)(lds + PG8_SB(b, h) + boff + n * 2048 + k * 1024); } while (0)
#define PG8_MMA(ai, bj, At, Bt) do { __builtin_amdgcn_s_setprio(1); _Pragma("unroll") for (int m = 0; m < 4; ++m) _Pragma("unroll") for (int n = 0; n < 2; ++n) _Pragma("unroll") for (int k = 0; k < 2; ++k) \
        acc[ai][bj][m][n] = __builtin_amdgcn_mfma_f32_16x16x32_bf16(Bt[n][k], At[m][k], acc[ai][bj][m][n], 0, 0, 0); __builtin_amdgcn_s_setprio(0); } while (0)
#define PG8_WAIT_V(n) asm volatile("s_waitcnt vmcnt(" #n ")" ::: "memory")
#define PG8_WAIT_L(n) asm volatile("s_waitcnt lgkmcnt(" #n ")" ::: "memory")
#define PG8_BAR __builtin_amdgcn_s_barrier()
#define PG8_SCHED __builtin_amdgcn_sched_barrier(0)
    float zf_ = 0.f; asm volatile("" : "+v"(zf_)); const f32x4 zero4_ = {zf_, zf_, zf_, zf_};
    Unit cur, nxt; int ui = 0;
    if (!S.next(0, cur)) return;
    f32x4 acc[2][2][4][2];
#pragma unroll
    for (int a = 0; a < 2; ++a)
#pragma unroll
        for (int b = 0; b < 2; ++b)
#pragma unroll
            for (int m = 0; m < 4; ++m)
#pragma unroll
                for (int n = 0; n < 2; ++n) acc[a][b][m][n] = zero4_;
    bf16x8 At[4][2], B0[2][2], B1[2][2];
    const char* cA = (const char*)g.A + (size_t)cur.pm * tstep; const char* cB = (const char*)g.Bt + (size_t)cur.pn * tstep;
    S.a_ready(cur);
    if constexpr (SP2) {
        PG8_STAGE(PG8_SB(0, 0), cB, voffB); PG8_STAGE(PG8_SB(0, 1), cB + hstep, voffB); PG8_STAGE(PG8_SA(0, 0), cA, voffA); PG8_STAGE(PG8_SA(0, 1), cA + hstep, voffA);
        if (wr == 1) PG8_BAR;
        PG8_WAIT_V(2); PG8_BAR;
        PG8_STAGE(PG8_SB(1, 0), cB + kstep, voffB); PG8_STAGE(PG8_SA(1, 0), cA + kstep, voffA); PG8_STAGE(PG8_SB(1, 1), cB + hstep + kstep, voffB);
        PG8_WAIT_V(6); PG8_BAR;
    } else {
        PG8_STAGE(PG8_SB(0, 0), cB, voffB); PG8_STAGE(PG8_SA(0, 0), cA, voffA); PG8_STAGE(PG8_SB(0, 1), cB + hstep, voffB); PG8_STAGE(PG8_SA(0, 1), cA + hstep, voffA);
        if (wr == 1) PG8_BAR;
        PG8_WAIT_V(4); PG8_BAR;
        PG8_STAGE(PG8_SB(1, 0), cB + kstep, voffB); PG8_STAGE(PG8_SA(1, 0), cA + kstep, voffA); PG8_STAGE(PG8_SB(1, 1), cB + hstep + kstep, voffB);
        PG8_WAIT_V(6); PG8_BAR;
    }
    for (;;) {
        const bool has_next = S.next(ui + 1, nxt);
        const char* nA = has_next ? (const char*)g.A + (size_t)nxt.pm * tstep : cA; const char* nB = has_next ? (const char*)g.Bt + (size_t)nxt.pn * tstep : cB;
        for (int t = 0; t < nt; t += 2) {
            const bool last = (t == nt - 2);
            const char* a1 = cA + (size_t)(t + 1) * kstep;
            const char* a2 = last ? nA : cA + (size_t)(t + 2) * kstep; const char* b2 = last ? nB : cB + (size_t)(t + 2) * kstep;
            const char* a3 = a2 + kstep; const char* b3 = b2 + kstep;
            if (last && has_next) S.a_ready(nxt);
            if constexpr (SP2) {
            PG8_LDB(B0, 0, 0); PG8_LDB(B1, 0, 1); PG8_SCHED; PG8_LDA(At, 0, 0); PG8_STAGE(PG8_SA(1, 1), a1 + hstep, voffA);
            PG8_WAIT_V(8); PG8_WAIT_L(0); PG8_BAR; PG8_MMA(0, 0, At, B0); PG8_MMA(0, 1, At, B1); PG8_BAR; PG8_SCHED;
            PG8_LDA(At, 0, 1); PG8_STAGE(PG8_SB(0, 0), b2, voffB); PG8_STAGE(PG8_SB(0, 1), b2 + hstep, voffB); PG8_STAGE(PG8_SA(0, 0), a2, voffA);
            PG8_WAIT_V(8); PG8_WAIT_L(0); PG8_BAR; PG8_MMA(1, 0, At, B0); PG8_MMA(1, 1, At, B1); PG8_BAR; PG8_SCHED;
            PG8_LDB(B0, 1, 0); PG8_LDB(B1, 1, 1); PG8_SCHED; PG8_LDA(At, 1, 0); PG8_STAGE(PG8_SA(0, 1), a2 + hstep, voffA);
            PG8_WAIT_V(8); PG8_WAIT_L(0); PG8_BAR; PG8_MMA(0, 0, At, B0); PG8_MMA(0, 1, At, B1); PG8_BAR; PG8_SCHED;
            PG8_LDA(At, 1, 1); PG8_STAGE(PG8_SB(1, 0), b3, voffB); PG8_STAGE(PG8_SB(1, 1), b3 + hstep, voffB); PG8_STAGE(PG8_SA(1, 0), a3, voffA);
            PG8_WAIT_V(8); PG8_WAIT_L(0); PG8_BAR; PG8_MMA(1, 0, At, B0); PG8_MMA(1, 1, At, B1); PG8_BAR; PG8_SCHED;
            } else {
            PG8_LDB(B0, 0, 0); PG8_SCHED; PG8_LDA(At, 0, 0); PG8_STAGE(PG8_SA(1, 1), a1 + hstep, voffA);
            PG8_WAIT_L(8); PG8_BAR; PG8_WAIT_L(0); PG8_MMA(0, 0, At, B0); PG8_BAR; PG8_SCHED;
            PG8_LDB(B1, 0, 1); PG8_STAGE(PG8_SB(0, 0), b2, voffB);
            PG8_BAR; PG8_WAIT_L(0); PG8_MMA(0, 1, At, B1); PG8_BAR;
            PG8_LDA(At, 0, 1); PG8_STAGE(PG8_SA(0, 0), a2, voffA);
            PG8_BAR; PG8_WAIT_L(0); PG8_MMA(1, 0, At, B0); PG8_BAR; PG8_SCHED;
            PG8_STAGE(PG8_SB(0, 1), b2 + hstep, voffB);
            PG8_WAIT_V(6); PG8_BAR; PG8_MMA(1, 1, At, B1); PG8_BAR;
            PG8_LDB(B0, 1, 0); PG8_SCHED; PG8_LDA(At, 1, 0); PG8_STAGE(PG8_SA(0, 1), a2 + hstep, voffA);
            PG8_WAIT_L(8); PG8_BAR; PG8_WAIT_L(0); PG8_MMA(0, 0, At, B0); PG8_BAR; PG8_SCHED;
            PG8_LDB(B1, 1, 1); PG8_STAGE(PG8_SB(1, 0), b3, voffB);
            PG8_BAR; PG8_WAIT_L(0); PG8_MMA(0, 1, At, B1); PG8_BAR;
            PG8_LDA(At, 1, 1); PG8_STAGE(PG8_SA(1, 0), a3, voffA);
            PG8_BAR; PG8_WAIT_L(0); PG8_MMA(1, 0, At, B0); PG8_BAR; PG8_SCHED;
            PG8_STAGE(PG8_SB(1, 1), b3 + hstep, voffB);
            PG8_WAIT_V(6); PG8_BAR; PG8_MMA(1, 1, At, B1); PG8_BAR;
            }
        }
        if constexpr (ALIGN_EPI) { if (wr == 0) PG8_BAR; }
        if constexpr (!Epi::AFTER_DRAIN) { E(acc, cur, wr, wc, fr, fq); S.done(cur); }
        if (!has_next) break;
#pragma unroll
        for (int a = 0; a < 2; ++a)
#pragma unroll
            for (int b = 0; b < 2; ++b)
#pragma unroll
                for (int m = 0; m < 4; ++m)
#pragma unroll
                    for (int n = 0; n < 2; ++n) acc[a][b][m][n] = zero4_;
        cur = nxt; cA = nA; cB = nB; ++ui;
        if constexpr (ALIGN_EPI) { if (wr == 1) PG8_BAR; }
    }
    PG8_WAIT_V(0);
    if constexpr (!ALIGN_EPI) { if (wr == 0) PG8_BAR; }
    PG8_BAR;
    if constexpr (Epi::AFTER_DRAIN) { E.fused(acc, cur, wr, wc, fr, fq, lds, wid, lane); S.done(cur); }
#undef PG8_SA
#undef PG8_SB
#undef PG8_STAGE
#undef PG8_LDA
#undef PG8_LDB
#undef PG8_MMA
#undef PG8_WAIT_V
#undef PG8_WAIT_L
#undef PG8_BAR
#undef PG8_SCHED
}
}

#define LAS __attribute__((address_space(3)))
typedef unsigned short bf16;
typedef unsigned v4u __attribute__((ext_vector_type(4)));
typedef unsigned v2u __attribute__((ext_vector_type(2)));
typedef float fx4 __attribute__((ext_vector_type(4)));
typedef float fx2 __attribute__((ext_vector_type(2)));
typedef float fx16 __attribute__((ext_vector_type(16)));
typedef short hx8 __attribute__((ext_vector_type(8)));
typedef short hx4 __attribute__((ext_vector_type(4)));
typedef __bf16 bfx2_t __attribute__((ext_vector_type(2)));

constexpr int NB = 4, SEQ = 8192, T = NB * SEQ, D = 1024, FF = 2816, NIN = 1952, NINP = 2048, PLE = 256;
constexpr int QL = 256, KVL = 128;
constexpr float EPS = 1e-6f;
constexpr int NTHREADS = 512;
constexpr int LDS_BYTES = 131072 + 1024;

constexpr size_t MiB = 1u << 20;
constexpr size_t OFF_WB = 0;
constexpr size_t OFF_TAB = 48 * MiB;
constexpr size_t OFF_LSE = 60 * MiB;
constexpr size_t OFF_XN = 64 * MiB;
constexpr size_t OFF_F = 128 * MiB;
constexpr size_t OFF_HID = 192 * MiB;
constexpr size_t OFF_Q = OFF_HID + 128 * MiB;
constexpr size_t OFF_KCAT = 368 * MiB;
constexpr size_t OFF_V = 416 * MiB;
constexpr size_t OFF_QLN = 448 * MiB;
constexpr size_t OFF_KVLN = 464 * MiB;
constexpr size_t OFF_BAR = 472 * MiB;
constexpr size_t BAR_BYTES = 16384;
constexpr size_t WS_NEED = 473 * MiB;
constexpr size_t WE_FIN_A = 0;
constexpr size_t WE_FDN_A = WE_FIN_A + (size_t)2 * FF * D;
constexpr size_t WE_FIN_B = WE_FDN_A + (size_t)D * FF;
constexpr size_t WE_FDN_B = WE_FIN_B + (size_t)2 * FF * D;
constexpr size_t WE_IN = WE_FDN_B + (size_t)D * FF;
constexpr size_t WE_QUP = WE_IN + (size_t)NINP * D;
constexpr size_t WE_OUT = WE_QUP + (size_t)1792 * 384;
constexpr size_t WE_PLE = WE_OUT + (size_t)D * D;
constexpr size_t WE_PG = WE_PLE + (size_t)D * PLE;
constexpr size_t WE_END = WE_PG + (size_t)D * D;
static_assert(WE_END * 2 <= 48 * MiB, "weights fit");

__device__ const float INV_M[16] = {1.000000000e+00f, 5.623413324e-01f, 3.162277639e-01f, 1.778279394e-01f, 1.000000015e-01f, 5.623413250e-02f, 3.162277490e-02f, 1.778279431e-02f, 9.999999776e-03f, 5.623413250e-03f, 3.162277630e-03f, 1.778279431e-03f, 1.000000047e-03f, 5.623413017e-04f, 3.162277571e-04f, 1.778279402e-04f};
__device__ const float INV_D[32] = {1.000000000e+00f, 7.498942614e-01f, 5.623413324e-01f, 4.216965139e-01f, 3.162277639e-01f, 2.371373773e-01f, 1.778279394e-01f, 1.333521307e-01f, 1.000000015e-01f, 7.498941571e-02f, 5.623413250e-02f, 4.216965288e-02f, 3.162277490e-02f, 2.371373773e-02f, 1.778279431e-02f, 1.333521493e-02f, 9.999999776e-03f, 7.498941850e-03f, 5.623413250e-03f, 4.216964822e-03f, 3.162277630e-03f, 2.371373586e-03f, 1.778279431e-03f, 1.333521446e-03f, 1.000000047e-03f, 7.498942432e-04f, 5.623413017e-04f, 4.216965172e-04f, 3.162277571e-04f, 2.371373703e-04f, 1.778279402e-04f, 1.333521504e-04f};

struct Params { const float* in[16]; float* out; unsigned char* ws; };

__device__ __forceinline__ unsigned pk2(float lo, float hi) { fx2 v = {lo, hi}; bfx2_t b = __builtin_convertvector(v, bfx2_t); return __builtin_bit_cast(unsigned, b); }
__device__ __forceinline__ float bflo(unsigned u) { return __uint_as_float(u << 16); }
__device__ __forceinline__ float bfhi(unsigned u) { return __uint_as_float(u & 0xffff0000u); }
__device__ __forceinline__ float wave_sum(float v) {
#pragma unroll
    for (int o = 1; o < 64; o <<= 1) v += __shfl_xor(v, o);
    return v;
}
__device__ __forceinline__ float fast_rcp(float x) { return __builtin_amdgcn_rcpf(x); }
__device__ __forceinline__ float fast_exp2(float x) { return __builtin_amdgcn_exp2f(x); }
__device__ __forceinline__ float fast_rsq(float x) { return __builtin_amdgcn_rsqf(x); }

namespace pg8 {
struct EpiSwiglu {
    static constexpr bool PERM = true, AFTER_DRAIN = false;
    bf16_t* O; int ldc;
    __device__ __forceinline__ void operator()(const f32x4 (&acc)[2][2][4][2], const Unit& u, int wr, int wc, int fr, int fq) const {
        const int row0 = u.pm * BM + wr * 64 + fr; const int col0 = u.pn * 128 + wc * 32 + 8 * fq;
#pragma unroll
        for (int ai = 0; ai < 2; ++ai)
#pragma unroll
            for (int m = 0; m < 4; ++m) {
                bf16_t* rowp = O + (size_t)(row0 + ai * HALF + m * 16) * ldc + col0;
                float h[8];
#pragma unroll
                for (int n = 0; n < 2; ++n)
#pragma unroll
                    for (int e = 0; e < 4; ++e) {
                        const float g = acc[ai][0][m][n][e], up = acc[ai][1][m][n][e];
                        const float sg = g * __builtin_amdgcn_rcpf(1.0f + __builtin_amdgcn_exp2f(-1.4426950408889634f * g));
                        h[n * 4 + e] = sg * up;
                    }
                u32x4 w; w.x = ::pk2(h[0], h[1]); w.y = ::pk2(h[2], h[3]); w.z = ::pk2(h[4], h[5]); w.w = ::pk2(h[6], h[7]);
                *(u32x4*)rowp = w;
            }
    }
};
struct EpiQKV {
    static constexpr bool PERM = true, AFTER_DRAIN = false;
    bf16_t* Q; bf16_t* Kc; bf16_t* V;
    __device__ __forceinline__ void operator()(const f32x4 (&acc)[2][2][4][2], const Unit& u, int wr, int wc, int fr, int fq) const {
        const int row0 = u.pm * BM + wr * 64 + fr;
#pragma unroll
        for (int bj = 0; bj < 2; ++bj) {
            bf16_t* ub; int rs;
            if (u.pn < 3) { ub = Q + u.pn * 256 + bj * 128 + wc * 32; rs = 768; }
            else { const int head = 2 * (u.pn - 3) + bj; if (wc < 2) { ub = Kc + head * 96 + wc * 32; rs = 768; } else { ub = V + head * 64 + (wc * 32 - 64); rs = 512; } }
            const unsigned loff = (unsigned)row0 * (unsigned)rs + 8u * (unsigned)fq;
#pragma unroll
            for (int ai = 0; ai < 2; ++ai)
#pragma unroll
                for (int m = 0; m < 4; ++m) {
                    bf16_t* dst = ub + (loff + (unsigned)((ai * HALF + m * 16) * rs));
                    const f32x4 v0 = acc[ai][bj][m][0], v1 = acc[ai][bj][m][1];
                    u32x4 w; w.x = ::pk2(v0[0], v0[1]); w.y = ::pk2(v0[2], v0[3]); w.z = ::pk2(v1[0], v1[1]); w.w = ::pk2(v1[2], v1[3]);
                    *(u32x4*)dst = w;
                }
        }
    }
};
struct EpiGate {
    static constexpr bool PERM = true, AFTER_DRAIN = false;
    bf16_t* O; const bf16_t* PP; int ldc;
    __device__ __forceinline__ void operator()(const f32x4 (&acc)[2][2][4][2], const Unit& u, int wr, int wc, int fr, int fq) const {
        const int row0 = u.pm * BM + wr * 64 + fr; const int col0 = u.pn * BM + wc * 32 + 8 * fq;
#pragma unroll
        for (int ai = 0; ai < 2; ++ai)
#pragma unroll
            for (int m = 0; m < 4; ++m)
#pragma unroll
                for (int bj = 0; bj < 2; ++bj) {
                    const size_t off = (size_t)(row0 + ai * HALF + m * 16) * ldc + col0 + bj * HALF;
                    const u32x4 pv = *(const u32x4*)(PP + off);
                    float pp[8] = {::bflo(pv.x), ::bfhi(pv.x), ::bflo(pv.y), ::bfhi(pv.y), ::bflo(pv.z), ::bfhi(pv.z), ::bflo(pv.w), ::bfhi(pv.w)};
                    float o[8];
#pragma unroll
                    for (int n = 0; n < 2; ++n)
#pragma unroll
                        for (int e = 0; e < 4; ++e) {
                            const float g = acc[ai][bj][m][n][e];
                            o[n * 4 + e] = pp[n * 4 + e] * __builtin_amdgcn_rcpf(1.0f + __builtin_amdgcn_exp2f(-1.4426950408889634f * g));
                        }
                    u32x4 w; w.x = ::pk2(o[0], o[1]); w.y = ::pk2(o[2], o[3]); w.z = ::pk2(o[4], o[5]); w.w = ::pk2(o[6], o[7]);
                    *(u32x4*)(O + off) = w;
                }
    }
};
}

__device__ __forceinline__ void tr_item(const float* W, int K, int N, int k0, int n0, bf16* WT, int drow0, int ldk, int dk, LAS float* scr, int lane) {
#pragma unroll 8
    for (int i = 0; i < 32; ++i) { const int kk = 2 * i + (lane >> 5); scr[kk * 33 + (lane & 31)] = W[(size_t)(k0 + kk) * N + n0 + (lane & 31)]; }
    asm volatile("s_waitcnt lgkmcnt(0)" ::: "memory");
    const int c = lane & 7;
#pragma unroll
    for (int j = 0; j < 4; ++j) { const int n = (lane >> 3) + 8 * j; const LAS float* s = scr + (8 * c) * 33 + n;
        v4u o; o.x = pk2(s[0 * 33], s[1 * 33]); o.y = pk2(s[2 * 33], s[3 * 33]); o.z = pk2(s[4 * 33], s[5 * 33]); o.w = pk2(s[6 * 33], s[7 * 33]);
        *(v4u*)(WT + (size_t)(drow0 + n) * ldk + dk + k0 + 8 * c) = o; }
    asm volatile("s_waitcnt lgkmcnt(0)" ::: "memory");
}
__device__ __forceinline__ void tr_matrix_item(const float* W, int K, int N, bf16* WT, int mode, int item, LAS float* scr, int lane, int ldk = 0, int dk = 0) {
    const int nblk = N / 32, kb = item / nblk, nb = item % nblk, k0 = 64 * kb, n0 = 32 * nb;
    int drow0 = n0;
    if (mode != 0) drow0 = 256 * (n0 >> 7) + (n0 & 127) + (mode == 2 ? 128 : 0);
    tr_item(W, K, N, k0, n0, WT, drow0, ldk ? ldk : K, dk, scr, lane);
}
__device__ __forceinline__ void convert_weights(const Params& P, unsigned char* ws, int layer, LAS unsigned char* lds, int gw, int NGW, int wave, int lane) {
    LAS float* scr = (LAS float*)(lds + wave * 16384);
    bf16* WB = (bf16*)(ws + OFF_WB);
    const float* w_in = P.in[4] + (size_t)layer * D * NIN;
    const float* w_qup = P.in[6] + (size_t)layer * QL * 768;
    const float* w_kvup = P.in[8] + (size_t)layer * KVL * 1024;
    const float* w_out = P.in[10] + (size_t)layer * D * D;
    const float* fg = P.in[11] + (size_t)layer * 2 * D * FF;
    const float* fu = P.in[12] + (size_t)layer * 2 * D * FF;
    const float* fd = P.in[13] + (size_t)layer * 2 * FF * D;
    const float* w_ple = P.in[14] + (size_t)layer * PLE * D;
    const float* w_pg = P.in[15] + (size_t)layer * D * D;
    constexpr int I_FIN = (D / 64) * (FF / 32);
    constexpr int I_FDN = (FF / 64) * (D / 32);
    constexpr int I_IN = (D / 64) * (NIN / 32);
    constexpr int I_QUP = (QL / 64) * (768 / 32);
    constexpr int I_KVUP = (KVL / 64) * (1024 / 32);
    constexpr int I_DD = (D / 64) * (D / 32);
    constexpr int I_PLE = (PLE / 64) * (D / 32);
    constexpr int NITEMS = 4 * I_FIN + 2 * I_FDN + I_IN + I_QUP + I_KVUP + 2 * I_DD + I_PLE;
    for (int it = gw; it < NITEMS; it += NGW) {
        int r = it;
        if (r < I_FIN) { tr_matrix_item(fg, D, FF, WB + WE_FIN_A, 1, r, scr, lane); continue; } r -= I_FIN;
        if (r < I_FIN) { tr_matrix_item(fu, D, FF, WB + WE_FIN_A, 2, r, scr, lane); continue; } r -= I_FIN;
        if (r < I_FIN) { tr_matrix_item(fg + (size_t)D * FF, D, FF, WB + WE_FIN_B, 1, r, scr, lane); continue; } r -= I_FIN;
        if (r < I_FIN) { tr_matrix_item(fu + (size_t)D * FF, D, FF, WB + WE_FIN_B, 2, r, scr, lane); continue; } r -= I_FIN;
        if (r < I_FDN) { tr_matrix_item(fd, FF, D, WB + WE_FDN_A, 0, r, scr, lane); continue; } r -= I_FDN;
        if (r < I_FDN) { tr_matrix_item(fd + (size_t)FF * D, FF, D, WB + WE_FDN_B, 0, r, scr, lane); continue; } r -= I_FDN;
        if (r < I_IN) { tr_matrix_item(w_in, D, NIN, WB + WE_IN, 0, r, scr, lane); continue; } r -= I_IN;
        if (r < I_QUP) { tr_matrix_item(w_qup, QL, 768, WB + WE_QUP, 0, r, scr, lane, 384, 0); continue; } r -= I_QUP;
        if (r < I_KVUP) { tr_matrix_item(w_kvup, KVL, 1024, WB + WE_QUP + (size_t)768 * 384, 0, r, scr, lane, 384, 256); continue; } r -= I_KVUP;
        if (r < I_DD) { tr_matrix_item(w_out, D, D, WB + WE_OUT, 0, r, scr, lane); continue; } r -= I_DD;
        if (r < I_PLE) { tr_matrix_item(w_ple, PLE, D, WB + WE_PLE, 0, r, scr, lane); continue; } r -= I_PLE;
        tr_matrix_item(w_pg, D, D, WB + WE_PG, 0, r, scr, lane);
    }
    {
        v4u* qk = (v4u*)(WB + WE_QUP); unsigned z0_ = 0u; asm volatile("" : "+v"(z0_)); const v4u z = {z0_, z0_, z0_, z0_};
        const int gt = gw * 64 + lane, NTT = NGW * 64;
        for (int i = gt; i < 768 * 16; i += NTT) { const int row = i >> 4, ch = i & 15; qk[(size_t)row * 48 + 32 + ch] = z; }
        for (int i = gt; i < 1024 * 32; i += NTT) { const int row = 768 + (i >> 5), ch = i & 31; qk[(size_t)row * 48 + ch] = z; }
    }
}

__device__ __forceinline__ void rope_tables(const Params& P, unsigned char* ws, int gtid, int NT) {
    const int* pos = (const int*)P.in[2];
    float* cosM = (float*)(ws + OFF_TAB); float* sinM = cosM + (size_t)T * 16; float* cosD = sinM + (size_t)T * 16; float* sinD = cosD + (size_t)T * 32;
    for (int e = gtid; e < T * 48; e += NT) {
        const int tok = e / 48, i = e % 48;
        const float inv = (i < 16) ? INV_M[i] : INV_D[i - 16];
        const float ang = (float)pos[tok] * inv;
        double tt = (double)ang * 0.15915494309189535; tt -= __builtin_rint(tt);
        const float rev = (float)tt;
        const float c = __builtin_amdgcn_cosf(rev), s = __builtin_amdgcn_sinf(rev);
        if (i < 16) { cosM[(size_t)tok * 16 + i] = c; sinM[(size_t)tok * 16 + i] = s; }
        else { cosD[(size_t)tok * 32 + i - 16] = c; sinD[(size_t)tok * 32 + i - 16] = s; }
    }
}

template <bool HAS_F>
__device__ __forceinline__ void resnorm_rows(const float* hin, float* hout, const bf16* f, float alpha, const float* ga, const float* gb, bf16* xn, int gw, int NGW, int lane) {
    for (int m = gw; m < T; m += NGW) {
        const fx4* hr = (const fx4*)(hin + (size_t)m * D) + lane;
        fx4 hv[4];
#pragma unroll
        for (int j = 0; j < 4; ++j) hv[j] = hr[64 * j];
        if (HAS_F) {
            const v2u* fr = (const v2u*)(f + (size_t)m * D) + lane;
            fx4 fv[4]; float ss = 0.f;
#pragma unroll
            for (int j = 0; j < 4; ++j) { const v2u w = fr[64 * j]; fv[j] = (fx4){bflo(w.x), bfhi(w.x), bflo(w.y), bfhi(w.y)}; ss += (fv[j].x * fv[j].x + fv[j].y * fv[j].y) + (fv[j].z * fv[j].z + fv[j].w * fv[j].w); }
            const float rstd = fast_rsq(wave_sum(ss) * (1.0f / D) + EPS) * alpha;
            fx4* ho = (fx4*)(hout + (size_t)m * D) + lane;
#pragma unroll
            for (int j = 0; j < 4; ++j) { const fx4 g = ((const fx4*)ga)[lane + 64 * j]; hv[j] = hv[j] + fv[j] * g * rstd; ho[64 * j] = hv[j]; }
        } else {
            fx4* ho = (fx4*)(hout + (size_t)m * D) + lane;
#pragma unroll
            for (int j = 0; j < 4; ++j) ho[64 * j] = hv[j];
        }
        float s2 = 0.f;
#pragma unroll
        for (int j = 0; j < 4; ++j) s2 += (hv[j].x * hv[j].x + hv[j].y * hv[j].y) + (hv[j].z * hv[j].z + hv[j].w * hv[j].w);
        const float rstd2 = fast_rsq(wave_sum(s2) * (1.0f / D) + EPS);
        v2u* xo = (v2u*)(xn + (size_t)m * D) + lane;
#pragma unroll
        for (int j = 0; j < 4; ++j) { const fx4 g = ((const fx4*)gb)[lane + 64 * j]; const fx4 y = hv[j] * g * rstd2; xo[64 * j] = (v2u){pk2(y.x, y.y), pk2(y.z, y.w)}; }
    }
}

__device__ __forceinline__ void mixer_prep_rows(const Params& P, unsigned char* ws, int layer, int gw, int NGW, int lane) {
    bf16* Z = (bf16*)(ws + OFF_HID); bf16* qkv = (bf16*)(ws + OFF_QLN); bf16* Kc = (bf16*)(ws + OFF_KCAT);
    const float* cosM = (const float*)(ws + OFF_TAB); const float* sinM = cosM + (size_t)T * 16; const float* cosD = sinM + (size_t)T * 16; const float* sinD = cosD + (size_t)T * 32;
    const float* qn = P.in[5] + (size_t)layer * QL; const float* kvn = P.in[7] + (size_t)layer * KVL;
    for (int m = gw; m < T; m += NGW) {
        bf16* z = Z + (size_t)m * NINP;
        {
            const v2u w = ((const v2u*)z)[lane]; const fx4 v = {bflo(w.x), bfhi(w.x), bflo(w.y), bfhi(w.y)};
            const float ss = (v.x * v.x + v.y * v.y) + (v.z * v.z + v.w * v.w);
            const float rstd = fast_rsq(wave_sum(ss) * (1.0f / QL) + EPS);
            const fx4 g = ((const fx4*)qn)[lane]; const fx4 y = v * g * rstd;
            ((v2u*)(qkv + (size_t)m * 384))[lane] = (v2u){pk2(y.x, y.y), pk2(y.z, y.w)};
        }
        {
            const unsigned w = ((const unsigned*)(z + 256))[lane]; const float a = bflo(w), b = bfhi(w);
            const float rstd = fast_rsq(wave_sum(a * a + b * b) * (1.0f / KVL) + EPS);
            const fx2 g = ((const fx2*)kvn)[lane];
            ((unsigned*)(qkv + (size_t)m * 384 + 256))[lane] = pk2(a * g.x * rstd, b * g.y * rstd);
        }
        if (lane < 16) {
            const float x1 = __uint_as_float((unsigned)z[384 + lane] << 16), x2 = __uint_as_float((unsigned)z[400 + lane] << 16);
            const float c = cosM[(size_t)m * 16 + lane], s = sinM[(size_t)m * 16 + lane];
            const unsigned o = pk2(x1 * c - x2 * s, x2 * c + x1 * s);
            bf16* kr = Kc + (size_t)m * 768 + 64 + lane;
#pragma unroll
            for (int h = 0; h < 8; ++h) { kr[h * 96] = (bf16)(o & 0xffffu); kr[h * 96 + 16] = (bf16)(o >> 16); }
        }
        {
            const int head = lane >> 3, c4 = lane & 7;
            const fx4 cs = ((const fx4*)(cosD + (size_t)m * 32))[c4], sn = ((const fx4*)(sinD + (size_t)m * 32))[c4];
#pragma unroll
            for (int w = 0; w < 2; ++w) {
                bf16* base = z + (w == 0 ? 416 : 928) + head * 64 + 4 * c4;
                const v2u a = *(const v2u*)base, b = *(const v2u*)(base + 32);
                const fx4 x1 = {bflo(a.x), bfhi(a.x), bflo(a.y), bfhi(a.y)}, x2 = {bflo(b.x), bfhi(b.x), bflo(b.y), bfhi(b.y)};
                const fx4 o1 = x1 * cs - x2 * sn, o2 = x2 * cs + x1 * sn;
                *(v2u*)base = (v2u){pk2(o1.x, o1.y), pk2(o1.z, o1.w)};
                *(v2u*)(base + 32) = (v2u){pk2(o2.x, o2.y), pk2(o2.z, o2.w)};
            }
        }
    }
}

__device__ __forceinline__ void merge_rows(const Params& P, unsigned char* ws, int layer, int gw, int NGW, int lane) {
    bf16* XN = (bf16*)(ws + OFF_XN); const bf16* Fb = (const bf16*)(ws + OFF_F); const float* LSE = (const float*)(ws + OFF_LSE);
    const float* gg = P.in[9] + (size_t)layer * D;
    const int head = lane >> 3;
    for (int m = gw; m < T; m += NGW) {
        const v4u wm = *(const v4u*)(XN + (size_t)m * D + 8 * lane);
        const v4u w2 = *(const v4u*)(XN + (size_t)m * D + 512 + 8 * lane);
        const v4u w0 = *(const v4u*)(Fb + (size_t)m * 512 + 8 * lane);
        const v4u w1 = *(const v4u*)(Fb + (size_t)T * 512 + (size_t)m * 512 + 8 * lane);
        const float L0 = LSE[(size_t)m * 8 + head], L1 = LSE[(size_t)T * 8 + (size_t)m * 8 + head], L2 = LSE[(size_t)2 * T * 8 + (size_t)m * 8 + head];
        const float mx = fmaxf(L0, fmaxf(L1, L2));
        float e0 = fast_exp2(L0 - mx), e1 = fast_exp2(L1 - mx), e2 = fast_exp2(L2 - mx);
        const float inv = fast_rcp(e0 + e1 + e2); e0 *= inv; e1 *= inv; e2 *= inv;
        float om[8] = {bflo(wm.x), bfhi(wm.x), bflo(wm.y), bfhi(wm.y), bflo(wm.z), bfhi(wm.z), bflo(wm.w), bfhi(wm.w)};
        float a0[8] = {bflo(w0.x), bfhi(w0.x), bflo(w0.y), bfhi(w0.y), bflo(w0.z), bfhi(w0.z), bflo(w0.w), bfhi(w0.w)};
        float a1[8] = {bflo(w1.x), bfhi(w1.x), bflo(w1.y), bfhi(w1.y), bflo(w1.z), bfhi(w1.z), bflo(w1.w), bfhi(w1.w)};
        float a2[8] = {bflo(w2.x), bfhi(w2.x), bflo(w2.y), bfhi(w2.y), bflo(w2.z), bfhi(w2.z), bflo(w2.w), bfhi(w2.w)};
        float od[8]; float ssm = 0.f, ssd = 0.f;
#pragma unroll
        for (int e = 0; e < 8; ++e) { od[e] = e0 * a0[e] + e1 * a1[e] + e2 * a2[e]; ssm += om[e] * om[e]; ssd += od[e] * od[e]; }
        const float rm = fast_rsq(wave_sum(ssm) * (1.0f / 512) + EPS), rd = fast_rsq(wave_sum(ssd) * (1.0f / 512) + EPS);
        const fx4 gm0 = ((const fx4*)gg)[2 * lane], gm1 = ((const fx4*)gg)[2 * lane + 1], gd0 = ((const fx4*)(gg + 512))[2 * lane], gd1 = ((const fx4*)(gg + 512))[2 * lane + 1];
        v4u o;
        o.x = pk2(om[0] * gm0.x * rm, om[1] * gm0.y * rm); o.y = pk2(om[2] * gm0.z * rm, om[3] * gm0.w * rm); o.z = pk2(om[4] * gm1.x * rm, om[5] * gm1.y * rm); o.w = pk2(om[6] * gm1.z * rm, om[7] * gm1.w * rm);
        *(v4u*)(XN + (size_t)m * D + 8 * lane) = o;
        o.x = pk2(od[0] * gd0.x * rd, od[1] * gd0.y * rd); o.y = pk2(od[2] * gd0.z * rd, od[3] * gd0.w * rd); o.z = pk2(od[4] * gd1.x * rd, od[5] * gd1.y * rd); o.w = pk2(od[6] * gd1.z * rd, od[7] * gd1.w * rd);
        *(v4u*)(XN + (size_t)m * D + 512 + 8 * lane) = o;
    }
}

__device__ __forceinline__ void convert_p(const Params& P, unsigned char* ws, int layer, int gtid, int NT) {
    const fx4* src = (const fx4*)(P.in[1] + (size_t)layer * T * PLE); v4u* dst = (v4u*)(ws + OFF_QLN);
    for (int i = gtid; i < T * PLE / 8; i += NT) { const fx4 a = src[2 * i], b = src[2 * i + 1]; dst[i] = (v4u){pk2(a.x, a.y), pk2(a.z, a.w), pk2(b.x, b.y), pk2(b.z, b.w)}; }
}

struct AttnArgs {
    const bf16* Q; int qs;
    const bf16* K; int ks;
    const bf16* V; int vs;
    bf16* O; int os;
    float* L; int ls;
    const float* cosT; const float* sinT;
    int q0; float c;
};
template <int DQK, bool WIN>
__device__ __forceinline__ void attn_unit(LAS unsigned char* lds, const AttnArgs& a) {
    constexpr int KCH = DQK / 8, NKC = 64 * KCH, NC = NKC + 512, NIT = (NC + 511) / 512;
    constexpr int KRS = DQK * 2 + 16, KBYTES = 64 * KRS, BUFB = KBYTES + 8192;
    constexpr int NDS = DQK / 16;
    int tid_ = threadIdx.x; asm volatile("" : "+v"(tid_));
    const int tid = tid_, lane = tid & 63, wid = __builtin_amdgcn_readfirstlane(tid >> 6), r32 = lane & 31, hi = lane >> 5;
    const int qw0 = a.q0 + 32 * wid, qpos = qw0 + r32;
    const int t_hi = (a.q0 + 256) >> 6;
    const int t_lo = WIN ? (a.q0 >= 128 ? ((a.q0 - 128) >> 6) : 0) : 0;
    v4u st[NIT];
#pragma unroll
    for (int it = 0; it < NIT; ++it) { const int c = tid + 512 * it;
        if (c < NC) { if (c < NKC) { const int row = c / KCH, ch = c % KCH; st[it] = *(const v4u*)(a.K + (long)(64 * t_lo + row) * a.ks + ch * 8); }
                      else { const int c2 = c - NKC, row = c2 >> 3, ch = c2 & 7; st[it] = *(const v4u*)(a.V + (long)(64 * t_lo + row) * a.vs + ch * 8); } } }
    hx8 qf[NDS];
    { const bf16* qrow = a.Q + (long)qpos * a.qs + 8 * hi;
#pragma unroll
      for (int ds = 0; ds < NDS; ++ds) qf[ds] = *(const hx8*)(qrow + 16 * ds);
      if (DQK == 96) {
          const fx4* cp = (const fx4*)(a.cosT + (long)qpos * 16 + 8 * hi); const fx4* sp = (const fx4*)(a.sinT + (long)qpos * 16 + 8 * hi);
          const fx4 c0 = cp[0], c1 = cp[1], s0 = sp[0], s1 = sp[1];
          const float cc[8] = {c0.x, c0.y, c0.z, c0.w, c1.x, c1.y, c1.z, c1.w}, sn[8] = {s0.x, s0.y, s0.z, s0.w, s1.x, s1.y, s1.z, s1.w};
          float n1[8], n2[8];
#pragma unroll
          for (int j = 0; j < 8; ++j) { const float x1 = __uint_as_float((unsigned)(unsigned short)qf[NDS - 2][j] << 16), x2 = __uint_as_float((unsigned)(unsigned short)qf[NDS - 1][j] << 16);
              n1[j] = x1 * cc[j] - x2 * sn[j]; n2[j] = x2 * cc[j] + x1 * sn[j]; }
          qf[NDS - 2] = __builtin_bit_cast(hx8, (v4u){pk2(n1[0], n1[1]), pk2(n1[2], n1[3]), pk2(n1[4], n1[5]), pk2(n1[6], n1[7])});
          qf[NDS - 1] = __builtin_bit_cast(hx8, (v4u){pk2(n2[0], n2[1]), pk2(n2[2], n2[3]), pk2(n2[4], n2[5]), pk2(n2[6], n2[7])});
      } }
#pragma unroll
    for (int it = 0; it < NIT; ++it) { const int c = tid + 512 * it;
        if (c < NC) { if (c < NKC) { const int row = c / KCH, ch = c % KCH; *(LAS v4u*)(lds + row * KRS + ch * 16) = st[it]; }
                      else { const int c2 = c - NKC, row = c2 >> 3, ch = c2 & 7; *(LAS v4u*)(lds + KBYTES + (ch >> 2) * 4096 + row * 64 + (ch & 3) * 16) = st[it]; } } }
    __syncthreads();
    float m_run = -INFINITY, l_run = 0.f;
    fx16 o[2];
#pragma unroll
    for (int r = 0; r < 16; ++r) { o[0][r] = 0.f; o[1][r] = 0.f; }
    const int vlane = ((lane >> 4) & 1) * 32 + (lane & 3) * 8 + (4 * hi + ((lane & 15) >> 2)) * 64;
    int cur = 0;
    for (int t = t_lo; t < t_hi; ++t) {
        const bool more = (t + 1 < t_hi);
        if (more) {
#pragma unroll
            for (int it = 0; it < NIT; ++it) { const int c = tid + 512 * it;
                if (c < NC) { if (c < NKC) { const int row = c / KCH, ch = c % KCH; st[it] = *(const v4u*)(a.K + (long)(64 * (t + 1) + row) * a.ks + ch * 8); }
                              else { const int c2 = c - NKC, row = c2 >> 3, ch = c2 & 7; st[it] = *(const v4u*)(a.V + (long)(64 * (t + 1) + row) * a.vs + ch * 8); } } }
        }
        const bool need = (64 * t <= qw0 + 31) && (!WIN || (64 * t + 63 >= qw0 - 128));
        if (need) {
            const LAS unsigned char* kb_ = lds + cur * BUFB; const LAS unsigned char* vb_ = kb_ + KBYTES + vlane;
            fx16 p[2];
#pragma unroll
            for (int kb = 0; kb < 2; ++kb) {
#pragma unroll
                for (int r = 0; r < 16; ++r) p[kb][r] = 0.f;
#pragma unroll
                for (int ds = 0; ds < NDS; ++ds) {
                    const hx8 kf = *(const LAS hx8*)(kb_ + (32 * kb + r32) * KRS + (16 * ds + 8 * hi) * 2);
                    p[kb] = __builtin_amdgcn_mfma_f32_32x32x16_bf16(kf, qf[ds], p[kb], 0, 0, 0);
                }
            }
            const bool domask = WIN || (64 * t + 63 > qw0);
            float mx = -INFINITY;
            if (domask) {
#pragma unroll
                for (int kb = 0; kb < 2; ++kb)
#pragma unroll
                    for (int r = 0; r < 16; ++r) {
                        const int kv = 64 * t + 32 * kb + (r & 3) + 8 * (r >> 2) + 4 * hi;
                        const bool ok = (kv <= qpos) && (!WIN || (qpos - kv <= 128));
                        const float v = ok ? p[kb][r] : -INFINITY; p[kb][r] = v; mx = fmaxf(mx, v);
                    }
            } else {
#pragma unroll
                for (int kb = 0; kb < 2; ++kb)
#pragma unroll
                    for (int r = 0; r < 16; ++r) mx = fmaxf(mx, p[kb][r]);
            }
            mx = fmaxf(mx, __shfl_xor(mx, 32));
            const float mnew = fmaxf(m_run, mx * a.c);
            const float muse = (mnew == -INFINITY) ? 0.f : mnew;
            const float alpha = fast_exp2(m_run - muse);
            m_run = mnew;
            float rs = 0.f;
#pragma unroll
            for (int kb = 0; kb < 2; ++kb)
#pragma unroll
                for (int r = 0; r < 16; ++r) { const float e = fast_exp2(__builtin_fmaf(p[kb][r], a.c, -muse)); p[kb][r] = e; rs += e; }
            l_run = l_run * alpha + rs;
#pragma unroll
            for (int r = 0; r < 16; ++r) { o[0][r] *= alpha; o[1][r] *= alpha; }
            hx8 pb[4];
#pragma unroll
            for (int ks = 0; ks < 4; ++ks) { const int kb = ks >> 1, s8 = (ks & 1) * 8;
                pb[ks] = __builtin_bit_cast(hx8, (v4u){pk2(p[kb][s8 + 0], p[kb][s8 + 1]), pk2(p[kb][s8 + 2], p[kb][s8 + 3]), pk2(p[kb][s8 + 4], p[kb][s8 + 5]), pk2(p[kb][s8 + 6], p[kb][s8 + 7])}); }
#pragma unroll
            for (int db = 0; db < 2; ++db)
#pragma unroll
                for (int ks = 0; ks < 4; ++ks) {
                    const hx4 lo = __builtin_bit_cast(hx4, __builtin_amdgcn_ds_read_tr16_b64_v4i16((LAS hx4*)(vb_ + db * 4096 + ks * 1024)));
                    const hx4 hh = __builtin_bit_cast(hx4, __builtin_amdgcn_ds_read_tr16_b64_v4i16((LAS hx4*)(vb_ + db * 4096 + ks * 1024 + 512)));
                    const hx8 vf = {lo[0], lo[1], lo[2], lo[3], hh[0], hh[1], hh[2], hh[3]};
                    o[db] = __builtin_amdgcn_mfma_f32_32x32x16_bf16(vf, pb[ks], o[db], 0, 0, 0);
                }
        }
        if (more) {
            LAS unsigned char* nb_ = lds + (cur ^ 1) * BUFB;
#pragma unroll
            for (int it = 0; it < NIT; ++it) { const int c = tid + 512 * it;
                if (c < NC) { if (c < NKC) { const int row = c / KCH, ch = c % KCH; *(LAS v4u*)(nb_ + row * KRS + ch * 16) = st[it]; }
                              else { const int c2 = c - NKC, row = c2 >> 3, ch = c2 & 7; *(LAS v4u*)(nb_ + KBYTES + (ch >> 2) * 4096 + row * 64 + (ch & 3) * 16) = st[it]; } } }
        }
        __syncthreads();
        cur ^= 1;
    }
    const float lt = l_run + __shfl_xor(l_run, 32);
    const float inv = fast_rcp(lt);
    bf16* orow = a.O + (long)qpos * a.os;
#pragma unroll
    for (int db = 0; db < 2; ++db)
#pragma unroll
        for (int g = 0; g < 4; ++g) {
            const v2u w = {pk2(o[db][4 * g] * inv, o[db][4 * g + 1] * inv), pk2(o[db][4 * g + 2] * inv, o[db][4 * g + 3] * inv)};
            *(v2u*)(orow + 32 * db + 8 * g + 4 * hi) = w;
        }
    if (WIN) { if (hi == 0) a.L[(long)qpos * a.ls] = m_run + __builtin_amdgcn_logf(lt); }
}

__device__ __forceinline__ void attn_unit_win(LAS unsigned char* lds, const AttnArgs& a) {
    constexpr int DQK = 64; constexpr bool WIN = true;
    constexpr int KRS = DQK * 2 + 16, KBYTES = 64 * KRS, BUFB = KBYTES + 8192, NDS = DQK / 16;
    int tid_ = threadIdx.x; asm volatile("" : "+v"(tid_));
    const int tid = tid_, lane = tid & 63, wid = __builtin_amdgcn_readfirstlane(tid >> 6), r32 = lane & 31, hi = lane >> 5;
    const int qw0 = a.q0 + 32 * wid, qpos = qw0 + r32;
    const int t_hi = (a.q0 + 256) >> 6;
    const int t_lo = a.q0 >= 128 ? ((a.q0 - 128) >> 6) : 0;
    const int nt = t_hi - t_lo;
    const int srow = tid >> 3, sch = tid & 7;
    v4u st[6][2];
#pragma unroll
    for (int s = 0; s < 6; ++s) if (s < nt) {
        st[s][0] = *(const v4u*)(a.K + (long)(64 * (t_lo + s) + srow) * a.ks + sch * 8);
        st[s][1] = *(const v4u*)(a.V + (long)(64 * (t_lo + s) + srow) * a.vs + sch * 8);
    }
    hx8 qf[NDS];
    { const bf16* qrow = a.Q + (long)qpos * a.qs + 8 * hi;
#pragma unroll
      for (int ds = 0; ds < NDS; ++ds) qf[ds] = *(const hx8*)(qrow + 16 * ds); }
#pragma unroll
    for (int s = 0; s < 6; ++s) if (s < nt) {
        *(LAS v4u*)(lds + s * BUFB + srow * KRS + sch * 16) = st[s][0];
        *(LAS v4u*)(lds + s * BUFB + KBYTES + (sch >> 2) * 4096 + srow * 64 + (sch & 3) * 16) = st[s][1];
    }
    __syncthreads();
    float m_run = -INFINITY, l_run = 0.f;
    fx16 o[2];
#pragma unroll
    for (int r = 0; r < 16; ++r) { o[0][r] = 0.f; o[1][r] = 0.f; }
    const int vlane = ((lane >> 4) & 1) * 32 + (lane & 3) * 8 + (4 * hi + ((lane & 15) >> 2)) * 64;
    for (int t = t_lo; t < t_hi; ++t) {
        const bool need = (64 * t <= qw0 + 31) && (64 * t + 63 >= qw0 - 128);
        if (need) {
            const LAS unsigned char* kb_ = lds + (t - t_lo) * BUFB; const LAS unsigned char* vb_ = kb_ + KBYTES + vlane;
            fx16 p[2];
#pragma unroll
            for (int kb = 0; kb < 2; ++kb) {
#pragma unroll
                for (int r = 0; r < 16; ++r) p[kb][r] = 0.f;
#pragma unroll
                for (int ds = 0; ds < NDS; ++ds) {
                    const hx8 kf = *(const LAS hx8*)(kb_ + (32 * kb + r32) * KRS + (16 * ds + 8 * hi) * 2);
                    p[kb] = __builtin_amdgcn_mfma_f32_32x32x16_bf16(kf, qf[ds], p[kb], 0, 0, 0);
                }
            }
            const bool domask = WIN || (64 * t + 63 > qw0);
            float mx = -INFINITY;
            if (domask) {
#pragma unroll
                for (int kb = 0; kb < 2; ++kb)
#pragma unroll
                    for (int r = 0; r < 16; ++r) {
                        const int kv = 64 * t + 32 * kb + (r & 3) + 8 * (r >> 2) + 4 * hi;
                        const bool ok = (kv <= qpos) && (!WIN || (qpos - kv <= 128));
                        const float v = ok ? p[kb][r] : -INFINITY; p[kb][r] = v; mx = fmaxf(mx, v);
                    }
            } else {
#pragma unroll
                for (int kb = 0; kb < 2; ++kb)
#pragma unroll
                    for (int r = 0; r < 16; ++r) mx = fmaxf(mx, p[kb][r]);
            }
            mx = fmaxf(mx, __shfl_xor(mx, 32));
            const float mnew = fmaxf(m_run, mx * a.c);
            const float muse = (mnew == -INFINITY) ? 0.f : mnew;
            const float alpha = fast_exp2(m_run - muse);
            m_run = mnew;
            float rs = 0.f;
#pragma unroll
            for (int kb = 0; kb < 2; ++kb)
#pragma unroll
                for (int r = 0; r < 16; ++r) { const float e = fast_exp2(__builtin_fmaf(p[kb][r], a.c, -muse)); p[kb][r] = e; rs += e; }
            l_run = l_run * alpha + rs;
#pragma unroll
            for (int r = 0; r < 16; ++r) { o[0][r] *= alpha; o[1][r] *= alpha; }
            hx8 pb[4];
#pragma unroll
            for (int ks = 0; ks < 4; ++ks) { const int kb = ks >> 1, s8 = (ks & 1) * 8;
                pb[ks] = __builtin_bit_cast(hx8, (v4u){pk2(p[kb][s8 + 0], p[kb][s8 + 1]), pk2(p[kb][s8 + 2], p[kb][s8 + 3]), pk2(p[kb][s8 + 4], p[kb][s8 + 5]), pk2(p[kb][s8 + 6], p[kb][s8 + 7])}); }
#pragma unroll
            for (int db = 0; db < 2; ++db)
#pragma unroll
                for (int ks = 0; ks < 4; ++ks) {
                    const hx4 lo = __builtin_bit_cast(hx4, __builtin_amdgcn_ds_read_tr16_b64_v4i16((LAS hx4*)(vb_ + db * 4096 + ks * 1024)));
                    const hx4 hh = __builtin_bit_cast(hx4, __builtin_amdgcn_ds_read_tr16_b64_v4i16((LAS hx4*)(vb_ + db * 4096 + ks * 1024 + 512)));
                    const hx8 vf = {lo[0], lo[1], lo[2], lo[3], hh[0], hh[1], hh[2], hh[3]};
                    o[db] = __builtin_amdgcn_mfma_f32_32x32x16_bf16(vf, pb[ks], o[db], 0, 0, 0);
                }
        }
    }
    const float lt = l_run + __shfl_xor(l_run, 32);
    const float inv = fast_rcp(lt);
    bf16* orow = a.O + (long)qpos * a.os;
#pragma unroll
    for (int db = 0; db < 2; ++db)
#pragma unroll
        for (int g = 0; g < 4; ++g) {
            const v2u w = {pk2(o[db][4 * g] * inv, o[db][4 * g + 1] * inv), pk2(o[db][4 * g + 2] * inv, o[db][4 * g + 3] * inv)};
            *(v2u*)(orow + 32 * db + 8 * g + 4 * hi) = w;
        }
    if (WIN) { if (hi == 0) a.L[(long)qpos * a.ls] = m_run + __builtin_amdgcn_logf(lt); }
    __syncthreads();
}

__device__ __forceinline__ void attention_phase(unsigned char* ws, LAS unsigned char* lds) {
    int bx_ = blockIdx.x; asm volatile("" : "+s"(bx_));
    const int G = gridDim.x, c = bx_;
    const float* cosM = (const float*)(ws + OFF_TAB); const float* sinM = cosM + (size_t)T * 16;
    bf16* XN = (bf16*)(ws + OFF_XN); bf16* Fb = (bf16*)(ws + OFF_F); float* LSE = (float*)(ws + OFF_LSE);
    const bf16* Z = (const bf16*)(ws + OFF_HID); const bf16* Qb = (const bf16*)(ws + OFF_Q);
    const bf16* Kc = (const bf16*)(ws + OFF_KCAT); const bf16* Vm = (const bf16*)(ws + OFF_V);
#ifdef EXP_MLA2
    for (int rep_ = 0; rep_ < 2; ++rep_)
#endif
    for (int pi = c; pi < 512; pi += G) {
        const int bh = pi >> 4, s = pi & 15, b = bh >> 3, h = bh & 7;
        const size_t tok0 = (size_t)b * SEQ;
        AttnArgs a;
        a.Q = Qb + tok0 * 768 + h * 96; a.qs = 768; a.K = Kc + tok0 * 768 + h * 96; a.ks = 768; a.V = Vm + tok0 * 512 + h * 64; a.vs = 512;
        a.O = XN + tok0 * D + h * 64; a.os = D; a.L = nullptr; a.ls = 0; a.cosT = cosM + tok0 * 16; a.sinT = sinM + tok0 * 16;
        a.c = 0.10206207261596577f * 1.4426950408889634f;
        for (int half = 0; half < 2; ++half) { a.q0 = half ? 256 * s : 256 * (31 - s); attn_unit<96, false>(lds, a); }
    }
#ifdef EXP_DIL2
    for (int rep_ = 0; rep_ < 2; ++rep_)
#endif
    for (int u = c; u < 3072; u += G) {
        const int br = u >> 10, rem = u & 1023, b = rem >> 8, h = (rem >> 5) & 7, idx = rem & 31;
        const int dil = (br == 0) ? 1 : (br == 1 ? 4 : 16); const int nsub = 32 / dil; const int r = idx / nsub, n = idx % nsub;
        const size_t tok0 = (size_t)b * SEQ + r;
        AttnArgs a;
        a.Q = Z + tok0 * NINP + 416 + h * 64; a.qs = NINP * dil; a.K = Z + tok0 * NINP + 928 + h * 64; a.ks = a.qs; a.V = Z + tok0 * NINP + 1440 + h * 64; a.vs = a.qs;
        if (br < 2) { a.O = Fb + (size_t)br * T * 512 + tok0 * 512 + h * 64; a.os = 512 * dil; }
        else { a.O = XN + tok0 * D + 512 + h * 64; a.os = D * dil; }
        a.L = LSE + (size_t)br * T * 8 + tok0 * 8 + h; a.ls = 8 * dil; a.cosT = nullptr; a.sinT = nullptr;
        a.c = 0.125f * 1.4426950408889634f; a.q0 = 256 * n;
        attn_unit_win(lds, a);
    }
}

#define XB_TMO      128
#define XB_XCNT(j)  (256  + 64 * (j))
#define XB_XSUB(j)  (1280 + 64 * (j))
#define XB_XGEN(j)  (2304 + 64 * (j))
#define XB_TOP      3328
#define XB_TOPGEN   3392
#define XCD_BAR_WORDS 3456
#define XB_SPIN_CAP (1u << 18)

__device__ __forceinline__ unsigned xb_ld(unsigned* p)              { return __hip_atomic_load(p, __ATOMIC_RELAXED, __HIP_MEMORY_SCOPE_AGENT); }
__device__ __forceinline__ unsigned xb_add(unsigned* p, unsigned v) { return __hip_atomic_fetch_add(p, v, __ATOMIC_RELAXED, __HIP_MEMORY_SCOPE_AGENT); }
__device__ __forceinline__ unsigned xb_xcc_id() { return (unsigned)__builtin_amdgcn_s_getreg((3 << 11) | 20) & 0xFu; }
#define XB_SPIN(cond, bar) do { unsigned _sp = 0; while (cond) { __builtin_amdgcn_s_sleep(1); \
    if ((++_sp & 255u) == 0u) { if (xb_ld(&(bar)[XB_TMO])) break; if (_sp > XB_SPIN_CAP) { atomicAdd(&(bar)[XB_TMO], 1u); break; } } } } while (0)

struct XcdBarrier {
    unsigned* bar; unsigned x;
    volatile LAS unsigned* st;
};

__device__ __forceinline__ XcdBarrier xcd_barrier_post(unsigned* bar, volatile LAS unsigned* st) {
    XcdBarrier b; b.bar = bar; b.x = xb_xcc_id(); b.st = st;
    if (threadIdx.x == 0) (void)xb_add(&bar[XB_XCNT(b.x)], 1u);
    return b;
}
__device__ __forceinline__ void xcd_barrier_complete(unsigned* bar, unsigned x, unsigned& nloc, unsigned& nx) {
    const unsigned G = gridDim.x * gridDim.y * gridDim.z;
    unsigned sum, cnt, mine, sp = 0u;
    for (;;) {
        sum = 0u; cnt = 0u; mine = 0u;
#pragma unroll
        for (unsigned j = 0; j < 16; ++j) { const unsigned c = xb_ld(&bar[XB_XCNT(j)]); sum += c; cnt += (c > 0u) ? 1u : 0u; mine = (j == x) ? c : mine; }
        if (sum == G) break;
        __builtin_amdgcn_s_sleep(1);
        if ((++sp & 255u) == 0u) { if (xb_ld(&bar[XB_TMO])) break; if (sp > XB_SPIN_CAP) { atomicAdd(&bar[XB_TMO], 1u); break; } }
    }
    nloc = mine > 0u ? mine : 1u; nx = cnt > 0u ? cnt : 1u;
}

__device__ __forceinline__ void xcd_barrier(const XcdBarrier& b) {
    asm volatile("s_waitcnt vmcnt(0)" ::: "memory");
    __syncthreads();
    if (threadIdx.x == 0) {
        unsigned* bar = b.bar;
        __builtin_amdgcn_s_waitcnt(0);
        unsigned nloc = b.st[0], nx = b.st[1];
        if (nloc == 0u) { xcd_barrier_complete(bar, b.x, nloc, nx); b.st[0] = nloc; b.st[1] = nx; }
        const unsigned old = xb_add(&bar[XB_XSUB(b.x)], 1u);
        const unsigned gen = old / nloc;
        if (old + 1u == (gen + 1u) * nloc) {
            __builtin_amdgcn_fence(__ATOMIC_RELEASE, "agent");
            asm volatile("s_waitcnt vmcnt(0)" ::: "memory");
            const unsigned og = xb_add(&bar[XB_TOP], 1u);
            const unsigned tg = og / nx;
            if (og + 1u == (tg + 1u) * nx) xb_add(&bar[XB_TOPGEN], 1u);
            else XB_SPIN(xb_ld(&bar[XB_TOPGEN]) == tg, bar);
            __builtin_amdgcn_fence(__ATOMIC_ACQUIRE, "agent");
            xb_add(&bar[XB_XGEN(b.x)], 1u);
            asm volatile("s_waitcnt vmcnt(0)" ::: "memory");
        } else {
            XB_SPIN(xb_ld(&bar[XB_XGEN(b.x)]) == gen, bar);
            __builtin_amdgcn_fence(__ATOMIC_ACQUIRE, "agent");
            asm volatile("s_waitcnt vmcnt(0)" ::: "memory");
        }
    }
    __syncthreads();
}


#ifdef NO_GEMM
#define GEMM_PHASE(EPI, Aptr, Bptr, Nn, Kk, Eobj) do { (void)(Eobj); } while (0)
#else
#define GEMM_PHASE(EPI, Aptr, Bptr, Nn, Kk, Eobj) do { int bx_ = blockIdx.x; asm volatile("" : "+s"(bx_)); pg8::Gemm g_{(const pg8::bf16_t*)(Aptr), (const pg8::bf16_t*)(Bptr), T, (Nn), (Kk)}; pg8::StaticOrder S_; S_.init(T, (Nn), (int)gridDim.x, bx_); \
    pg8::gemm_phase<EPI, pg8::StaticOrder, true, true>(lds, g_, S_, (Eobj)); } while (0)
#endif
#define PH_IDS int tid = threadIdx.x; asm volatile("" : "+v"(tid)); const int lane = tid & 63, wave = __builtin_amdgcn_readfirstlane(tid >> 6); int bxp = blockIdx.x; asm volatile("" : "+s"(bxp)); \
    const int gw = bxp * 8 + wave, NGW = gridDim.x * 8, gtid = bxp * NTHREADS + tid, NT = gridDim.x * NTHREADS; (void)lane; (void)gw; (void)NGW; (void)gtid; (void)NT;
#define GASP(T_, p_) ((T_*)(__attribute__((address_space(1))) T_*)(p_))
#define PH_WS unsigned char* ws = P.ws;
#define WP(off) ((bf16*)(ws + (off)))
#define WBP(eoff) ((bf16*)(ws + OFF_WB) + (eoff))

__global__ void __launch_bounds__(NTHREADS, 2) mega_fwd(Params Pk) {
    Params P;
#pragma unroll
    for (int i = 0; i < 16; ++i) P.in[i] = GASP(const float, Pk.in[i]);
    P.out = GASP(float, Pk.out); P.ws = GASP(unsigned char, Pk.ws);
    extern __shared__ __attribute__((aligned(16))) unsigned char lds_raw[];
    LAS unsigned char* lds = (LAS unsigned char*)lds_raw;
    cg::grid_group grid = cg::this_grid();
    volatile LAS unsigned* bst = (volatile LAS unsigned*)(lds + 131072);
    if (threadIdx.x < 2) bst[threadIdx.x] = 0u;
    __syncthreads();
    const XcdBarrier bar = xcd_barrier_post((unsigned*)(P.ws + OFF_BAR), bst);
#define GSYNC() xcd_barrier(bar)

    { PH_IDS PH_WS
      convert_weights(P, ws, 0, lds, gw, NGW, wave, lane);
      rope_tables(P, ws, gtid, NT);
      resnorm_rows<false>(P.in[0], P.out, nullptr, 0.f, nullptr, P.in[3], WP(OFF_XN), gw, NGW, lane); }
    grid.sync();

    { const int layer = 0;
        { PH_WS pg8::EpiSwiglu E{WP(OFF_HID), FF}; GEMM_PHASE(pg8::EpiSwiglu, WP(OFF_XN), WBP(WE_FIN_A), 2 * FF, D, E); }
        GSYNC();
        { PH_WS pg8::EpiBf16<0> E{WP(OFF_F), D, nullptr, 0, 0, 1.f}; GEMM_PHASE(pg8::EpiBf16<0>, WP(OFF_HID), WBP(WE_FDN_A), D, FF, E); }
        GSYNC();
        { PH_IDS PH_WS const float* gains = P.in[3] + (size_t)layer * 8 * D;
          resnorm_rows<true>(P.out, P.out, WP(OFF_F), 0.5f, gains + 1 * D, gains + 2 * D, WP(OFF_XN), gw, NGW, lane); }
        GSYNC();
        { PH_WS pg8::EpiBf16<0> E{WP(OFF_HID), NINP, nullptr, 0, 0, 1.f}; GEMM_PHASE(pg8::EpiBf16<0>, WP(OFF_XN), WBP(WE_IN), NINP, D, E); }
        GSYNC();
        { PH_IDS PH_WS mixer_prep_rows(P, ws, layer, gw, NGW, lane); }
        GSYNC();
        { PH_WS pg8::EpiQKV E{WP(OFF_Q), WP(OFF_KCAT), WP(OFF_V)}; int kq_ = 384; asm volatile("" : "+s"(kq_)); GEMM_PHASE(pg8::EpiQKV, WP(OFF_QLN), WBP(WE_QUP), 1792, kq_, E); }
        GSYNC();
#ifndef NO_ATTN
        { PH_WS attention_phase(ws, lds); }
#endif
        GSYNC();
#ifdef EXP_SYNC
        for (int rep_ = 0; rep_ < 16; ++rep_) GSYNC();
#endif
        { PH_IDS PH_WS merge_rows(P, ws, layer, gw, NGW, lane); }
        GSYNC();
        { PH_WS pg8::EpiBf16<0> E{WP(OFF_F), D, nullptr, 0, 0, 1.f}; GEMM_PHASE(pg8::EpiBf16<0>, WP(OFF_XN), WBP(WE_OUT), D, D, E); }
        GSYNC();
        { PH_IDS PH_WS const float* gains = P.in[3] + (size_t)layer * 8 * D;
          resnorm_rows<true>(P.out, P.out, WP(OFF_F), 1.0f, gains + 3 * D, gains + 4 * D, WP(OFF_XN), gw, NGW, lane);
          convert_p(P, ws, layer, gtid, NT); }
        GSYNC();
        { PH_WS pg8::EpiSwiglu E{WP(OFF_HID), FF}; GEMM_PHASE(pg8::EpiSwiglu, WP(OFF_XN), WBP(WE_FIN_B), 2 * FF, D, E); }
        GSYNC();
        { PH_WS pg8::EpiBf16<0> E{WP(OFF_F), D, nullptr, 0, 0, 1.f}; GEMM_PHASE(pg8::EpiBf16<0>, WP(OFF_HID), WBP(WE_FDN_B), D, FF, E); }
        GSYNC();
        { PH_IDS PH_WS const float* gains = P.in[3] + (size_t)layer * 8 * D;
          resnorm_rows<true>(P.out, P.out, WP(OFF_F), 0.5f, gains + 5 * D, gains + 6 * D, WP(OFF_XN), gw, NGW, lane); }
        { PH_WS pg8::EpiBf16<0> E{WP(OFF_HID), D, nullptr, 0, 0, 1.f}; GEMM_PHASE(pg8::EpiBf16<0>, WP(OFF_QLN), WBP(WE_PLE), D, PLE, E); }
        GSYNC();
        { PH_WS pg8::EpiGate E{WP(OFF_F), WP(OFF_HID), D}; GEMM_PHASE(pg8::EpiGate, WP(OFF_XN), WBP(WE_PG), D, D, E); }
        GSYNC();
        { PH_IDS PH_WS const float* gains = P.in[3] + (size_t)layer * 8 * D;
          resnorm_rows<true>(P.out, P.out, WP(OFF_F), 1.0f, gains + 7 * D, P.in[3] + (size_t)((layer + 1) & 1) * 8 * D, WP(OFF_XN), gw, NGW, lane);
          if (layer == 0) convert_weights(P, ws, 1, lds, gw, NGW, wave, lane); }
        if (layer == 0) GSYNC();
    }
    { const int layer = 1;
        { PH_WS pg8::EpiSwiglu E{WP(OFF_HID), FF}; GEMM_PHASE(pg8::EpiSwiglu, WP(OFF_XN), WBP(WE_FIN_A), 2 * FF, D, E); }
        GSYNC();
        { PH_WS pg8::EpiBf16<0> E{WP(OFF_F), D, nullptr, 0, 0, 1.f}; GEMM_PHASE(pg8::EpiBf16<0>, WP(OFF_HID), WBP(WE_FDN_A), D, FF, E); }
        GSYNC();
        { PH_IDS PH_WS const float* gains = P.in[3] + (size_t)layer * 8 * D;
          resnorm_rows<true>(P.out, P.out, WP(OFF_F), 0.5f, gains + 1 * D, gains + 2 * D, WP(OFF_XN), gw, NGW, lane); }
        GSYNC();
        { PH_WS pg8::EpiBf16<0> E{WP(OFF_HID), NINP, nullptr, 0, 0, 1.f}; GEMM_PHASE(pg8::EpiBf16<0>, WP(OFF_XN), WBP(WE_IN), NINP, D, E); }
        GSYNC();
        { PH_IDS PH_WS mixer_prep_rows(P, ws, layer, gw, NGW, lane); }
        GSYNC();
        { PH_WS pg8::EpiQKV E{WP(OFF_Q), WP(OFF_KCAT), WP(OFF_V)}; int kq_ = 384; asm volatile("" : "+s"(kq_)); GEMM_PHASE(pg8::EpiQKV, WP(OFF_QLN), WBP(WE_QUP), 1792, kq_, E); }
        GSYNC();
#ifndef NO_ATTN
        { PH_WS attention_phase(ws, lds); }
#endif
        GSYNC();
#ifdef EXP_SYNC
        for (int rep_ = 0; rep_ < 16; ++rep_) GSYNC();
#endif
        { PH_IDS PH_WS merge_rows(P, ws, layer, gw, NGW, lane); }
        GSYNC();
        { PH_WS pg8::EpiBf16<0> E{WP(OFF_F), D, nullptr, 0, 0, 1.f}; GEMM_PHASE(pg8::EpiBf16<0>, WP(OFF_XN), WBP(WE_OUT), D, D, E); }
        GSYNC();
        { PH_IDS PH_WS const float* gains = P.in[3] + (size_t)layer * 8 * D;
          resnorm_rows<true>(P.out, P.out, WP(OFF_F), 1.0f, gains + 3 * D, gains + 4 * D, WP(OFF_XN), gw, NGW, lane);
          convert_p(P, ws, layer, gtid, NT); }
        GSYNC();
        { PH_WS pg8::EpiSwiglu E{WP(OFF_HID), FF}; GEMM_PHASE(pg8::EpiSwiglu, WP(OFF_XN), WBP(WE_FIN_B), 2 * FF, D, E); }
        GSYNC();
        { PH_WS pg8::EpiBf16<0> E{WP(OFF_F), D, nullptr, 0, 0, 1.f}; GEMM_PHASE(pg8::EpiBf16<0>, WP(OFF_HID), WBP(WE_FDN_B), D, FF, E); }
        GSYNC();
        { PH_IDS PH_WS const float* gains = P.in[3] + (size_t)layer * 8 * D;
          resnorm_rows<true>(P.out, P.out, WP(OFF_F), 0.5f, gains + 5 * D, gains + 6 * D, WP(OFF_XN), gw, NGW, lane); }
        { PH_WS pg8::EpiBf16<0> E{WP(OFF_HID), D, nullptr, 0, 0, 1.f}; GEMM_PHASE(pg8::EpiBf16<0>, WP(OFF_QLN), WBP(WE_PLE), D, PLE, E); }
        GSYNC();
        { PH_WS pg8::EpiGate E{WP(OFF_F), WP(OFF_HID), D}; GEMM_PHASE(pg8::EpiGate, WP(OFF_XN), WBP(WE_PG), D, D, E); }
        GSYNC();
        { PH_IDS PH_WS const float* gains = P.in[3] + (size_t)layer * 8 * D;
          resnorm_rows<true>(P.out, P.out, WP(OFF_F), 1.0f, gains + 7 * D, P.in[3] + (size_t)((layer + 1) & 1) * 8 * D, WP(OFF_XN), gw, NGW, lane);
          if (layer == 0) convert_weights(P, ws, 1, lds, gw, NGW, wave, lane); }
        if (layer == 0) GSYNC();
    }
}

extern "C" void kernel_launch(void* const* d_in, const int* in_sizes, int n_in, void* d_out, int out_size, void* d_ws, size_t ws_size, hipStream_t stream) {
    static int grid = 0;
    if (grid == 0) {
        if (n_in != 16 || out_size != T * D || ws_size < WS_NEED) { fprintf(stderr, "kernel_launch: unexpected shapes (n_in %d out %d ws %zu)\n", n_in, out_size, ws_size); grid = -1; return; }
        int dev = 0, cus = 0, per_cu = 0;
        hipGetDevice(&dev); hipDeviceGetAttribute(&cus, hipDeviceAttributeMultiprocessorCount, dev);
        hipFuncSetAttribute((const void*)mega_fwd, hipFuncAttributeMaxDynamicSharedMemorySize, LDS_BYTES);
        hipOccupancyMaxActiveBlocksPerMultiprocessor(&per_cu, (const void*)mega_fwd, NTHREADS, LDS_BYTES);
        (void)hipGetLastError();
        if (per_cu < 1) fprintf(stderr, "kernel_launch: occupancy query says %d\n", per_cu);
        grid = cus;
    }
    if (grid < 0) return;
    if (hipMemsetAsync((char*)d_ws + OFF_BAR, 0, BAR_BYTES, stream) != hipSuccess) { fprintf(stderr, "kernel_launch: memset failed\n"); return; }
    Params p{};
    for (int i = 0; i < 16; ++i) p.in[i] = (const float*)d_in[i];
    p.out = (float*)d_out; p.ws = (unsigned char*)d_ws;
    void* args[] = {&p};
    hipError_t e = hipLaunchCooperativeKernel((const void*)mega_fwd, dim3(grid), dim3(NTHREADS), args, LDS_BYTES, stream);
    if (e != hipSuccess) fprintf(stderr, "cooperative launch failed: %s (grid %d)\n", hipGetErrorString(e), grid);
}
```

```cpp
#include <hip/hip_runtime.h>
#include <hip/hip_cooperative_groups.h>
#include <cstdio>
#include <cstdint>
#include <cmath>
namespace cg = cooperative_groups;
namespace pg8 {
#define PG8_LAS __attribute__((address_space(3)))
typedef unsigned short bf16_t;
typedef short bf16x8 __attribute__((ext_vector_type(8)));
typedef float f32x4 __attribute__((ext_vector_type(4)));
typedef unsigned u32x4 __attribute__((ext_vector_type(4)));
constexpr int BM = 256, BK = 64, HALF = 128, HTB = HALF * BK * 2  , STAGE_BYTES = 8 * HTB, NXCD = 8, WGM = 8;

__host__ __device__ __forceinline__ int lds_byte(int r, int c) { const int st = (r >> 4) * 2 + (c >> 5), rr = r & 15, cc = c & 31, ob = rr * 64 + cc * 2; return st * 1024 + (ob ^ (((ob >> 9) & 1) << 5)); }
__host__ __device__ __forceinline__ void stage_rc(int b, int& R, int& C) { const int st = b / 1024, sb = b % 1024, swz = sb ^ (((sb >> 9) & 1) << 5); R = (st >> 1) * 16 + swz / 64; C = (st & 1) * 32 + (swz % 64) / 2; }
__host__ __device__ __forceinline__ int perm32(int rho) { const int n = rho >> 4, i = rho & 15; return 8 * (i >> 2) + 4 * n + (i & 3); }

struct Unit { int pm, pn; };
struct Gemm { const bf16_t* A; const bf16_t* Bt; int M, N, K; };

struct StaticOrder {
    int nM, nN, nwg, G, c;
    __host__ __device__ void init(int M, int N, int G_, int c_) { nM = M / BM; nN = N / BM; nwg = nM * nN; G = G_; c = c_; }
    __host__ __device__ bool next(int i, Unit& u) const {
        const long L = (long)i * G + c; if (L >= nwg) return false;
        int wgid = (int)L; { const int q = nwg / NXCD, r = nwg % NXCD, xcd = wgid % NXCD, off = wgid / NXCD; wgid = (xcd < r ? xcd * (q + 1) : r * (q + 1) + (xcd - r) * q) + off; }
        const int nig = WGM * nN, gid = wgid / nig, fm = gid * WGM, gsz = (nM - fm) < WGM ? (nM - fm) : WGM;
        u.pm = fm + ((wgid % nig) % gsz); u.pn = (wgid % nig) / gsz; return true;
    }
    __device__ __forceinline__ void a_ready(const Unit&) const {}
    __device__ __forceinline__ void done(const Unit&) const {}
};

__device__ __forceinline__ unsigned cvt_pk_bf16(float lo, float hi) { unsigned r; asm volatile("v_cvt_pk_bf16_f32 %0, %1, %2" : "=v"(r) : "v"(lo), "v"(hi)); return r; }
typedef float f32x2 __attribute__((ext_vector_type(2)));
__device__ __forceinline__ f32x2 gelu_pk(f32x2 v) {
    const f32x2 av = __builtin_elementwise_abs(v), d = av * 0.2316418882f + 1.0f;
    f32x2 t; t.x = __builtin_amdgcn_rcpf(d.x); t.y = __builtin_amdgcn_rcpf(d.y);
    f32x2 q = t * 0.5307027145f + (-0.7265760135f); q = q * t + 0.7107068705f; q = q * t + (-0.142248368f); q = q * t + 0.127414796f; q = q * t;
    const f32x2 s = (v * v) * (-0.72134752044f);
    f32x2 e; e.x = __builtin_amdgcn_exp2f(s.x); e.y = __builtin_amdgcn_exp2f(s.y);
    const f32x2 m = v * (q * e), r = v - m;
    f32x2 o; o.x = v.x < 0.f ? m.x : r.x; o.y = v.y < 0.f ? m.y : r.y; return o;
}

template <int ACT  > struct EpiBf16 {
    static constexpr bool PERM = true, AFTER_DRAIN = false; static_assert(ACT == 0 || ACT == 1, "EpiBf16: ACT is 0 (none) or 1 (gelu_pk)");
    bf16_t* O; int ldc; const float* bias; int split_cols; size_t split_stride; float scale0;
    __device__ __forceinline__ void operator()(const f32x4 (&acc)[2][2][4][2], const Unit& u, int wr, int wc, int fr, int fq) const {
        const int row0 = u.pm * BM + wr * 64 + fr; int colt = u.pn * BM; bf16_t* base = O;
        float sc = 1.f; if (split_cols) { const int t = colt / split_cols; base += (size_t)t * split_stride; colt -= t * split_cols; if (t == 0) sc = scale0; }
        const int col0 = colt + wc * 32 + 8 * fq, bcol0 = u.pn * BM + wc * 32 + 8 * fq;
        f32x4 bv[2][2];
#pragma unroll
        for (int bj = 0; bj < 2; ++bj)
#pragma unroll
            for (int n = 0; n < 2; ++n) bv[bj][n] = bias ? *(const f32x4*)(bias + bcol0 + bj * HALF + 4 * n) : (f32x4){0.f, 0.f, 0.f, 0.f};
#pragma unroll
        for (int ai = 0; ai < 2; ++ai)
#pragma unroll
            for (int m = 0; m < 4; ++m) { bf16_t* rowp = base + (size_t)(row0 + ai * HALF + m * 16) * ldc + col0;
#pragma unroll
                for (int bj = 0; bj < 2; ++bj) { f32x4 v0 = acc[ai][bj][m][0] + bv[bj][0], v1 = acc[ai][bj][m][1] + bv[bj][1];
                    if (ACT == 1) { f32x2 a = gelu_pk((f32x2){v0[0], v0[1]}), b = gelu_pk((f32x2){v0[2], v0[3]}), c = gelu_pk((f32x2){v1[0], v1[1]}), d = gelu_pk((f32x2){v1[2], v1[3]});
                        v0 = (f32x4){a.x, a.y, b.x, b.y}; v1 = (f32x4){c.x, c.y, d.x, d.y}; }
                    v0 = v0 * sc; v1 = v1 * sc; u32x4 w; w.x = cvt_pk_bf16(v0[0], v0[1]); w.y = cvt_pk_bf16(v0[2], v0[3]); w.z = cvt_pk_bf16(v1[0], v1[1]); w.w = cvt_pk_bf16(v1[2], v1[3]);
                    *(u32x4*)(rowp + bj * HALF) = w; } }
    }
};

template <class Epi, class Sched, bool ALIGN_EPI = false, bool SP2 = false>
__device__ __forceinline__ void gemm_phase(PG8_LAS unsigned char* lds, const Gemm g, const Sched& S, const Epi& E) {
    int tid_ = threadIdx.x; asm volatile("" : "+v"(tid_));
    const int tid = tid_, wid = __builtin_amdgcn_readfirstlane(tid >> 6), lane = tid & 63, wr = wid >> 2, wc = wid & 3, fr = lane & 15, fq = lane >> 4;
    const int K = g.K, nt = K / BK;
    unsigned voffA[2], voffB[2];
#pragma unroll
    for (int i = 0; i < 2; ++i) { int R, C; stage_rc(tid * 16 + i * 8192, R, C); const int Rb = Epi::PERM ? ((R & ~31) + perm32(R & 31)) : R;
        voffA[i] = (unsigned)(R * K + C) * 2u; voffB[i] = (unsigned)(Rb * K + C) * 2u; }
    const size_t kstep = (size_t)(BK * 2);
    const size_t hstep = (size_t)HALF * K * 2;
    const size_t tstep = 2 * hstep;
    const unsigned ldsw = (unsigned)wid * 1024u;
    const int aoff = lds_byte(wr * 64 + fr, fq * 8), boff = lds_byte(wc * 32 + fr, fq * 8);
#define PG8_SA(b, h) (((b) * 2 + (h)) * HTB)
#define PG8_SB(b, h) ((4 + (b) * 2 + (h)) * HTB)
#define PG8_STAGE(bufoff, gbase, voff) do { _Pragma("unroll") for (int _i = 0; _i < 2; ++_i) \
        __builtin_amdgcn_global_load_lds((const unsigned*)((const char*)(gbase) + (voff)[_i]), (PG8_LAS unsigned*)(lds + (bufoff) + ldsw + _i * 8192), 16, 0, 0); } while (0)
#define PG8_LDA(dst, b, h) do { _Pragma("unroll") for (int m = 0; m < 4; ++m) _Pragma("unroll") for (int k = 0; k < 2; ++k) dst[m][k] = *(const PG8_LAS bf16x8*)(lds + PG8_SA(b, h) + aoff + m * 2048 + k * 1024); } while (0)
#define PG8_LDB(dst, b, h) do { _Pragma("unroll") for (int n = 0; n < 2; ++n) _Pragma("unroll") for (int k = 0; k < 2; ++k) dst[n][k] = *(const PG8_LAS bf16x8*)(lds + PG8_SB(b, h) + boff + n * 2048 + k * 1024); } while (0)
#define PG8_MMA(ai, bj, At, Bt) do { __builtin_amdgcn_s_setprio(1); _Pragma("unroll") for (int m = 0; m < 4; ++m) _Pragma("unroll") for (int n = 0; n < 2; ++n) _Pragma("unroll") for (int k = 0; k < 2; ++k) \
        acc[ai][bj][m][n] = __builtin_amdgcn_mfma_f32_16x16x32_bf16(Bt[n][k], At[m][k], acc[ai][bj][m][n], 0, 0, 0); __builtin_amdgcn_s_setprio(0); } while (0)
#define PG8_WAIT_V(n) asm volatile("s_waitcnt vmcnt(" #n ")" ::: "memory")
#define PG8_WAIT_L(n) asm volatile("s_waitcnt lgkmcnt(" #n ")" ::: "memory")
#define PG8_BAR __builtin_amdgcn_s_barrier()
#define PG8_SCHED __builtin_amdgcn_sched_barrier(0)
    float zf_ = 0.f; asm volatile("" : "+v"(zf_)); const f32x4 zero4_ = {zf_, zf_, zf_, zf_};
    Unit cur, nxt; int ui = 0;
    if (!S.next(0, cur)) return;
    f32x4 acc[2][2][4][2];
#pragma unroll
    for (int a = 0; a < 2; ++a)
#pragma unroll
        for (int b = 0; b < 2; ++b)
#pragma unroll
            for (int m = 0; m < 4; ++m)
#pragma unroll
                for (int n = 0; n < 2; ++n) acc[a][b][m][n] = zero4_;
    bf16x8 At[4][2], B0[2][2], B1[2][2];
    const char* cA = (const char*)g.A + (size_t)cur.pm * tstep; const char* cB = (const char*)g.Bt + (size_t)cur.pn * tstep;
    S.a_ready(cur);
    if constexpr (SP2) {
        PG8_STAGE(PG8_SB(0, 0), cB, voffB); PG8_STAGE(PG8_SB(0, 1), cB + hstep, voffB); PG8_STAGE(PG8_SA(0, 0), cA, voffA); PG8_STAGE(PG8_SA(0, 1), cA + hstep, voffA);
        if (wr == 1) PG8_BAR;
        PG8_WAIT_V(2); PG8_BAR;
        PG8_STAGE(PG8_SB(1, 0), cB + kstep, voffB); PG8_STAGE(PG8_SA(1, 0), cA + kstep, voffA); PG8_STAGE(PG8_SB(1, 1), cB + hstep + kstep, voffB);
        PG8_WAIT_V(6); PG8_BAR;
    } else {
        PG8_STAGE(PG8_SB(0, 0), cB, voffB); PG8_STAGE(PG8_SA(0, 0), cA, voffA); PG8_STAGE(PG8_SB(0, 1), cB + hstep, voffB); PG8_STAGE(PG8_SA(0, 1), cA + hstep, voffA);
        if (wr == 1) PG8_BAR;
        PG8_WAIT_V(4); PG8_BAR;
        PG8_STAGE(PG8_SB(1, 0), cB + kstep, voffB); PG8_STAGE(PG8_SA(1, 0), cA + kstep, voffA); PG8_STAGE(PG8_SB(1, 1), cB + hstep + kstep, voffB);
        PG8_WAIT_V(6); PG8_BAR;
    }
    for (;;) {
        const bool has_next = S.next(ui + 1, nxt);
        const char* nA = has_next ? (const char*)g.A + (size_t)nxt.pm * tstep : cA; const char* nB = has_next ? (const char*)g.Bt + (size_t)nxt.pn * tstep : cB;
        for (int t = 0; t < nt; t += 2) {
            const bool last = (t == nt - 2);
            const char* a1 = cA + (size_t)(t + 1) * kstep;
            const char* a2 = last ? nA : cA + (size_t)(t + 2) * kstep; const char* b2 = last ? nB : cB + (size_t)(t + 2) * kstep;
            const char* a3 = a2 + kstep; const char* b3 = b2 + kstep;
            if (last && has_next) S.a_ready(nxt);
            if constexpr (SP2) {
            PG8_LDB(B0, 0, 0); PG8_LDB(B1, 0, 1); PG8_SCHED; PG8_LDA(At, 0, 0); PG8_STAGE(PG8_SA(1, 1), a1 + hstep, voffA);
            PG8_WAIT_V(8); PG8_WAIT_L(0); PG8_BAR; PG8_MMA(0, 0, At, B0); PG8_MMA(0, 1, At, B1); PG8_BAR; PG8_SCHED;
            PG8_LDA(At, 0, 1); PG8_STAGE(PG8_SB(0, 0), b2, voffB); PG8_STAGE(PG8_SB(0, 1), b2 + hstep, voffB); PG8_STAGE(PG8_SA(0, 0), a2, voffA);
            PG8_WAIT_V(8); PG8_WAIT_L(0); PG8_BAR; PG8_MMA(1, 0, At, B0); PG8_MMA(1, 1, At, B1); PG8_BAR; PG8_SCHED;
            PG8_LDB(B0, 1, 0); PG8_LDB(B1, 1, 1); PG8_SCHED; PG8_LDA(At, 1, 0); PG8_STAGE(PG8_SA(0, 1), a2 + hstep, voffA);
            PG8_WAIT_V(8); PG8_WAIT_L(0); PG8_BAR; PG8_MMA(0, 0, At, B0); PG8_MMA(0, 1, At, B1); PG8_BAR; PG8_SCHED;
            PG8_LDA(At, 1, 1); PG8_STAGE(PG8_SB(1, 0), b3, voffB); PG8_STAGE(PG8_SB(1, 1), b3 + hstep, voffB); PG8_STAGE(PG8_SA(1, 0), a3, voffA);
            PG8_WAIT_V(8); PG8_WAIT_L(0); PG8_BAR; PG8_MMA(1, 0, At, B0); PG8_MMA(1, 1, At, B1); PG8_BAR; PG8_SCHED;
            } else {
            PG8_LDB(B0, 0, 0); PG8_SCHED; PG8_LDA(At, 0, 0); PG8_STAGE(PG8_SA(1, 1), a1 + hstep, voffA);
            PG8_WAIT_L(8); PG8_BAR; PG8_WAIT_L(0); PG8_MMA(0, 0, At, B0); PG8_BAR; PG8_SCHED;
            PG8_LDB(B1, 0, 1); PG8_STAGE(PG8_SB(0, 0), b2, voffB);
            PG8_BAR; PG8_WAIT_L(0); PG8_MMA(0, 1, At, B1); PG8_BAR;
            PG8_LDA(At, 0, 1); PG8_STAGE(PG8_SA(0, 0), a2, voffA);
            PG8_BAR; PG8_WAIT_L(0); PG8_MMA(1, 0, At, B0); PG8_BAR; PG8_SCHED;
            PG8_STAGE(PG8_SB(0, 1), b2 + hstep, voffB);
            PG8_WAIT_V(6); PG8_BAR; PG8_MMA(1, 1, At, B1); PG8_BAR;
            PG8_LDB(B0, 1, 0); PG8_SCHED; PG8_LDA(At, 1, 0); PG8_STAGE(PG8_SA(0, 1), a2 + hstep, voffA);
            PG8_WAIT_L(8); PG8_BAR; PG8_WAIT_L(0); PG8_MMA(0, 0, At, B0); PG8_BAR; PG8_SCHED;
            PG8_LDB(B1, 1, 1); PG8_STAGE(PG8_SB(1, 0), b3, voffB);
            PG8_BAR; PG8_WAIT_L(0); PG8_MMA(0, 1, At, B1); PG8_BAR;
            PG8_LDA(At, 1, 1); PG8_STAGE(PG8_SA(1, 0), a3, voffA);
            PG8_BAR; PG8_WAIT_L(0); PG8_MMA(1, 0, At, B0); PG8_BAR; PG8_SCHED;
            PG8_STAGE(PG8_SB(1, 1), b3 + hstep, voffB);
            PG8_WAIT_V(6); PG8_BAR; PG8_MMA(1, 1, At, B1); PG8_BAR;
            }
        }
        if constexpr (ALIGN_EPI) { if (wr == 0) PG8_BAR; }
        if constexpr (!Epi::AFTER_DRAIN) { E(acc, cur, wr, wc, fr, fq); S.done(cur); }
        if (!has_next) break;
#pragma unroll
        for (int a = 0; a < 2; ++a)
#pragma unroll
            for (int b = 0; b < 2; ++b)
#pragma unroll
                for (int m = 0; m < 4; ++m)
#pragma unroll
                    for (int n = 0; n < 2; ++n) acc[a][b][m][n] = zero4_;
        cur = nxt; cA = nA; cB = nB; ++ui;
        if constexpr (ALIGN_EPI) { if (wr == 1) PG8_BAR; }
    }
    PG8_WAIT_V(0);
    if constexpr (!ALIGN_EPI) { if (wr == 0) PG8_BAR; }
    PG8_BAR;
    if constexpr (Epi::AFTER_DRAIN) { E.fused(acc, cur, wr, wc, fr, fq, lds, wid, lane); S.done(cur); }
#undef PG8_SA
#undef PG8_SB
#undef PG8_STAGE
#undef PG8_LDA
#undef PG8_LDB
#undef PG8_MMA
#undef PG8_WAIT_V
#undef PG8_WAIT_L
#undef PG8_BAR
#undef PG8_SCHED
}
}

#define LAS __attribute__((address_space(3)))
typedef unsigned short bf16;
typedef unsigned v4u __attribute__((ext_vector_type(4)));
typedef unsigned v2u __attribute__((ext_vector_type(2)));
typedef float fx4 __attribute__((ext_vector_type(4)));
typedef float fx2 __attribute__((ext_vector_type(2)));
typedef float fx16 __attribute__((ext_vector_type(16)));
typedef short hx8 __attribute__((ext_vector_type(8)));
typedef short hx4 __attribute__((ext_vector_type(4)));
typedef __bf16 bfx2_t __attribute__((ext_vector_type(2)));

constexpr int NB = 4, SEQ = 8192, T = NB * SEQ, D = 1024, FF = 2816, NIN = 1952, NINP = 2048, PLE = 256;
constexpr int QL = 256, KVL = 128;
constexpr float EPS = 1e-6f;
constexpr int NTHREADS = 512;
constexpr int LDS_BYTES = 131072 + 1024;

constexpr size_t MiB = 1u << 20;
constexpr size_t OFF_WB = 0;
constexpr size_t OFF_TAB = 48 * MiB;
constexpr size_t OFF_LSE = 60 * MiB;
constexpr size_t OFF_XN = 64 * MiB;
constexpr size_t OFF_F = 128 * MiB;
constexpr size_t OFF_HID = 192 * MiB;
constexpr size_t OFF_Q = OFF_HID + 128 * MiB;
constexpr size_t OFF_KCAT = 368 * MiB;
constexpr size_t OFF_V = 416 * MiB;
constexpr size_t OFF_QLN = 448 * MiB;
constexpr size_t OFF_KVLN = 464 * MiB;
constexpr size_t OFF_BAR = 472 * MiB;
constexpr size_t BAR_BYTES = 16384;
constexpr size_t WS_NEED = 473 * MiB;
constexpr size_t WE_FIN_A = 0;
constexpr size_t WE_FDN_A = WE_FIN_A + (size_t)2 * FF * D;
constexpr size_t WE_FIN_B = WE_FDN_A + (size_t)D * FF;
constexpr size_t WE_FDN_B = WE_FIN_B + (size_t)2 * FF * D;
constexpr size_t WE_IN = WE_FDN_B + (size_t)D * FF;
constexpr size_t WE_QUP = WE_IN + (size_t)NINP * D;
constexpr size_t WE_OUT = WE_QUP + (size_t)1792 * 384;
constexpr size_t WE_PLE = WE_OUT + (size_t)D * D;
constexpr size_t WE_PG = WE_PLE + (size_t)D * PLE;
constexpr size_t WE_END = WE_PG + (size_t)D * D;
static_assert(WE_END * 2 <= 48 * MiB, "weights fit");

__device__ const float INV_M[16] = {1.000000000e+00f, 5.623413324e-01f, 3.162277639e-01f, 1.778279394e-01f, 1.000000015e-01f, 5.623413250e-02f, 3.162277490e-02f, 1.778279431e-02f, 9.999999776e-03f, 5.623413250e-03f, 3.162277630e-03f, 1.778279431e-03f, 1.000000047e-03f, 5.623413017e-04f, 3.162277571e-04f, 1.778279402e-04f};
__device__ const float INV_D[32] = {1.000000000e+00f, 7.498942614e-01f, 5.623413324e-01f, 4.216965139e-01f, 3.162277639e-01f, 2.371373773e-01f, 1.778279394e-01f, 1.333521307e-01f, 1.000000015e-01f, 7.498941571e-02f, 5.623413250e-02f, 4.216965288e-02f, 3.162277490e-02f, 2.371373773e-02f, 1.778279431e-02f, 1.333521493e-02f, 9.999999776e-03f, 7.498941850e-03f, 5.623413250e-03f, 4.216964822e-03f, 3.162277630e-03f, 2.371373586e-03f, 1.778279431e-03f, 1.333521446e-03f, 1.000000047e-03f, 7.498942432e-04f, 5.623413017e-04f, 4.216965172e-04f, 3.162277571e-04f, 2.371373703e-04f, 1.778279402e-04f, 1.333521504e-04f};

struct Params { const float* in[16]; float* out; unsigned char* ws; };

__device__ __forceinline__ unsigned pk2(float lo, float hi) { fx2 v = {lo, hi}; bfx2_t b = __builtin_convertvector(v, bfx2_t); return __builtin_bit_cast(unsigned, b); }
__device__ __forceinline__ float bflo(unsigned u) { return __uint_as_float(u << 16); }
__device__ __forceinline__ float bfhi(unsigned u) { return __uint_as_float(u & 0xffff0000u); }
__device__ __forceinline__ float wave_sum(float v) {
#pragma unroll
    for (int o = 1; o < 64; o <<= 1) v += __shfl_xor(v, o);
    return v;
}
__device__ __forceinline__ float fast_rcp(float x) { return __builtin_amdgcn_rcpf(x); }
__device__ __forceinline__ float fast_exp2(float x) { return __builtin_amdgcn_exp2f(x); }
__device__ __forceinline__ float fast_rsq(float x) { return __builtin_amdgcn_rsqf(x); }

namespace pg8 {
struct EpiSwiglu {
    static constexpr bool PERM = true, AFTER_DRAIN = false;
    bf16_t* O; int ldc;
    __device__ __forceinline__ void operator()(const f32x4 (&acc)[2][2][4][2], const Unit& u, int wr, int wc, int fr, int fq) const {
        const int row0 = u.pm * BM + wr * 64 + fr; const int col0 = u.pn * 128 + wc * 32 + 8 * fq;
#pragma unroll
        for (int ai = 0; ai < 2; ++ai)
#pragma unroll
            for (int m = 0; m < 4; ++m) {
                bf16_t* rowp = O + (size_t)(row0 + ai * HALF + m * 16) * ldc + col0;
                float h[8];
#pragma unroll
                for (int n = 0; n < 2; ++n)
#pragma unroll
                    for (int e = 0; e < 4; ++e) {
                        const float g = acc[ai][0][m][n][e], up = acc[ai][1][m][n][e];
                        const float sg = g * __builtin_amdgcn_rcpf(1.0f + __builtin_amdgcn_exp2f(-1.4426950408889634f * g));
                        h[n * 4 + e] = sg * up;
                    }
                u32x4 w; w.x = ::pk2(h[0], h[1]); w.y = ::pk2(h[2], h[3]); w.z = ::pk2(h[4], h[5]); w.w = ::pk2(h[6], h[7]);
                *(u32x4*)rowp = w;
            }
    }
};
struct EpiQKV {
    static constexpr bool PERM = true, AFTER_DRAIN = false;
    bf16_t* Q; bf16_t* Kc; bf16_t* V;
    __device__ __forceinline__ void operator()(const f32x4 (&acc)[2][2][4][2], const Unit& u, int wr, int wc, int fr, int fq) const {
        const int row0 = u.pm * BM + wr * 64 + fr;
#pragma unroll
        for (int bj = 0; bj < 2; ++bj) {
            bf16_t* ub; int rs;
            if (u.pn < 3) { ub = Q + u.pn * 256 + bj * 128 + wc * 32; rs = 768; }
            else { const int head = 2 * (u.pn - 3) + bj; if (wc < 2) { ub = Kc + head * 96 + wc * 32; rs = 768; } else { ub = V + head * 64 + (wc * 32 - 64); rs = 512; } }
            const unsigned loff = (unsigned)row0 * (unsigned)rs + 8u * (unsigned)fq;
#pragma unroll
            for (int ai = 0; ai < 2; ++ai)
#pragma unroll
                for (int m = 0; m < 4; ++m) {
                    bf16_t* dst = ub + (loff + (unsigned)((ai * HALF + m * 16) * rs));
                    const f32x4 v0 = acc[ai][bj][m][0], v1 = acc[ai][bj][m][1];
                    u32x4 w; w.x = ::pk2(v0[0], v0[1]); w.y = ::pk2(v0[2], v0[3]); w.z = ::pk2(v1[0], v1[1]); w.w = ::pk2(v1[2], v1[3]);
                    *(u32x4*)dst = w;
                }
        }
    }
};
struct EpiGate {
    static constexpr bool PERM = true, AFTER_DRAIN = false;
    bf16_t* O; const bf16_t* PP; int ldc;
    __device__ __forceinline__ void operator()(const f32x4 (&acc)[2][2][4][2], const Unit& u, int wr, int wc, int fr, int fq) const {
        const int row0 = u.pm * BM + wr * 64 + fr; const int col0 = u.pn * BM + wc * 32 + 8 * fq;
#pragma unroll
        for (int ai = 0; ai < 2; ++ai)
#pragma unroll
            for (int m = 0; m < 4; ++m)
#pragma unroll
                for (int bj = 0; bj < 2; ++bj) {
                    const size_t off = (size_t)(row0 + ai * HALF + m * 16) * ldc + col0 + bj * HALF;
                    const u32x4 pv = *(const u32x4*)(PP + off);
                    float pp[8] = {::bflo(pv.x), ::bfhi(pv.x), ::bflo(pv.y), ::bfhi(pv.y), ::bflo(pv.z), ::bfhi(pv.z), ::bflo(pv.w), ::bfhi(pv.w)};
                    float o[8];
#pragma unroll
                    for (int n = 0; n < 2; ++n)
#pragma unroll
                        for (int e = 0; e < 4; ++e) {
                            const float g = acc[ai][bj][m][n][e];
                            o[n * 4 + e] = pp[n * 4 + e] * __builtin_amdgcn_rcpf(1.0f + __builtin_amdgcn_exp2f(-1.4426950408889634f * g));
                        }
                    u32x4 w; w.x = ::pk2(o[0], o[1]); w.y = ::pk2(o[2], o[3]); w.z = ::pk2(o[4], o[5]); w.w = ::pk2(o[6], o[7]);
                    *(u32x4*)(O + off) = w;
                }
    }
};
}

__device__ __forceinline__ void tr_item(const float* W, int K, int N, int k0, int n0, bf16* WT, int drow0, int ldk, int dk, LAS float* scr, int lane) {
#pragma unroll 8
    for (int i = 0; i < 32; ++i) { const int kk = 2 * i + (lane >> 5); scr[kk * 33 + (lane & 31)] = W[(size_t)(k0 + kk) * N + n0 + (lane & 31)]; }
    asm volatile("s_waitcnt lgkmcnt(0)" ::: "memory");
    const int c = lane & 7;
#pragma unroll
    for (int j = 0; j < 4; ++j) { const int n = (lane >> 3) + 8 * j; const LAS float* s = scr + (8 * c) * 33 + n;
        v4u o; o.x = pk2(s[0 * 33], s[1 * 33]); o.y = pk2(s[2 * 33], s[3 * 33]); o.z = pk2(s[4 * 33], s[5 * 33]); o.w = pk2(s[6 * 33], s[7 * 33]);
        *(v4u*)(WT + (size_t)(drow0 + n) * ldk + dk + k0 + 8 * c) = o; }
    asm volatile("s_waitcnt lgkmcnt(0)" ::: "memory");
}
__device__ __forceinline__ void tr_matrix_item(const float* W, int K, int N, bf16* WT, int mode, int item, LAS float* scr, int lane, int ldk = 0, int dk = 0) {
    const int nblk = N / 32, kb = item / nblk, nb = item % nblk, k0 = 64 * kb, n0 = 32 * nb;
    int drow0 = n0;
    if (mode != 0) drow0 = 256 * (n0 >> 7) + (n0 & 127) + (mode == 2 ? 128 : 0);
    tr_item(W, K, N, k0, n0, WT, drow0, ldk ? ldk : K, dk, scr, lane);
}
__device__ __forceinline__ void convert_weights(const Params& P, unsigned char* ws, int layer, LAS unsigned char* lds, int gw, int NGW, int wave, int lane) {
    LAS float* scr = (LAS float*)(lds + wave * 16384);
    bf16* WB = (bf16*)(ws + OFF_WB);
    const float* w_in = P.in[4] + (size_t)layer * D * NIN;
    const float* w_qup = P.in[6] + (size_t)layer * QL * 768;
    const float* w_kvup = P.in[8] + (size_t)layer * KVL * 1024;
    const float* w_out = P.in[10] + (size_t)layer * D * D;
    const float* fg = P.in[11] + (size_t)layer * 2 * D * FF;
    const float* fu = P.in[12] + (size_t)layer * 2 * D * FF;
    const float* fd = P.in[13] + (size_t)layer * 2 * FF * D;
    const float* w_ple = P.in[14] + (size_t)layer * PLE * D;
    const float* w_pg = P.in[15] + (size_t)layer * D * D;
    constexpr int I_FIN = (D / 64) * (FF / 32);
    constexpr int I_FDN = (FF / 64) * (D / 32);
    constexpr int I_IN = (D / 64) * (NIN / 32);
    constexpr int I_QUP = (QL / 64) * (768 / 32);
    constexpr int I_KVUP = (KVL / 64) * (1024 / 32);
    constexpr int I_DD = (D / 64) * (D / 32);
    constexpr int I_PLE = (PLE / 64) * (D / 32);
    constexpr int NITEMS = 4 * I_FIN + 2 * I_FDN + I_IN + I_QUP + I_KVUP + 2 * I_DD + I_PLE;
    for (int it = gw; it < NITEMS; it += NGW) {
        int r = it;
        if (r < I_FIN) { tr_matrix_item(fg, D, FF, WB + WE_FIN_A, 1, r, scr, lane); continue; } r -= I_FIN;
        if (r < I_FIN) { tr_matrix_item(fu, D, FF, WB + WE_FIN_A, 2, r, scr, lane); continue; } r -= I_FIN;
        if (r < I_FIN) { tr_matrix_item(fg + (size_t)D * FF, D, FF, WB + WE_FIN_B, 1, r, scr, lane); continue; } r -= I_FIN;
        if (r < I_FIN) { tr_matrix_item(fu + (size_t)D * FF, D, FF, WB + WE_FIN_B, 2, r, scr, lane); continue; } r -= I_FIN;
        if (r < I_FDN) { tr_matrix_item(fd, FF, D, WB + WE_FDN_A, 0, r, scr, lane); continue; } r -= I_FDN;
        if (r < I_FDN) { tr_matrix_item(fd + (size_t)FF * D, FF, D, WB + WE_FDN_B, 0, r, scr, lane); continue; } r -= I_FDN;
        if (r < I_IN) { tr_matrix_item(w_in, D, NIN, WB + WE_IN, 0, r, scr, lane); continue; } r -= I_IN;
        if (r < I_QUP) { tr_matrix_item(w_qup, QL, 768, WB + WE_QUP, 0, r, scr, lane, 384, 0); continue; } r -= I_QUP;
        if (r < I_KVUP) { tr_matrix_item(w_kvup, KVL, 1024, WB + WE_QUP + (size_t)768 * 384, 0, r, scr, lane, 384, 256); continue; } r -= I_KVUP;
        if (r < I_DD) { tr_matrix_item(w_out, D, D, WB + WE_OUT, 0, r, scr, lane); continue; } r -= I_DD;
        if (r < I_PLE) { tr_matrix_item(w_ple, PLE, D, WB + WE_PLE, 0, r, scr, lane); continue; } r -= I_PLE;
        tr_matrix_item(w_pg, D, D, WB + WE_PG, 0, r, scr, lane);
    }
    {
        v4u* qk = (v4u*)(WB + WE_QUP); unsigned z0_ = 0u; asm volatile("" : "+v"(z0_)); const v4u z = {z0_, z0_, z0_, z0_};
        const int gt = gw * 64 + lane, NTT = NGW * 64;
        for (int i = gt; i < 768 * 16; i += NTT) { const int row = i >> 4, ch = i & 15; qk[(size_t)row * 48 + 32 + ch] = z; }
        for (int i = gt; i < 1024 * 32; i += NTT) { const int row = 768 + (i >> 5), ch = i & 31; qk[(size_t)row * 48 + ch] = z; }
    }
}

__device__ __forceinline__ void rope_tables(const Params& P, unsigned char* ws, int gtid, int NT) {
    const int* pos = (const int*)P.in[2];
    float* cosM = (float*)(ws + OFF_TAB); float* sinM = cosM + (size_t)T * 16; float* cosD = sinM + (size_t)T * 16; float* sinD = cosD + (size_t)T * 32;
    for (int e = gtid; e < T * 48; e += NT) {
        const int tok = e / 48, i = e % 48;
        const float inv = (i < 16) ? INV_M[i] : INV_D[i - 16];
        const float ang = (float)pos[tok] * inv;
        double tt = (double)ang * 0.15915494309189535; tt -= __builtin_rint(tt);
        const float rev = (float)tt;
        const float c = __builtin_amdgcn_cosf(rev), s = __builtin_amdgcn_sinf(rev);
        if (i < 16) { cosM[(size_t)tok * 16 + i] = c; sinM[(size_t)tok * 16 + i] = s; }
        else { cosD[(size_t)tok * 32 + i - 16] = c; sinD[(size_t)tok * 32 + i - 16] = s; }
    }
}

template <bool HAS_F, bool HIN_BF, bool HOUT_BF>
__device__ __forceinline__ void resnorm_rows(const void* hin, void* hout, const bf16* f, float alpha, const float* ga, const float* gb, bf16* xn, int gw, int NGW, int lane) {
    for (int m = gw; m < T; m += NGW) {
        fx4 hv[4];
        if (HIN_BF) {
            const v2u* hr = (const v2u*)((const bf16*)hin + (size_t)m * 2048) + lane;
#pragma unroll
            for (int j = 0; j < 4; ++j) { const v2u w = hr[64 * j]; hv[j] = (fx4){bflo(w.x), bfhi(w.x), bflo(w.y), bfhi(w.y)}; }
        } else {
            const fx4* hr = (const fx4*)((const float*)hin + (size_t)m * D) + lane;
#pragma unroll
            for (int j = 0; j < 4; ++j) hv[j] = hr[64 * j];
        }
        if (HAS_F) {
            const v2u* fr = (const v2u*)(f + (size_t)m * D) + lane;
            fx4 fv[4]; float ss = 0.f;
#pragma unroll
            for (int j = 0; j < 4; ++j) { const v2u w = fr[64 * j]; fv[j] = (fx4){bflo(w.x), bfhi(w.x), bflo(w.y), bfhi(w.y)}; ss += (fv[j].x * fv[j].x + fv[j].y * fv[j].y) + (fv[j].z * fv[j].z + fv[j].w * fv[j].w); }
            const float rstd = fast_rsq(wave_sum(ss) * (1.0f / D) + EPS) * alpha;
#pragma unroll
            for (int j = 0; j < 4; ++j) { const fx4 g = ((const fx4*)ga)[lane + 64 * j]; hv[j] = hv[j] + fv[j] * g * rstd; }
        }
        if (HOUT_BF) {
            v2u* ho = (v2u*)((bf16*)hout + (size_t)m * 2048) + lane;
#pragma unroll
            for (int j = 0; j < 4; ++j) ho[64 * j] = (v2u){pk2(hv[j].x, hv[j].y), pk2(hv[j].z, hv[j].w)};
        } else {
            fx4* ho = (fx4*)((float*)hout + (size_t)m * D) + lane;
#pragma unroll
            for (int j = 0; j < 4; ++j) ho[64 * j] = hv[j];
        }
        float s2 = 0.f;
#pragma unroll
        for (int j = 0; j < 4; ++j) s2 += (hv[j].x * hv[j].x + hv[j].y * hv[j].y) + (hv[j].z * hv[j].z + hv[j].w * hv[j].w);
        const float rstd2 = fast_rsq(wave_sum(s2) * (1.0f / D) + EPS);
        v2u* xo = (v2u*)(xn + (size_t)m * D) + lane;
#pragma unroll
        for (int j = 0; j < 4; ++j) { const fx4 g = ((const fx4*)gb)[lane + 64 * j]; const fx4 y = hv[j] * g * rstd2; xo[64 * j] = (v2u){pk2(y.x, y.y), pk2(y.z, y.w)}; }
    }
}

__device__ __forceinline__ void mixer_prep_rows(const Params& P, unsigned char* ws, int layer, int gw, int NGW, int lane) {
    bf16* Z = (bf16*)(ws + OFF_HID); bf16* qkv = (bf16*)(ws + OFF_QLN); bf16* Kc = (bf16*)(ws + OFF_KCAT);
    const float* cosM = (const float*)(ws + OFF_TAB); const float* sinM = cosM + (size_t)T * 16; const float* cosD = sinM + (size_t)T * 16; const float* sinD = cosD + (size_t)T * 32;
    const float* qn = P.in[5] + (size_t)layer * QL; const float* kvn = P.in[7] + (size_t)layer * KVL;
    for (int m = gw; m < T; m += NGW) {
        bf16* z = Z + (size_t)m * NINP;
        {
            const v2u w = ((const v2u*)z)[lane]; const fx4 v = {bflo(w.x), bfhi(w.x), bflo(w.y), bfhi(w.y)};
            const float ss = (v.x * v.x + v.y * v.y) + (v.z * v.z + v.w * v.w);
            const float rstd = fast_rsq(wave_sum(ss) * (1.0f / QL) + EPS);
            const fx4 g = ((const fx4*)qn)[lane]; const fx4 y = v * g * rstd;
            ((v2u*)(qkv + (size_t)m * 384))[lane] = (v2u){pk2(y.x, y.y), pk2(y.z, y.w)};
        }
        {
            const unsigned w = ((const unsigned*)(z + 256))[lane]; const float a = bflo(w), b = bfhi(w);
            const float rstd = fast_rsq(wave_sum(a * a + b * b) * (1.0f / KVL) + EPS);
            const fx2 g = ((const fx2*)kvn)[lane];
            ((unsigned*)(qkv + (size_t)m * 384 + 256))[lane] = pk2(a * g.x * rstd, b * g.y * rstd);
        }
        if (lane < 16) {
            const float x1 = __uint_as_float((unsigned)z[384 + lane] << 16), x2 = __uint_as_float((unsigned)z[400 + lane] << 16);
            const float c = cosM[(size_t)m * 16 + lane], s = sinM[(size_t)m * 16 + lane];
            const unsigned o = pk2(x1 * c - x2 * s, x2 * c + x1 * s);
            bf16* kr = Kc + (size_t)m * 768 + 64 + lane;
#pragma unroll
            for (int h = 0; h < 8; ++h) { kr[h * 96] = (bf16)(o & 0xffffu); kr[h * 96 + 16] = (bf16)(o >> 16); }
        }
        {
            const int head = lane >> 3, c4 = lane & 7;
            const fx4 cs = ((const fx4*)(cosD + (size_t)m * 32))[c4], sn = ((const fx4*)(sinD + (size_t)m * 32))[c4];
#pragma unroll
            for (int w = 0; w < 2; ++w) {
                bf16* base = z + (w == 0 ? 416 : 928) + head * 64 + 4 * c4;
                const v2u a = *(const v2u*)base, b = *(const v2u*)(base + 32);
                const fx4 x1 = {bflo(a.x), bfhi(a.x), bflo(a.y), bfhi(a.y)}, x2 = {bflo(b.x), bfhi(b.x), bflo(b.y), bfhi(b.y)};
                const fx4 o1 = x1 * cs - x2 * sn, o2 = x2 * cs + x1 * sn;
                *(v2u*)base = (v2u){pk2(o1.x, o1.y), pk2(o1.z, o1.w)};
                *(v2u*)(base + 32) = (v2u){pk2(o2.x, o2.y), pk2(o2.z, o2.w)};
            }
        }
    }
}

__device__ __forceinline__ void merge_rows(const Params& P, unsigned char* ws, int layer, int gw, int NGW, int lane) {
    bf16* XN = (bf16*)(ws + OFF_XN); const bf16* Fb = (const bf16*)(ws + OFF_F); const float* LSE = (const float*)(ws + OFF_LSE);
    const float* gg = P.in[9] + (size_t)layer * D;
    const int head = lane >> 3;
    for (int m = gw; m < T; m += NGW) {
        const v4u wm = *(const v4u*)(XN + (size_t)m * D + 8 * lane);
        const v4u w2 = *(const v4u*)(XN + (size_t)m * D + 512 + 8 * lane);
        const v4u w0 = *(const v4u*)(Fb + (size_t)m * 512 + 8 * lane);
        const v4u w1 = *(const v4u*)(Fb + (size_t)T * 512 + (size_t)m * 512 + 8 * lane);
        const float L0 = LSE[(size_t)m * 8 + head], L1 = LSE[(size_t)T * 8 + (size_t)m * 8 + head], L2 = LSE[(size_t)2 * T * 8 + (size_t)m * 8 + head];
        const float mx = fmaxf(L0, fmaxf(L1, L2));
        float e0 = fast_exp2(L0 - mx), e1 = fast_exp2(L1 - mx), e2 = fast_exp2(L2 - mx);
        const float inv = fast_rcp(e0 + e1 + e2); e0 *= inv; e1 *= inv; e2 *= inv;
        float om[8] = {bflo(wm.x), bfhi(wm.x), bflo(wm.y), bfhi(wm.y), bflo(wm.z), bfhi(wm.z), bflo(wm.w), bfhi(wm.w)};
        float a0[8] = {bflo(w0.x), bfhi(w0.x), bflo(w0.y), bfhi(w0.y), bflo(w0.z), bfhi(w0.z), bflo(w0.w), bfhi(w0.w)};
        float a1[8] = {bflo(w1.x), bfhi(w1.x), bflo(w1.y), bfhi(w1.y), bflo(w1.z), bfhi(w1.z), bflo(w1.w), bfhi(w1.w)};
        float a2[8] = {bflo(w2.x), bfhi(w2.x), bflo(w2.y), bfhi(w2.y), bflo(w2.z), bfhi(w2.z), bflo(w2.w), bfhi(w2.w)};
        float od[8]; float ssm = 0.f, ssd = 0.f;
#pragma unroll
        for (int e = 0; e < 8; ++e) { od[e] = e0 * a0[e] + e1 * a1[e] + e2 * a2[e]; ssm += om[e] * om[e]; ssd += od[e] * od[e]; }
        const float rm = fast_rsq(wave_sum(ssm) * (1.0f / 512) + EPS), rd = fast_rsq(wave_sum(ssd) * (1.0f / 512) + EPS);
        const fx4 gm0 = ((const fx4*)gg)[2 * lane], gm1 = ((const fx4*)gg)[2 * lane + 1], gd0 = ((const fx4*)(gg + 512))[2 * lane], gd1 = ((const fx4*)(gg + 512))[2 * lane + 1];
        v4u o;
        o.x = pk2(om[0] * gm0.x * rm, om[1] * gm0.y * rm); o.y = pk2(om[2] * gm0.z * rm, om[3] * gm0.w * rm); o.z = pk2(om[4] * gm1.x * rm, om[5] * gm1.y * rm); o.w = pk2(om[6] * gm1.z * rm, om[7] * gm1.w * rm);
        *(v4u*)(XN + (size_t)m * D + 8 * lane) = o;
        o.x = pk2(od[0] * gd0.x * rd, od[1] * gd0.y * rd); o.y = pk2(od[2] * gd0.z * rd, od[3] * gd0.w * rd); o.z = pk2(od[4] * gd1.x * rd, od[5] * gd1.y * rd); o.w = pk2(od[6] * gd1.z * rd, od[7] * gd1.w * rd);
        *(v4u*)(XN + (size_t)m * D + 512 + 8 * lane) = o;
    }
}

__device__ __forceinline__ void convert_p(const Params& P, unsigned char* ws, int layer, int gtid, int NT) {
    const fx4* src = (const fx4*)(P.in[1] + (size_t)layer * T * PLE); v4u* dst = (v4u*)(ws + OFF_QLN);
    for (int i = gtid; i < T * PLE / 8; i += NT) { const fx4 a = src[2 * i], b = src[2 * i + 1]; dst[i] = (v4u){pk2(a.x, a.y), pk2(a.z, a.w), pk2(b.x, b.y), pk2(b.z, b.w)}; }
}

struct AttnArgs {
    const bf16* Q; int qs;
    const bf16* K; int ks;
    const bf16* V; int vs;
    bf16* O; int os;
    float* L; int ls;
    const float* cosT; const float* sinT;
    int q0; float c;
};
template <int DQK, bool WIN>
__device__ __forceinline__ void attn_unit(LAS unsigned char* lds, const AttnArgs& a) {
    constexpr int KCH = DQK / 8, NKC = 64 * KCH, NC = NKC + 512, NIT = (NC + 511) / 512;
    constexpr int KRS = DQK * 2 + 16, KBYTES = 64 * KRS, BUFB = KBYTES + 8192;
    constexpr int NDS = DQK / 16;
    int tid_ = threadIdx.x; asm volatile("" : "+v"(tid_));
    const int tid = tid_, lane = tid & 63, wid = __builtin_amdgcn_readfirstlane(tid >> 6), r32 = lane & 31, hi = lane >> 5;
    const int qw0 = a.q0 + 32 * wid, qpos = qw0 + r32;
    const int t_hi = (a.q0 + 256) >> 6;
    const int t_lo = WIN ? (a.q0 >= 128 ? ((a.q0 - 128) >> 6) : 0) : 0;
    v4u st[NIT];
#pragma unroll
    for (int it = 0; it < NIT; ++it) { const int c = tid + 512 * it;
        if (c < NC) { if (c < NKC) { const int row = c / KCH, ch = c % KCH; st[it] = *(const v4u*)(a.K + (long)(64 * t_lo + row) * a.ks + ch * 8); }
                      else { const int c2 = c - NKC, row = c2 >> 3, ch = c2 & 7; st[it] = *(const v4u*)(a.V + (long)(64 * t_lo + row) * a.vs + ch * 8); } } }
    hx8 qf[NDS];
    { const bf16* qrow = a.Q + (long)qpos * a.qs + 8 * hi;
#pragma unroll
      for (int ds = 0; ds < NDS; ++ds) qf[ds] = *(const hx8*)(qrow + 16 * ds);
      if (DQK == 96) {
          const fx4* cp = (const fx4*)(a.cosT + (long)qpos * 16 + 8 * hi); const fx4* sp = (const fx4*)(a.sinT + (long)qpos * 16 + 8 * hi);
          const fx4 c0 = cp[0], c1 = cp[1], s0 = sp[0], s1 = sp[1];
          const float cc[8] = {c0.x, c0.y, c0.z, c0.w, c1.x, c1.y, c1.z, c1.w}, sn[8] = {s0.x, s0.y, s0.z, s0.w, s1.x, s1.y, s1.z, s1.w};
          float n1[8], n2[8];
#pragma unroll
          for (int j = 0; j < 8; ++j) { const float x1 = __uint_as_float((unsigned)(unsigned short)qf[NDS - 2][j] << 16), x2 = __uint_as_float((unsigned)(unsigned short)qf[NDS - 1][j] << 16);
              n1[j] = x1 * cc[j] - x2 * sn[j]; n2[j] = x2 * cc[j] + x1 * sn[j]; }
          qf[NDS - 2] = __builtin_bit_cast(hx8, (v4u){pk2(n1[0], n1[1]), pk2(n1[2], n1[3]), pk2(n1[4], n1[5]), pk2(n1[6], n1[7])});
          qf[NDS - 1] = __builtin_bit_cast(hx8, (v4u){pk2(n2[0], n2[1]), pk2(n2[2], n2[3]), pk2(n2[4], n2[5]), pk2(n2[6], n2[7])});
      } }
#pragma unroll
    for (int it = 0; it < NIT; ++it) { const int c = tid + 512 * it;
        if (c < NC) { if (c < NKC) { const int row = c / KCH, ch = c % KCH; *(LAS v4u*)(lds + row * KRS + ch * 16) = st[it]; }
                      else { const int c2 = c - NKC, row = c2 >> 3, ch = c2 & 7; *(LAS v4u*)(lds + KBYTES + (ch >> 2) * 4096 + row * 64 + (ch & 3) * 16) = st[it]; } } }
    __syncthreads();
    float m_run = -INFINITY, l_run = 0.f;
    fx16 o[2];
#pragma unroll
    for (int r = 0; r < 16; ++r) { o[0][r] = 0.f; o[1][r] = 0.f; }
    const int vlane = ((lane >> 4) & 1) * 32 + (lane & 3) * 8 + (4 * hi + ((lane & 15) >> 2)) * 64;
    int cur = 0;
    for (int t = t_lo; t < t_hi; ++t) {
        const bool more = (t + 1 < t_hi);
        if (more) {
#pragma unroll
            for (int it = 0; it < NIT; ++it) { const int c = tid + 512 * it;
                if (c < NC) { if (c < NKC) { const int row = c / KCH, ch = c % KCH; st[it] = *(const v4u*)(a.K + (long)(64 * (t + 1) + row) * a.ks + ch * 8); }
                              else { const int c2 = c - NKC, row = c2 >> 3, ch = c2 & 7; st[it] = *(const v4u*)(a.V + (long)(64 * (t + 1) + row) * a.vs + ch * 8); } } }
        }
        const bool need = (64 * t <= qw0 + 31) && (!WIN || (64 * t + 63 >= qw0 - 128));
        if (need) {
            const LAS unsigned char* kb_ = lds + cur * BUFB; const LAS unsigned char* vb_ = kb_ + KBYTES + vlane;
            fx16 p[2];
#pragma unroll
            for (int kb = 0; kb < 2; ++kb) {
#pragma unroll
                for (int r = 0; r < 16; ++r) p[kb][r] = 0.f;
#pragma unroll
                for (int ds = 0; ds < NDS; ++ds) {
                    const hx8 kf = *(const LAS hx8*)(kb_ + (32 * kb + r32) * KRS + (16 * ds + 8 * hi) * 2);
                    p[kb] = __builtin_amdgcn_mfma_f32_32x32x16_bf16(kf, qf[ds], p[kb], 0, 0, 0);
                }
            }
            const bool domask = WIN || (64 * t + 63 > qw0);
            float mx = -INFINITY;
            if (domask) {
#pragma unroll
                for (int kb = 0; kb < 2; ++kb)
#pragma unroll
                    for (int r = 0; r < 16; ++r) {
                        const int kv = 64 * t + 32 * kb + (r & 3) + 8 * (r >> 2) + 4 * hi;
                        const bool ok = (kv <= qpos) && (!WIN || (qpos - kv <= 128));
                        const float v = ok ? p[kb][r] : -INFINITY; p[kb][r] = v; mx = fmaxf(mx, v);
                    }
            } else {
#pragma unroll
                for (int kb = 0; kb < 2; ++kb)
#pragma unroll
                    for (int r = 0; r < 16; ++r) mx = fmaxf(mx, p[kb][r]);
            }
            mx = fmaxf(mx, __shfl_xor(mx, 32));
            const float mnew = fmaxf(m_run, mx * a.c);
            const float muse = (mnew == -INFINITY) ? 0.f : mnew;
            const float alpha = fast_exp2(m_run - muse);
            m_run = mnew;
            float rs = 0.f;
#pragma unroll
            for (int kb = 0; kb < 2; ++kb)
#pragma unroll
                for (int r = 0; r < 16; ++r) { const float e = fast_exp2(__builtin_fmaf(p[kb][r], a.c, -muse)); p[kb][r] = e; rs += e; }
            l_run = l_run * alpha + rs;
#pragma unroll
            for (int r = 0; r < 16; ++r) { o[0][r] *= alpha; o[1][r] *= alpha; }
            hx8 pb[4];
#pragma unroll
            for (int ks = 0; ks < 4; ++ks) { const int kb = ks >> 1, s8 = (ks & 1) * 8;
                pb[ks] = __builtin_bit_cast(hx8, (v4u){pk2(p[kb][s8 + 0], p[kb][s8 + 1]), pk2(p[kb][s8 + 2], p[kb][s8 + 3]), pk2(p[kb][s8 + 4], p[kb][s8 + 5]), pk2(p[kb][s8 + 6], p[kb][s8 + 7])}); }
#pragma unroll
            for (int db = 0; db < 2; ++db)
#pragma unroll
                for (int ks = 0; ks < 4; ++ks) {
                    const hx4 lo = __builtin_bit_cast(hx4, __builtin_amdgcn_ds_read_tr16_b64_v4i16((LAS hx4*)(vb_ + db * 4096 + ks * 1024)));
                    const hx4 hh = __builtin_bit_cast(hx4, __builtin_amdgcn_ds_read_tr16_b64_v4i16((LAS hx4*)(vb_ + db * 4096 + ks * 1024 + 512)));
                    const hx8 vf = {lo[0], lo[1], lo[2], lo[3], hh[0], hh[1], hh[2], hh[3]};
                    o[db] = __builtin_amdgcn_mfma_f32_32x32x16_bf16(vf, pb[ks], o[db], 0, 0, 0);
                }
        }
        if (more) {
            LAS unsigned char* nb_ = lds + (cur ^ 1) * BUFB;
#pragma unroll
            for (int it = 0; it < NIT; ++it) { const int c = tid + 512 * it;
                if (c < NC) { if (c < NKC) { const int row = c / KCH, ch = c % KCH; *(LAS v4u*)(nb_ + row * KRS + ch * 16) = st[it]; }
                              else { const int c2 = c - NKC, row = c2 >> 3, ch = c2 & 7; *(LAS v4u*)(nb_ + KBYTES + (ch >> 2) * 4096 + row * 64 + (ch & 3) * 16) = st[it]; } } }
        }
        __syncthreads();
        cur ^= 1;
    }
    const float lt = l_run + __shfl_xor(l_run, 32);
    const float inv = fast_rcp(lt);
    bf16* orow = a.O + (long)qpos * a.os;
#pragma unroll
    for (int db = 0; db < 2; ++db)
#pragma unroll
        for (int g = 0; g < 4; ++g) {
            const v2u w = {pk2(o[db][4 * g] * inv, o[db][4 * g + 1] * inv), pk2(o[db][4 * g + 2] * inv, o[db][4 * g + 3] * inv)};
            *(v2u*)(orow + 32 * db + 8 * g + 4 * hi) = w;
        }
    if (WIN) { if (hi == 0) a.L[(long)qpos * a.ls] = m_run + __builtin_amdgcn_logf(lt); }
}

__device__ __forceinline__ void attn_unit_win(LAS unsigned char* lds, const AttnArgs& a) {
    constexpr int DQK = 64; constexpr bool WIN = true;
    constexpr int KRS = DQK * 2 + 16, KBYTES = 64 * KRS, BUFB = KBYTES + 8192, NDS = DQK / 16;
    int tid_ = threadIdx.x; asm volatile("" : "+v"(tid_));
    const int tid = tid_, lane = tid & 63, wid = __builtin_amdgcn_readfirstlane(tid >> 6), r32 = lane & 31, hi = lane >> 5;
    const int qw0 = a.q0 + 32 * wid, qpos = qw0 + r32;
    const int t_hi = (a.q0 + 256) >> 6;
    const int t_lo = a.q0 >= 128 ? ((a.q0 - 128) >> 6) : 0;
    const int nt = t_hi - t_lo;
    const int srow = tid >> 3, sch = tid & 7;
    v4u st[6][2];
#pragma unroll
    for (int s = 0; s < 6; ++s) if (s < nt) {
        st[s][0] = *(const v4u*)(a.K + (long)(64 * (t_lo + s) + srow) * a.ks + sch * 8);
        st[s][1] = *(const v4u*)(a.V + (long)(64 * (t_lo + s) + srow) * a.vs + sch * 8);
    }
    hx8 qf[NDS];
    { const bf16* qrow = a.Q + (long)qpos * a.qs + 8 * hi;
#pragma unroll
      for (int ds = 0; ds < NDS; ++ds) qf[ds] = *(const hx8*)(qrow + 16 * ds); }
#pragma unroll
    for (int s = 0; s < 6; ++s) if (s < nt) {
        *(LAS v4u*)(lds + s * BUFB + srow * KRS + sch * 16) = st[s][0];
        *(LAS v4u*)(lds + s * BUFB + KBYTES + (sch >> 2) * 4096 + srow * 64 + (sch & 3) * 16) = st[s][1];
    }
    __syncthreads();
    float m_run = -INFINITY, l_run = 0.f;
    fx16 o[2];
#pragma unroll
    for (int r = 0; r < 16; ++r) { o[0][r] = 0.f; o[1][r] = 0.f; }
    const int vlane = ((lane >> 4) & 1) * 32 + (lane & 3) * 8 + (4 * hi + ((lane & 15) >> 2)) * 64;
    for (int t = t_lo; t < t_hi; ++t) {
        const bool need = (64 * t <= qw0 + 31) && (64 * t + 63 >= qw0 - 128);
        if (need) {
            const LAS unsigned char* kb_ = lds + (t - t_lo) * BUFB; const LAS unsigned char* vb_ = kb_ + KBYTES + vlane;
            fx16 p[2];
#pragma unroll
            for (int kb = 0; kb < 2; ++kb) {
#pragma unroll
                for (int r = 0; r < 16; ++r) p[kb][r] = 0.f;
#pragma unroll
                for (int ds = 0; ds < NDS; ++ds) {
                    const hx8 kf = *(const LAS hx8*)(kb_ + (32 * kb + r32) * KRS + (16 * ds + 8 * hi) * 2);
                    p[kb] = __builtin_amdgcn_mfma_f32_32x32x16_bf16(kf, qf[ds], p[kb], 0, 0, 0);
                }
            }
            const bool domask = WIN || (64 * t + 63 > qw0);
            float mx = -INFINITY;
            if (domask) {
#pragma unroll
                for (int kb = 0; kb < 2; ++kb)
#pragma unroll
                    for (int r = 0; r < 16; ++r) {
                        const int kv = 64 * t + 32 * kb + (r & 3) + 8 * (r >> 2) + 4 * hi;
                        const bool ok = (kv <= qpos) && (!WIN || (qpos - kv <= 128));
                        const float v = ok ? p[kb][r] : -INFINITY; p[kb][r] = v; mx = fmaxf(mx, v);
                    }
            } else {
#pragma unroll
                for (int kb = 0; kb < 2; ++kb)
#pragma unroll
                    for (int r = 0; r < 16; ++r) mx = fmaxf(mx, p[kb][r]);
            }
            mx = fmaxf(mx, __shfl_xor(mx, 32));
            const float mnew = fmaxf(m_run, mx * a.c);
            const float muse = (mnew == -INFINITY) ? 0.f : mnew;
            const float alpha = fast_exp2(m_run - muse);
            m_run = mnew;
            float rs = 0.f;
#pragma unroll
            for (int kb = 0; kb < 2; ++kb)
#pragma unroll
                for (int r = 0; r < 16; ++r) { const float e = fast_exp2(__builtin_fmaf(p[kb][r], a.c, -muse)); p[kb][r] = e; rs += e; }
            l_run = l_run * alpha + rs;
#pragma unroll
            for (int r = 0; r < 16; ++r) { o[0][r] *= alpha; o[1][r] *= alpha; }
            hx8 pb[4];
#pragma unroll
            for (int ks = 0; ks < 4; ++ks) { const int kb = ks >> 1, s8 = (ks & 1) * 8;
                pb[ks] = __builtin_bit_cast(hx8, (v4u){pk2(p[kb][s8 + 0], p[kb][s8 + 1]), pk2(p[kb][s8 + 2], p[kb][s8 + 3]), pk2(p[kb][s8 + 4], p[kb][s8 + 5]), pk2(p[kb][s8 + 6], p[kb][s8 + 7])}); }
#pragma unroll
            for (int db = 0; db < 2; ++db)
#pragma unroll
                for (int ks = 0; ks < 4; ++ks) {
                    const hx4 lo = __builtin_bit_cast(hx4, __builtin_amdgcn_ds_read_tr16_b64_v4i16((LAS hx4*)(vb_ + db * 4096 + ks * 1024)));
                    const hx4 hh = __builtin_bit_cast(hx4, __builtin_amdgcn_ds_read_tr16_b64_v4i16((LAS hx4*)(vb_ + db * 4096 + ks * 1024 + 512)));
                    const hx8 vf = {lo[0], lo[1], lo[2], lo[3], hh[0], hh[1], hh[2], hh[3]};
                    o[db] = __builtin_amdgcn_mfma_f32_32x32x16_bf16(vf, pb[ks], o[db], 0, 0, 0);
                }
        }
    }
    const float lt = l_run + __shfl_xor(l_run, 32);
    const float inv = fast_rcp(lt);
    bf16* orow = a.O + (long)qpos * a.os;
#pragma unroll
    for (int db = 0; db < 2; ++db)
#pragma unroll
        for (int g = 0; g < 4; ++g) {
            const v2u w = {pk2(o[db][4 * g] * inv, o[db][4 * g + 1] * inv), pk2(o[db][4 * g + 2] * inv, o[db][4 * g + 3] * inv)};
            *(v2u*)(orow + 32 * db + 8 * g + 4 * hi) = w;
        }
    if (WIN) { if (hi == 0) a.L[(long)qpos * a.ls] = m_run + __builtin_amdgcn_logf(lt); }
    __syncthreads();
}

__device__ __forceinline__ void attention_phase(unsigned char* ws, LAS unsigned char* lds) {
    int bx_ = blockIdx.x; asm volatile("" : "+s"(bx_));
    const int G = gridDim.x, c = bx_;
    const float* cosM = (const float*)(ws + OFF_TAB); const float* sinM = cosM + (size_t)T * 16;
    bf16* XN = (bf16*)(ws + OFF_XN); bf16* Fb = (bf16*)(ws + OFF_F); float* LSE = (float*)(ws + OFF_LSE);
    const bf16* Z = (const bf16*)(ws + OFF_HID); const bf16* Qb = (const bf16*)(ws + OFF_Q);
    const bf16* Kc = (const bf16*)(ws + OFF_KCAT); const bf16* Vm = (const bf16*)(ws + OFF_V);
#ifdef EXP_MLA2
    for (int rep_ = 0; rep_ < 2; ++rep_)
#endif
    for (int pi0 = c, rnd = 0; pi0 < 512; pi0 += G, ++rnd) {
        int pi = pi0;
        if (G == 256) { const int xcd = c & 7, j = c >> 3; pi = ((4 * xcd + 2 * rnd + (j >> 4)) << 4) | (j & 15); }
        const int bh = pi >> 4, s = pi & 15, b = bh >> 3, h = bh & 7;
        const size_t tok0 = (size_t)b * SEQ;
        AttnArgs a;
        a.Q = Qb + tok0 * 768 + h * 96; a.qs = 768; a.K = Kc + tok0 * 768 + h * 96; a.ks = 768; a.V = Vm + tok0 * 512 + h * 64; a.vs = 512;
        a.O = XN + tok0 * D + h * 64; a.os = D; a.L = nullptr; a.ls = 0; a.cosT = cosM + tok0 * 16; a.sinT = sinM + tok0 * 16;
        a.c = 0.10206207261596577f * 1.4426950408889634f;
        for (int half = 0; half < 2; ++half) { a.q0 = half ? 256 * s : 256 * (31 - s); attn_unit<96, false>(lds, a); }
    }
#ifdef EXP_DIL2
    for (int rep_ = 0; rep_ < 2; ++rep_)
#endif
    for (int u = c; u < 3072; u += G) {
        const int br = u >> 10, rem = u & 1023, b = rem >> 8, h = (rem >> 5) & 7, idx = rem & 31;
        const int dil = (br == 0) ? 1 : (br == 1 ? 4 : 16); const int nsub = 32 / dil; const int r = idx / nsub, n = idx % nsub;
        const size_t tok0 = (size_t)b * SEQ + r;
        AttnArgs a;
        a.Q = Z + tok0 * NINP + 416 + h * 64; a.qs = NINP * dil; a.K = Z + tok0 * NINP + 928 + h * 64; a.ks = a.qs; a.V = Z + tok0 * NINP + 1440 + h * 64; a.vs = a.qs;
        if (br < 2) { a.O = Fb + (size_t)br * T * 512 + tok0 * 512 + h * 64; a.os = 512 * dil; }
        else { a.O = XN + tok0 * D + 512 + h * 64; a.os = D * dil; }
        a.L = LSE + (size_t)br * T * 8 + tok0 * 8 + h; a.ls = 8 * dil; a.cosT = nullptr; a.sinT = nullptr;
        a.c = 0.125f * 1.4426950408889634f; a.q0 = 256 * n;
        attn_unit_win(lds, a);
    }
}

#define XB_TMO      128
#define XB_XCNT(j)  (256  + 64 * (j))
#define XB_XSUB(j)  (1280 + 64 * (j))
#define XB_XGEN(j)  (2304 + 64 * (j))
#define XB_TOP      3328
#define XB_TOPGEN   3392
#define XCD_BAR_WORDS 3456
#define XB_SPIN_CAP (1u << 18)

__device__ __forceinline__ unsigned xb_ld(unsigned* p)              { return __hip_atomic_load(p, __ATOMIC_RELAXED, __HIP_MEMORY_SCOPE_AGENT); }
__device__ __forceinline__ unsigned xb_add(unsigned* p, unsigned v) { return __hip_atomic_fetch_add(p, v, __ATOMIC_RELAXED, __HIP_MEMORY_SCOPE_AGENT); }
__device__ __forceinline__ unsigned xb_xcc_id() { return (unsigned)__builtin_amdgcn_s_getreg((3 << 11) | 20) & 0xFu; }
#define XB_SPIN(cond, bar) do { unsigned _sp = 0; while (cond) { __builtin_amdgcn_s_sleep(1); \
    if ((++_sp & 255u) == 0u) { if (xb_ld(&(bar)[XB_TMO])) break; if (_sp > XB_SPIN_CAP) { atomicAdd(&(bar)[XB_TMO], 1u); break; } } } } while (0)

struct XcdBarrier {
    unsigned* bar; unsigned x;
    volatile LAS unsigned* st;
};

__device__ __forceinline__ XcdBarrier xcd_barrier_post(unsigned* bar, volatile LAS unsigned* st) {
    XcdBarrier b; b.bar = bar; b.x = xb_xcc_id(); b.st = st;
    if (threadIdx.x == 0) (void)xb_add(&bar[XB_XCNT(b.x)], 1u);
    return b;
}
__device__ __forceinline__ void xcd_barrier_complete(unsigned* bar, unsigned x, unsigned& nloc, unsigned& nx) {
    const unsigned G = gridDim.x * gridDim.y * gridDim.z;
    unsigned sum, cnt, mine, sp = 0u;
    for (;;) {
        sum = 0u; cnt = 0u; mine = 0u;
#pragma unroll
        for (unsigned j = 0; j < 16; ++j) { const unsigned c = xb_ld(&bar[XB_XCNT(j)]); sum += c; cnt += (c > 0u) ? 1u : 0u; mine = (j == x) ? c : mine; }
        if (sum == G) break;
        __builtin_amdgcn_s_sleep(1);
        if ((++sp & 255u) == 0u) { if (xb_ld(&bar[XB_TMO])) break; if (sp > XB_SPIN_CAP) { atomicAdd(&bar[XB_TMO], 1u); break; } }
    }
    nloc = mine > 0u ? mine : 1u; nx = cnt > 0u ? cnt : 1u;
}

__device__ __forceinline__ void xcd_barrier(const XcdBarrier& b) {
    asm volatile("s_waitcnt vmcnt(0)" ::: "memory");
    __syncthreads();
    if (threadIdx.x == 0) {
        unsigned* bar = b.bar;
        __builtin_amdgcn_s_waitcnt(0);
        unsigned nloc = b.st[0], nx = b.st[1];
        if (nloc == 0u) { xcd_barrier_complete(bar, b.x, nloc, nx); b.st[0] = nloc; b.st[1] = nx; }
        const unsigned old = xb_add(&bar[XB_XSUB(b.x)], 1u);
        const unsigned gen = old / nloc;
        if (old + 1u == (gen + 1u) * nloc) {
            __builtin_amdgcn_fence(__ATOMIC_RELEASE, "agent");
            asm volatile("s_waitcnt vmcnt(0)" ::: "memory");
            const unsigned og = xb_add(&bar[XB_TOP], 1u);
            const unsigned tg = og / nx;
            if (og + 1u == (tg + 1u) * nx) xb_add(&bar[XB_TOPGEN], 1u);
            else XB_SPIN(xb_ld(&bar[XB_TOPGEN]) == tg, bar);
            __builtin_amdgcn_fence(__ATOMIC_ACQUIRE, "agent");
            xb_add(&bar[XB_XGEN(b.x)], 1u);
            asm volatile("s_waitcnt vmcnt(0)" ::: "memory");
        } else {
            XB_SPIN(xb_ld(&bar[XB_XGEN(b.x)]) == gen, bar);
            __builtin_amdgcn_fence(__ATOMIC_ACQUIRE, "agent");
            asm volatile("s_waitcnt vmcnt(0)" ::: "memory");
        }
    }
    __syncthreads();
}


#ifdef NO_GEMM
#define GEMM_PHASE(EPI, Aptr, Bptr, Nn, Kk, Eobj) do { (void)(Eobj); } while (0)
#else
#define GEMM_PHASE(EPI, Aptr, Bptr, Nn, Kk, Eobj) do { int bx_ = blockIdx.x; asm volatile("" : "+s"(bx_)); pg8::Gemm g_{(const pg8::bf16_t*)(Aptr), (const pg8::bf16_t*)(Bptr), T, (Nn), (Kk)}; pg8::StaticOrder S_; S_.init(T, (Nn), (int)gridDim.x, bx_); \
    pg8::gemm_phase<EPI, pg8::StaticOrder, true, true>(lds, g_, S_, (Eobj)); } while (0)
#endif
#define PH_IDS int tid = threadIdx.x; asm volatile("" : "+v"(tid)); const int lane = tid & 63, wave = __builtin_amdgcn_readfirstlane(tid >> 6); int bxp = blockIdx.x; asm volatile("" : "+s"(bxp)); \
    const int gw = bxp * 8 + wave, NGW = gridDim.x * 8, gtid = bxp * NTHREADS + tid, NT = gridDim.x * NTHREADS; (void)lane; (void)gw; (void)NGW; (void)gtid; (void)NT;
#define GASP(T_, p_) ((T_*)(__attribute__((address_space(1))) T_*)(p_))
#define PH_WS unsigned char* ws = P.ws;
#define WP(off) ((bf16*)(ws + (off)))
#define WBP(eoff) ((bf16*)(ws + OFF_WB) + (eoff))

__global__ void __launch_bounds__(NTHREADS, 2) mega_fwd(Params Pk) {
    Params P;
#pragma unroll
    for (int i = 0; i < 16; ++i) P.in[i] = GASP(const float, Pk.in[i]);
    P.out = GASP(float, Pk.out); P.ws = GASP(unsigned char, Pk.ws);
    extern __shared__ __attribute__((aligned(16))) unsigned char lds_raw[];
    LAS unsigned char* lds = (LAS unsigned char*)lds_raw;
    cg::grid_group grid = cg::this_grid();
    volatile LAS unsigned* bst = (volatile LAS unsigned*)(lds + 131072);
    if (threadIdx.x < 2) bst[threadIdx.x] = 0u;
    __syncthreads();
    const XcdBarrier bar = xcd_barrier_post((unsigned*)(P.ws + OFF_BAR), bst);
#define GSYNC() xcd_barrier(bar)

    { PH_IDS PH_WS
      convert_weights(P, ws, 0, lds, gw, NGW, wave, lane);
      rope_tables(P, ws, gtid, NT);
      resnorm_rows<false, false, true>(P.in[0], P.out, nullptr, 0.f, nullptr, P.in[3], WP(OFF_XN), gw, NGW, lane); }
    grid.sync();

    { const int layer = 0;
        { PH_WS pg8::EpiSwiglu E{WP(OFF_HID), FF}; GEMM_PHASE(pg8::EpiSwiglu, WP(OFF_XN), WBP(WE_FIN_A), 2 * FF, D, E); }
        GSYNC();
        { PH_WS pg8::EpiBf16<0> E{WP(OFF_F), D, nullptr, 0, 0, 1.f}; GEMM_PHASE(pg8::EpiBf16<0>, WP(OFF_HID), WBP(WE_FDN_A), D, FF, E); }
        GSYNC();
        { PH_IDS PH_WS const float* gains = P.in[3] + (size_t)layer * 8 * D;
          resnorm_rows<true, true, true>(P.out, P.out, WP(OFF_F), 0.5f, gains + 1 * D, gains + 2 * D, WP(OFF_XN), gw, NGW, lane); }
        GSYNC();
        { PH_WS pg8::EpiBf16<0> E{WP(OFF_HID), NINP, nullptr, 0, 0, 1.f}; GEMM_PHASE(pg8::EpiBf16<0>, WP(OFF_XN), WBP(WE_IN), NINP, D, E); }
        GSYNC();
        { PH_IDS PH_WS mixer_prep_rows(P, ws, layer, gw, NGW, lane); }
        GSYNC();
        { PH_WS pg8::EpiQKV E{WP(OFF_Q), WP(OFF_KCAT), WP(OFF_V)}; int kq_ = 384; asm volatile("" : "+s"(kq_)); GEMM_PHASE(pg8::EpiQKV, WP(OFF_QLN), WBP(WE_QUP), 1792, kq_, E); }
        GSYNC();
#ifndef NO_ATTN
        { PH_WS attention_phase(ws, lds); }
#endif
        GSYNC();
#ifdef EXP_SYNC
        for (int rep_ = 0; rep_ < 16; ++rep_) GSYNC();
#endif
        { PH_IDS PH_WS merge_rows(P, ws, layer, gw, NGW, lane); }
        GSYNC();
        { PH_WS pg8::EpiBf16<0> E{WP(OFF_F), D, nullptr, 0, 0, 1.f}; GEMM_PHASE(pg8::EpiBf16<0>, WP(OFF_XN), WBP(WE_OUT), D, D, E); }
        GSYNC();
        { PH_IDS PH_WS const float* gains = P.in[3] + (size_t)layer * 8 * D;
          resnorm_rows<true, true, true>(P.out, P.out, WP(OFF_F), 1.0f, gains + 3 * D, gains + 4 * D, WP(OFF_XN), gw, NGW, lane);
          convert_p(P, ws, layer, gtid, NT); }
        GSYNC();
        { PH_WS pg8::EpiSwiglu E{WP(OFF_HID), FF}; GEMM_PHASE(pg8::EpiSwiglu, WP(OFF_XN), WBP(WE_FIN_B), 2 * FF, D, E); }
        GSYNC();
        { PH_WS pg8::EpiBf16<0> E{WP(OFF_F), D, nullptr, 0, 0, 1.f}; GEMM_PHASE(pg8::EpiBf16<0>, WP(OFF_HID), WBP(WE_FDN_B), D, FF, E); }
        GSYNC();
        { PH_IDS PH_WS const float* gains = P.in[3] + (size_t)layer * 8 * D;
          resnorm_rows<true, true, true>(P.out, P.out, WP(OFF_F), 0.5f, gains + 5 * D, gains + 6 * D, WP(OFF_XN), gw, NGW, lane); }
        { PH_WS pg8::EpiBf16<0> E{WP(OFF_HID), D, nullptr, 0, 0, 1.f}; GEMM_PHASE(pg8::EpiBf16<0>, WP(OFF_QLN), WBP(WE_PLE), D, PLE, E); }
        GSYNC();
        { PH_WS pg8::EpiGate E{WP(OFF_F), WP(OFF_HID), D}; GEMM_PHASE(pg8::EpiGate, WP(OFF_XN), WBP(WE_PG), D, D, E); }
        GSYNC();
        { PH_IDS PH_WS const float* gains = P.in[3] + (size_t)layer * 8 * D;
          if (layer == 1) resnorm_rows<true, true, false>(P.out, P.out, WP(OFF_F), 1.0f, gains + 7 * D, P.in[3], WP(OFF_XN), gw, NGW, lane);
          else resnorm_rows<true, true, true>(P.out, P.out, WP(OFF_F), 1.0f, gains + 7 * D, P.in[3] + (size_t)8 * D, WP(OFF_XN), gw, NGW, lane);
          if (layer == 0) convert_weights(P, ws, 1, lds, gw, NGW, wave, lane); }
        if (layer == 0) GSYNC();
    }
    { const int layer = 1;
        { PH_WS pg8::EpiSwiglu E{WP(OFF_HID), FF}; GEMM_PHASE(pg8::EpiSwiglu, WP(OFF_XN), WBP(WE_FIN_A), 2 * FF, D, E); }
        GSYNC();
        { PH_WS pg8::EpiBf16<0> E{WP(OFF_F), D, nullptr, 0, 0, 1.f}; GEMM_PHASE(pg8::EpiBf16<0>, WP(OFF_HID), WBP(WE_FDN_A), D, FF, E); }
        GSYNC();
        { PH_IDS PH_WS const float* gains = P.in[3] + (size_t)layer * 8 * D;
          resnorm_rows<true, true, true>(P.out, P.out, WP(OFF_F), 0.5f, gains + 1 * D, gains + 2 * D, WP(OFF_XN), gw, NGW, lane); }
        GSYNC();
        { PH_WS pg8::EpiBf16<0> E{WP(OFF_HID), NINP, nullptr, 0, 0, 1.f}; GEMM_PHASE(pg8::EpiBf16<0>, WP(OFF_XN), WBP(WE_IN), NINP, D, E); }
        GSYNC();
        { PH_IDS PH_WS mixer_prep_rows(P, ws, layer, gw, NGW, lane); }
        GSYNC();
        { PH_WS pg8::EpiQKV E{WP(OFF_Q), WP(OFF_KCAT), WP(OFF_V)}; int kq_ = 384; asm volatile("" : "+s"(kq_)); GEMM_PHASE(pg8::EpiQKV, WP(OFF_QLN), WBP(WE_QUP), 1792, kq_, E); }
        GSYNC();
#ifndef NO_ATTN
        { PH_WS attention_phase(ws, lds); }
#endif
        GSYNC();
#ifdef EXP_SYNC
        for (int rep_ = 0; rep_ < 16; ++rep_) GSYNC();
#endif
        { PH_IDS PH_WS merge_rows(P, ws, layer, gw, NGW, lane); }
        GSYNC();
        { PH_WS pg8::EpiBf16<0> E{WP(OFF_F), D, nullptr, 0, 0, 1.f}; GEMM_PHASE(pg8::EpiBf16<0>, WP(OFF_XN), WBP(WE_OUT), D, D, E); }
        GSYNC();
        { PH_IDS PH_WS const float* gains = P.in[3] + (size_t)layer * 8 * D;
          resnorm_rows<true, true, true>(P.out, P.out, WP(OFF_F), 1.0f, gains + 3 * D, gains + 4 * D, WP(OFF_XN), gw, NGW, lane);
          convert_p(P, ws, layer, gtid, NT); }
        GSYNC();
        { PH_WS pg8::EpiSwiglu E{WP(OFF_HID), FF}; GEMM_PHASE(pg8::EpiSwiglu, WP(OFF_XN), WBP(WE_FIN_B), 2 * FF, D, E); }
        GSYNC();
        { PH_WS pg8::EpiBf16<0> E{WP(OFF_F), D, nullptr, 0, 0, 1.f}; GEMM_PHASE(pg8::EpiBf16<0>, WP(OFF_HID), WBP(WE_FDN_B), D, FF, E); }
        GSYNC();
        { PH_IDS PH_WS const float* gains = P.in[3] + (size_t)layer * 8 * D;
          resnorm_rows<true, true, true>(P.out, P.out, WP(OFF_F), 0.5f, gains + 5 * D, gains + 6 * D, WP(OFF_XN), gw, NGW, lane); }
        { PH_WS pg8::EpiBf16<0> E{WP(OFF_HID), D, nullptr, 0, 0, 1.f}; GEMM_PHASE(pg8::EpiBf16<0>, WP(OFF_QLN), WBP(WE_PLE), D, PLE, E); }
        GSYNC();
        { PH_WS pg8::EpiGate E{WP(OFF_F), WP(OFF_HID), D}; GEMM_PHASE(pg8::EpiGate, WP(OFF_XN), WBP(WE_PG), D, D, E); }
        GSYNC();
        { PH_IDS PH_WS const float* gains = P.in[3] + (size_t)layer * 8 * D;
          if (layer == 1) resnorm_rows<true, true, false>(P.out, P.out, WP(OFF_F), 1.0f, gains + 7 * D, P.in[3], WP(OFF_XN), gw, NGW, lane);
          else resnorm_rows<true, true, true>(P.out, P.out, WP(OFF_F), 1.0f, gains + 7 * D, P.in[3] + (size_t)8 * D, WP(OFF_XN), gw, NGW, lane);
          if (layer == 0) convert_weights(P, ws, 1, lds, gw, NGW, wave, lane); }
        if (layer == 0) GSYNC();
    }
}

extern "C" void kernel_launch(void* const* d_in, const int* in_sizes, int n_in, void* d_out, int out_size, void* d_ws, size_t ws_size, hipStream_t stream) {
    static int grid = 0;
    if (grid == 0) {
        if (n_in != 16 || out_size != T * D || ws_size < WS_NEED) { fprintf(stderr, "kernel_launch: unexpected shapes (n_in %d out %d ws %zu)\n", n_in, out_size, ws_size); grid = -1; return; }
        int dev = 0, cus = 0, per_cu = 0;
        hipGetDevice(&dev); hipDeviceGetAttribute(&cus, hipDeviceAttributeMultiprocessorCount, dev);
        hipFuncSetAttribute((const void*)mega_fwd, hipFuncAttributeMaxDynamicSharedMemorySize, LDS_BYTES);
        hipOccupancyMaxActiveBlocksPerMultiprocessor(&per_cu, (const void*)mega_fwd, NTHREADS, LDS_BYTES);
        (void)hipGetLastError();
        if (per_cu < 1) fprintf(stderr, "kernel_launch: occupancy query says %d\n", per_cu);
        grid = cus;
    }
    if (grid < 0) return;
    if (hipMemsetAsync((char*)d_ws + OFF_BAR, 0, BAR_BYTES, stream) != hipSuccess) { fprintf(stderr, "kernel_launch: memset failed\n"); return; }
    Params p{};
    for (int i = 0; i < 16; ++i) p.in[i] = (const float*)d_in[i];
    p.out = (float*)d_out; p.ws = (unsigned char*)d_ws;
    void* args[] = {&p};
    hipError_t e = hipLaunchCooperativeKernel((const void*)mega_fwd, dim3(grid), dim3(NTHREADS), args, LDS_BYTES, stream);
    if (e != hipSuccess) fprintf(stderr, "cooperative launch failed: %s (grid %d)\n", hipGetErrorString(e), grid);
}
```

```cpp
#include <hip/hip_runtime.h>
#include <hip/hip_cooperative_groups.h>
#include <cstdio>
#include <cstdint>
#include <cmath>
namespace cg = cooperative_groups;
namespace pg8 {
#define PG8_LAS __attribute__((address_space(3)))
typedef unsigned short bf16_t;
typedef short bf16x8 __attribute__((ext_vector_type(8)));
typedef float f32x4 __attribute__((ext_vector_type(4)));
typedef unsigned u32x4 __attribute__((ext_vector_type(4)));
constexpr int BM = 256, BK = 64, HALF = 128, HTB = HALF * BK * 2  , STAGE_BYTES = 8 * HTB, NXCD = 8, WGM = 8;

__host__ __device__ __forceinline__ int lds_byte(int r, int c) { const int st = (r >> 4) * 2 + (c >> 5), rr = r & 15, cc = c & 31, ob = rr * 64 + cc * 2; return st * 1024 + (ob ^ (((ob >> 9) & 1) << 5)); }
__host__ __device__ __forceinline__ void stage_rc(int b, int& R, int& C) { const int st = b / 1024, sb = b % 1024, swz = sb ^ (((sb >> 9) & 1) << 5); R = (st >> 1) * 16 + swz / 64; C = (st & 1) * 32 + (swz % 64) / 2; }
__host__ __device__ __forceinline__ int perm32(int rho) { const int n = rho >> 4, i = rho & 15; return 8 * (i >> 2) + 4 * n + (i & 3); }

struct Unit { int pm, pn; };
struct Gemm { const bf16_t* A; const bf16_t* Bt; int M, N, K; };

struct StaticOrder {
    int nM, nN, nwg, G, c;
    __host__ __device__ void init(int M, int N, int G_, int c_) { nM = M / BM; nN = N / BM; nwg = nM * nN; G = G_; c = c_; }
    __host__ __device__ bool next(int i, Unit& u) const {
        const long L = (long)i * G + c; if (L >= nwg) return false;
        int wgid = (int)L; { const int q = nwg / NXCD, r = nwg % NXCD, xcd = wgid % NXCD, off = wgid / NXCD; wgid = (xcd < r ? xcd * (q + 1) : r * (q + 1) + (xcd - r) * q) + off; }
        const int nig = WGM * nN, gid = wgid / nig, fm = gid * WGM, gsz = (nM - fm) < WGM ? (nM - fm) : WGM;
        u.pm = fm + ((wgid % nig) % gsz); u.pn = (wgid % nig) / gsz; return true;
    }
    __device__ __forceinline__ void a_ready(const Unit&) const {}
    __device__ __forceinline__ void done(const Unit&) const {}
};

__device__ __forceinline__ unsigned cvt_pk_bf16(float lo, float hi) { unsigned r; asm volatile("v_cvt_pk_bf16_f32 %0, %1, %2" : "=v"(r) : "v"(lo), "v"(hi)); return r; }
typedef float f32x2 __attribute__((ext_vector_type(2)));
__device__ __forceinline__ f32x2 gelu_pk(f32x2 v) {
    const f32x2 av = __builtin_elementwise_abs(v), d = av * 0.2316418882f + 1.0f;
    f32x2 t; t.x = __builtin_amdgcn_rcpf(d.x); t.y = __builtin_amdgcn_rcpf(d.y);
    f32x2 q = t * 0.5307027145f + (-0.7265760135f); q = q * t + 0.7107068705f; q = q * t + (-0.142248368f); q = q * t + 0.127414796f; q = q * t;
    const f32x2 s = (v * v) * (-0.72134752044f);
    f32x2 e; e.x = __builtin_amdgcn_exp2f(s.x); e.y = __builtin_amdgcn_exp2f(s.y);
    const f32x2 m = v * (q * e), r = v - m;
    f32x2 o; o.x = v.x < 0.f ? m.x : r.x; o.y = v.y < 0.f ? m.y : r.y; return o;
}

template <int ACT  > struct EpiBf16 {
    static constexpr bool PERM = true, AFTER_DRAIN = false; static_assert(ACT == 0 || ACT == 1, "EpiBf16: ACT is 0 (none) or 1 (gelu_pk)");
    bf16_t* O; int ldc; const float* bias; int split_cols; size_t split_stride; float scale0;
    __device__ __forceinline__ void operator()(const f32x4 (&acc)[2][2][4][2], const Unit& u, int wr, int wc, int fr, int fq) const {
        const int row0 = u.pm * BM + wr * 64 + fr; int colt = u.pn * BM; bf16_t* base = O;
        float sc = 1.f; if (split_cols) { const int t = colt / split_cols; base += (size_t)t * split_stride; colt -= t * split_cols; if (t == 0) sc = scale0; }
        const int col0 = colt + wc * 32 + 8 * fq, bcol0 = u.pn * BM + wc * 32 + 8 * fq;
        f32x4 bv[2][2];
#pragma unroll
        for (int bj = 0; bj < 2; ++bj)
#pragma unroll
            for (int n = 0; n < 2; ++n) bv[bj][n] = bias ? *(const f32x4*)(bias + bcol0 + bj * HALF + 4 * n) : (f32x4){0.f, 0.f, 0.f, 0.f};
#pragma unroll
        for (int ai = 0; ai < 2; ++ai)
#pragma unroll
            for (int m = 0; m < 4; ++m) { bf16_t* rowp = base + (size_t)(row0 + ai * HALF + m * 16) * ldc + col0;
#pragma unroll
                for (int bj = 0; bj < 2; ++bj) { f32x4 v0 = acc[ai][bj][m][0] + bv[bj][0], v1 = acc[ai][bj][m][1] + bv[bj][1];
                    if (ACT == 1) { f32x2 a = gelu_pk((f32x2){v0[0], v0[1]}), b = gelu_pk((f32x2){v0[2], v0[3]}), c = gelu_pk((f32x2){v1[0], v1[1]}), d = gelu_pk((f32x2){v1[2], v1[3]});
                        v0 = (f32x4){a.x, a.y, b.x, b.y}; v1 = (f32x4){c.x, c.y, d.x, d.y}; }
                    v0 = v0 * sc; v1 = v1 * sc; u32x4 w; w.x = cvt_pk_bf16(v0[0], v0[1]); w.y = cvt_pk_bf16(v0[2], v0[3]); w.z = cvt_pk_bf16(v1[0], v1[1]); w.w = cvt_pk_bf16(v1[2], v1[3]);
                    *(u32x4*)(rowp + bj * HALF) = w; } }
    }
};

template <class Epi, class Sched, bool ALIGN_EPI = false, bool SP2 = false>
__device__ __forceinline__ void gemm_phase(PG8_LAS unsigned char* lds, const Gemm g, const Sched& S, const Epi& E) {
    int tid_ = threadIdx.x; asm volatile("" : "+v"(tid_));
    const int tid = tid_, wid = __builtin_amdgcn_readfirstlane(tid >> 6), lane = tid & 63, wr = wid >> 2, wc = wid & 3, fr = lane & 15, fq = lane >> 4;
    const int K = g.K, nt = K / BK;
    unsigned voffA[2], voffB[2];
#pragma unroll
    for (int i = 0; i < 2; ++i) { int R, C; stage_rc(tid * 16 + i * 8192, R, C); const int Rb = Epi::PERM ? ((R & ~31) + perm32(R & 31)) : R;
        voffA[i] = (unsigned)(R * K + C) * 2u; voffB[i] = (unsigned)(Rb * K + C) * 2u; }
    const size_t kstep = (size_t)(BK * 2);
    const size_t hstep = (size_t)HALF * K * 2;
    const size_t tstep = 2 * hstep;
    const unsigned ldsw = (unsigned)wid * 1024u;
    const int aoff = lds_byte(wr * 64 + fr, fq * 8), boff = lds_byte(wc * 32 + fr, fq * 8);
#define PG8_SA(b, h) (((b) * 2 + (h)) * HTB)
#define PG8_SB(b, h) ((4 + (b) * 2 + (h)) * HTB)
#define PG8_STAGE(bufoff, gbase, voff) do { _Pragma("unroll") for (int _i = 0; _i < 2; ++_i) \
        __builtin_amdgcn_global_load_lds((const unsigned*)((const char*)(gbase) + (voff)[_i]), (PG8_LAS unsigned*)(lds + (bufoff) + ldsw + _i * 8192), 16, 0, 0); } while (0)
#define PG8_LDA(dst, b, h) do { _Pragma("unroll") for (int m = 0; m < 4; ++m) _Pragma("unroll") for (int k = 0; k < 2; ++k) dst[m][k] = *(const PG8_LAS bf16x8*)(lds + PG8_SA(b, h) + aoff + m * 2048 + k * 1024); } while (0)
#define PG8_LDB(dst, b, h) do { _Pragma("unroll") for (int n = 0; n < 2; ++n) _Pragma("unroll") for (int k = 0; k < 2; ++k) dst[n][k] = *(const PG8_LAS bf16x8*)(lds + PG8_SB(b, h) + boff + n * 2048 + k * 1024); } while (0)
#define PG8_MMA(ai, bj, At, Bt) do { __builtin_amdgcn_s_setprio(1); _Pragma("unroll") for (int m = 0; m < 4; ++m) _Pragma("unroll") for (int n = 0; n < 2; ++n) _Pragma("unroll") for (int k = 0; k < 2; ++k) \
        acc[ai][bj][m][n] = __builtin_amdgcn_mfma_f32_16x16x32_bf16(Bt[n][k], At[m][k], acc[ai][bj][m][n], 0, 0, 0); __builtin_amdgcn_s_setprio(0); } while (0)
#define PG8_WAIT_V(n) asm volatile("s_waitcnt vmcnt(" #n ")" ::: "memory")
#define PG8_WAIT_L(n) asm volatile("s_waitcnt lgkmcnt(" #n ")" ::: "memory")
#define PG8_BAR __builtin_amdgcn_s_barrier()
#define PG8_SCHED __builtin_amdgcn_sched_barrier(0)
    float zf_ = 0.f; asm volatile("" : "+v"(zf_)); const f32x4 zero4_ = {zf_, zf_, zf_, zf_};
    Unit cur, nxt; int ui = 0;
    if (!S.next(0, cur)) return;
    f32x4 acc[2][2][4][2];
#pragma unroll
    for (int a = 0; a < 2; ++a)
#pragma unroll
        for (int b = 0; b < 2; ++b)
#pragma unroll
            for (int m = 0; m < 4; ++m)
#pragma unroll
                for (int n = 0; n < 2; ++n) acc[a][b][m][n] = zero4_;
    bf16x8 At[4][2], B0[2][2], B1[2][2];
    const char* cA = (const char*)g.A + (size_t)cur.pm * tstep; const char* cB = (const char*)g.Bt + (size_t)cur.pn * tstep;
    S.a_ready(cur);
    if constexpr (SP2) {
        PG8_STAGE(PG8_SB(0, 0), cB, voffB); PG8_STAGE(PG8_SB(0, 1), cB + hstep, voffB); PG8_STAGE(PG8_SA(0, 0), cA, voffA); PG8_STAGE(PG8_SA(0, 1), cA + hstep, voffA);
        if (wr == 1) PG8_BAR;
        PG8_WAIT_V(2); PG8_BAR;
        PG8_STAGE(PG8_SB(1, 0), cB + kstep, voffB); PG8_STAGE(PG8_SA(1, 0), cA + kstep, voffA); PG8_STAGE(PG8_SB(1, 1), cB + hstep + kstep, voffB);
        PG8_WAIT_V(6); PG8_BAR;
    } else {
        PG8_STAGE(PG8_SB(0, 0), cB, voffB); PG8_STAGE(PG8_SA(0, 0), cA, voffA); PG8_STAGE(PG8_SB(0, 1), cB + hstep, voffB); PG8_STAGE(PG8_SA(0, 1), cA + hstep, voffA);
        if (wr == 1) PG8_BAR;
        PG8_WAIT_V(4); PG8_BAR;
        PG8_STAGE(PG8_SB(1, 0), cB + kstep, voffB); PG8_STAGE(PG8_SA(1, 0), cA + kstep, voffA); PG8_STAGE(PG8_SB(1, 1), cB + hstep + kstep, voffB);
        PG8_WAIT_V(6); PG8_BAR;
    }
    for (;;) {
        const bool has_next = S.next(ui + 1, nxt);
        const char* nA = has_next ? (const char*)g.A + (size_t)nxt.pm * tstep : cA; const char* nB = has_next ? (const char*)g.Bt + (size_t)nxt.pn * tstep : cB;
        for (int t = 0; t < nt; t += 2) {
            const bool last = (t == nt - 2);
            const char* a1 = cA + (size_t)(t + 1) * kstep;
            const char* a2 = last ? nA : cA + (size_t)(t + 2) * kstep; const char* b2 = last ? nB : cB + (size_t)(t + 2) * kstep;
            const char* a3 = a2 + kstep; const char* b3 = b2 + kstep;
            if (last && has_next) S.a_ready(nxt);
            if constexpr (SP2) {
            PG8_LDB(B0, 0, 0); PG8_LDB(B1, 0, 1); PG8_SCHED; PG8_LDA(At, 0, 0); PG8_STAGE(PG8_SA(1, 1), a1 + hstep, voffA);
            PG8_WAIT_V(8); PG8_WAIT_L(0); PG8_BAR; PG8_MMA(0, 0, At, B0); PG8_MMA(0, 1, At, B1); PG8_BAR; PG8_SCHED;
            PG8_LDA(At, 0, 1); PG8_STAGE(PG8_SB(0, 0), b2, voffB); PG8_STAGE(PG8_SB(0, 1), b2 + hstep, voffB); PG8_STAGE(PG8_SA(0, 0), a2, voffA);
            PG8_WAIT_V(8); PG8_WAIT_L(0); PG8_BAR; PG8_MMA(1, 0, At, B0); PG8_MMA(1, 1, At, B1); PG8_BAR; PG8_SCHED;
            PG8_LDB(B0, 1, 0); PG8_LDB(B1, 1, 1); PG8_SCHED; PG8_LDA(At, 1, 0); PG8_STAGE(PG8_SA(0, 1), a2 + hstep, voffA);
            PG8_WAIT_V(8); PG8_WAIT_L(0); PG8_BAR; PG8_MMA(0, 0, At, B0); PG8_MMA(0, 1, At, B1); PG8_BAR; PG8_SCHED;
            PG8_LDA(At, 1, 1); PG8_STAGE(PG8_SB(1, 0), b3, voffB); PG8_STAGE(PG8_SB(1, 1), b3 + hstep, voffB); PG8_STAGE(PG8_SA(1, 0), a3, voffA);
            PG8_WAIT_V(8); PG8_WAIT_L(0); PG8_BAR; PG8_MMA(1, 0, At, B0); PG8_MMA(1, 1, At, B1); PG8_BAR; PG8_SCHED;
            } else {
            PG8_LDB(B0, 0, 0); PG8_SCHED; PG8_LDA(At, 0, 0); PG8_STAGE(PG8_SA(1, 1), a1 + hstep, voffA);
            PG8_WAIT_L(8); PG8_BAR; PG8_WAIT_L(0); PG8_MMA(0, 0, At, B0); PG8_BAR; PG8_SCHED;
            PG8_LDB(B1, 0, 1); PG8_STAGE(PG8_SB(0, 0), b2, voffB);
            PG8_BAR; PG8_WAIT_L(0); PG8_MMA(0, 1, At, B1); PG8_BAR;
            PG8_LDA(At, 0, 1); PG8_STAGE(PG8_SA(0, 0), a2, voffA);
            PG8_BAR; PG8_WAIT_L(0); PG8_MMA(1, 0, At, B0); PG8_BAR; PG8_SCHED;
            PG8_STAGE(PG8_SB(0, 1), b2 + hstep, voffB);
            PG8_WAIT_V(6); PG8_BAR; PG8_MMA(1, 1, At, B1); PG8_BAR;
            PG8_LDB(B0, 1, 0); PG8_SCHED; PG8_LDA(At, 1, 0); PG8_STAGE(PG8_SA(0, 1), a2 + hstep, voffA);
            PG8_WAIT_L(8); PG8_BAR; PG8_WAIT_L(0); PG8_MMA(0, 0, At, B0); PG8_BAR; PG8_SCHED;
            PG8_LDB(B1, 1, 1); PG8_STAGE(PG8_SB(1, 0), b3, voffB);
            PG8_BAR; PG8_WAIT_L(0); PG8_MMA(0, 1, At, B1); PG8_BAR;
            PG8_LDA(At, 1, 1); PG8_STAGE(PG8_SA(1, 0), a3, voffA);
            PG8_BAR; PG8_WAIT_L(0); PG8_MMA(1, 0, At, B0); PG8_BAR; PG8_SCHED;
            PG8_STAGE(PG8_SB(1, 1), b3 + hstep, voffB);
            PG8_WAIT_V(6); PG8_BAR; PG8_MMA(1, 1, At, B1); PG8_BAR;
            }
        }
        if constexpr (ALIGN_EPI) { if (wr == 0) PG8_BAR; }
        if constexpr (!Epi::AFTER_DRAIN) { E(acc, cur, wr, wc, fr, fq); S.done(cur); }
        if (!has_next) break;
#pragma unroll
        for (int a = 0; a < 2; ++a)
#pragma unroll
            for (int b = 0; b < 2; ++b)
#pragma unroll
                for (int m = 0; m < 4; ++m)
#pragma unroll
                    for (int n = 0; n < 2; ++n) acc[a][b][m][n] = zero4_;
        cur = nxt; cA = nA; cB = nB; ++ui;
        if constexpr (ALIGN_EPI) { if (wr == 1) PG8_BAR; }
    }
    PG8_WAIT_V(0);
    if constexpr (!ALIGN_EPI) { if (wr == 0) PG8_BAR; }
    PG8_BAR;
    if constexpr (Epi::AFTER_DRAIN) { E.fused(acc, cur, wr, wc, fr, fq, lds, wid, lane); S.done(cur); }
#undef PG8_SA
#undef PG8_SB
#undef PG8_STAGE
#undef PG8_LDA
#undef PG8_LDB
#undef PG8_MMA
#undef PG8_WAIT_V
#undef PG8_WAIT_L
#undef PG8_BAR
#undef PG8_SCHED
}
}

#define LAS __attribute__((address_space(3)))
typedef unsigned short bf16;
typedef unsigned v4u __attribute__((ext_vector_type(4)));
typedef unsigned v2u __attribute__((ext_vector_type(2)));
typedef float fx4 __attribute__((ext_vector_type(4)));
typedef float fx2 __attribute__((ext_vector_type(2)));
typedef float fx16 __attribute__((ext_vector_type(16)));
typedef short hx8 __attribute__((ext_vector_type(8)));
typedef short hx4 __attribute__((ext_vector_type(4)));
typedef __bf16 bfx2_t __attribute__((ext_vector_type(2)));

constexpr int NB = 4, SEQ = 8192, T = NB * SEQ, D = 1024, FF = 2816, NIN = 1952, NINP = 2048, PLE = 256;
constexpr int QL = 256, KVL = 128;
constexpr float EPS = 1e-6f;
constexpr int NTHREADS = 512;
constexpr int LDS_BYTES = 131072 + 1024;

constexpr size_t MiB = 1u << 20;
constexpr size_t OFF_WB = 0;
constexpr size_t OFF_TAB = 48 * MiB;
constexpr size_t OFF_LSE = 60 * MiB;
constexpr size_t OFF_XN = 64 * MiB;
constexpr size_t OFF_F = 128 * MiB;
constexpr size_t OFF_HID = 192 * MiB;
constexpr size_t OFF_Q = OFF_HID + 128 * MiB;
constexpr size_t OFF_KCAT = 368 * MiB;
constexpr size_t OFF_V = 416 * MiB;
constexpr size_t OFF_QLN = 448 * MiB;
constexpr size_t OFF_KVLN = 464 * MiB;
constexpr size_t OFF_BAR = 472 * MiB;
constexpr size_t BAR_BYTES = 16384;
constexpr size_t WS_NEED = 473 * MiB;
constexpr size_t WE_FIN_A = 0;
constexpr size_t WE_FDN_A = WE_FIN_A + (size_t)2 * FF * D;
constexpr size_t WE_FIN_B = WE_FDN_A + (size_t)D * FF;
constexpr size_t WE_FDN_B = WE_FIN_B + (size_t)2 * FF * D;
constexpr size_t WE_IN = WE_FDN_B + (size_t)D * FF;
constexpr size_t WE_QUP = WE_IN + (size_t)NINP * D;
constexpr size_t WE_OUT = WE_QUP + (size_t)1792 * 384;
constexpr size_t WE_PLE = WE_OUT + (size_t)D * D;
constexpr size_t WE_PG = WE_PLE + (size_t)D * PLE;
constexpr size_t WE_END = WE_PG + (size_t)D * D;
static_assert(WE_END * 2 <= 48 * MiB, "weights fit");

__device__ const float INV_M[16] = {1.000000000e+00f, 5.623413324e-01f, 3.162277639e-01f, 1.778279394e-01f, 1.000000015e-01f, 5.623413250e-02f, 3.162277490e-02f, 1.778279431e-02f, 9.999999776e-03f, 5.623413250e-03f, 3.162277630e-03f, 1.778279431e-03f, 1.000000047e-03f, 5.623413017e-04f, 3.162277571e-04f, 1.778279402e-04f};
__device__ const float INV_D[32] = {1.000000000e+00f, 7.498942614e-01f, 5.623413324e-01f, 4.216965139e-01f, 3.162277639e-01f, 2.371373773e-01f, 1.778279394e-01f, 1.333521307e-01f, 1.000000015e-01f, 7.498941571e-02f, 5.623413250e-02f, 4.216965288e-02f, 3.162277490e-02f, 2.371373773e-02f, 1.778279431e-02f, 1.333521493e-02f, 9.999999776e-03f, 7.498941850e-03f, 5.623413250e-03f, 4.216964822e-03f, 3.162277630e-03f, 2.371373586e-03f, 1.778279431e-03f, 1.333521446e-03f, 1.000000047e-03f, 7.498942432e-04f, 5.623413017e-04f, 4.216965172e-04f, 3.162277571e-04f, 2.371373703e-04f, 1.778279402e-04f, 1.333521504e-04f};

struct Params { const float* in[16]; float* out; unsigned char* ws; };

__device__ __forceinline__ unsigned pk2(float lo, float hi) { fx2 v = {lo, hi}; bfx2_t b = __builtin_convertvector(v, bfx2_t); return __builtin_bit_cast(unsigned, b); }
__device__ __forceinline__ float bflo(unsigned u) { return __uint_as_float(u << 16); }
__device__ __forceinline__ float bfhi(unsigned u) { return __uint_as_float(u & 0xffff0000u); }
__device__ __forceinline__ float wave_sum(float v) {
#pragma unroll
    for (int o = 1; o < 64; o <<= 1) v += __shfl_xor(v, o);
    return v;
}
__device__ __forceinline__ float fast_rcp(float x) { return __builtin_amdgcn_rcpf(x); }
__device__ __forceinline__ float fast_exp2(float x) { return __builtin_amdgcn_exp2f(x); }
__device__ __forceinline__ float fast_rsq(float x) { return __builtin_amdgcn_rsqf(x); }

namespace pg8 {
struct EpiSwiglu {
    static constexpr bool PERM = true, AFTER_DRAIN = false;
    bf16_t* O; int ldc;
    __device__ __forceinline__ void operator()(const f32x4 (&acc)[2][2][4][2], const Unit& u, int wr, int wc, int fr, int fq) const {
        const int row0 = u.pm * BM + wr * 64 + fr; const int col0 = u.pn * 128 + wc * 32 + 8 * fq;
#pragma unroll
        for (int ai = 0; ai < 2; ++ai)
#pragma unroll
            for (int m = 0; m < 4; ++m) {
                bf16_t* rowp = O + (size_t)(row0 + ai * HALF + m * 16) * ldc + col0;
                float h[8];
#pragma unroll
                for (int n = 0; n < 2; ++n)
#pragma unroll
                    for (int e = 0; e < 4; ++e) {
                        const float g = acc[ai][0][m][n][e], up = acc[ai][1][m][n][e];
                        const float sg = g * __builtin_amdgcn_rcpf(1.0f + __builtin_amdgcn_exp2f(-1.4426950408889634f * g));
                        h[n * 4 + e] = sg * up;
                    }
                u32x4 w; w.x = ::pk2(h[0], h[1]); w.y = ::pk2(h[2], h[3]); w.z = ::pk2(h[4], h[5]); w.w = ::pk2(h[6], h[7]);
                *(u32x4*)rowp = w;
            }
    }
};
struct EpiQKV {
    static constexpr bool PERM = true, AFTER_DRAIN = false;
    bf16_t* Q; bf16_t* Kc; bf16_t* V;
    __device__ __forceinline__ void operator()(const f32x4 (&acc)[2][2][4][2], const Unit& u, int wr, int wc, int fr, int fq) const {
        const int row0 = u.pm * BM + wr * 64 + fr;
#pragma unroll
        for (int bj = 0; bj < 2; ++bj) {
            bf16_t* ub; int rs;
            if (u.pn < 3) { ub = Q + u.pn * 256 + bj * 128 + wc * 32; rs = 768; }
            else { const int head = 2 * (u.pn - 3) + bj; if (wc < 2) { ub = Kc + head * 96 + wc * 32; rs = 768; } else { ub = V + head * 64 + (wc * 32 - 64); rs = 512; } }
            const unsigned loff = (unsigned)row0 * (unsigned)rs + 8u * (unsigned)fq;
#pragma unroll
            for (int ai = 0; ai < 2; ++ai)
#pragma unroll
                for (int m = 0; m < 4; ++m) {
                    bf16_t* dst = ub + (loff + (unsigned)((ai * HALF + m * 16) * rs));
                    const f32x4 v0 = acc[ai][bj][m][0], v1 = acc[ai][bj][m][1];
                    u32x4 w; w.x = ::pk2(v0[0], v0[1]); w.y = ::pk2(v0[2], v0[3]); w.z = ::pk2(v1[0], v1[1]); w.w = ::pk2(v1[2], v1[3]);
                    *(u32x4*)dst = w;
                }
        }
    }
};
struct EpiGate {
    static constexpr bool PERM = true, AFTER_DRAIN = false;
    bf16_t* O; const bf16_t* PP; int ldc;
    __device__ __forceinline__ void operator()(const f32x4 (&acc)[2][2][4][2], const Unit& u, int wr, int wc, int fr, int fq) const {
        const int row0 = u.pm * BM + wr * 64 + fr; const int col0 = u.pn * BM + wc * 32 + 8 * fq;
#pragma unroll
        for (int ai = 0; ai < 2; ++ai)
#pragma unroll
            for (int m = 0; m < 4; ++m)
#pragma unroll
                for (int bj = 0; bj < 2; ++bj) {
                    const size_t off = (size_t)(row0 + ai * HALF + m * 16) * ldc + col0 + bj * HALF;
                    const u32x4 pv = *(const u32x4*)(PP + off);
                    float pp[8] = {::bflo(pv.x), ::bfhi(pv.x), ::bflo(pv.y), ::bfhi(pv.y), ::bflo(pv.z), ::bfhi(pv.z), ::bflo(pv.w), ::bfhi(pv.w)};
                    float o[8];
#pragma unroll
                    for (int n = 0; n < 2; ++n)
#pragma unroll
                        for (int e = 0; e < 4; ++e) {
                            const float g = acc[ai][bj][m][n][e];
                            o[n * 4 + e] = pp[n * 4 + e] * __builtin_amdgcn_rcpf(1.0f + __builtin_amdgcn_exp2f(-1.4426950408889634f * g));
                        }
                    u32x4 w; w.x = ::pk2(o[0], o[1]); w.y = ::pk2(o[2], o[3]); w.z = ::pk2(o[4], o[5]); w.w = ::pk2(o[6], o[7]);
                    *(u32x4*)(O + off) = w;
                }
    }
};
}

__device__ __forceinline__ void tr_item(const float* W, int K, int N, int k0, int n0, bf16* WT, int drow0, int ldk, int dk, LAS float* scr, int lane) {
#pragma unroll 8
    for (int i = 0; i < 32; ++i) { const int kk = 2 * i + (lane >> 5); scr[kk * 33 + (lane & 31)] = W[(size_t)(k0 + kk) * N + n0 + (lane & 31)]; }
    asm volatile("s_waitcnt lgkmcnt(0)" ::: "memory");
    const int c = lane & 7;
#pragma unroll
    for (int j = 0; j < 4; ++j) { const int n = (lane >> 3) + 8 * j; const LAS float* s = scr + (8 * c) * 33 + n;
        v4u o; o.x = pk2(s[0 * 33], s[1 * 33]); o.y = pk2(s[2 * 33], s[3 * 33]); o.z = pk2(s[4 * 33], s[5 * 33]); o.w = pk2(s[6 * 33], s[7 * 33]);
        *(v4u*)(WT + (size_t)(drow0 + n) * ldk + dk + k0 + 8 * c) = o; }
    asm volatile("s_waitcnt lgkmcnt(0)" ::: "memory");
}
__device__ __forceinline__ void tr_matrix_item(const float* W, int K, int N, bf16* WT, int mode, int item, LAS float* scr, int lane, int ldk = 0, int dk = 0) {
    const int nblk = N / 32, kb = item / nblk, nb = item % nblk, k0 = 64 * kb, n0 = 32 * nb;
    int drow0 = n0;
    if (mode != 0) drow0 = 256 * (n0 >> 7) + (n0 & 127) + (mode == 2 ? 128 : 0);
    tr_item(W, K, N, k0, n0, WT, drow0, ldk ? ldk : K, dk, scr, lane);
}
__device__ __forceinline__ void convert_weights(const Params& P, unsigned char* ws, int layer, LAS unsigned char* lds, int gw, int NGW, int wave, int lane) {
    LAS float* scr = (LAS float*)(lds + wave * 16384);
    bf16* WB = (bf16*)(ws + OFF_WB);
    const float* w_in = P.in[4] + (size_t)layer * D * NIN;
    const float* w_qup = P.in[6] + (size_t)layer * QL * 768;
    const float* w_kvup = P.in[8] + (size_t)layer * KVL * 1024;
    const float* w_out = P.in[10] + (size_t)layer * D * D;
    const float* fg = P.in[11] + (size_t)layer * 2 * D * FF;
    const float* fu = P.in[12] + (size_t)layer * 2 * D * FF;
    const float* fd = P.in[13] + (size_t)layer * 2 * FF * D;
    const float* w_ple = P.in[14] + (size_t)layer * PLE * D;
    const float* w_pg = P.in[15] + (size_t)layer * D * D;
    constexpr int I_FIN = (D / 64) * (FF / 32);
    constexpr int I_FDN = (FF / 64) * (D / 32);
    constexpr int I_IN = (D / 64) * (NIN / 32);
    constexpr int I_QUP = (QL / 64) * (768 / 32);
    constexpr int I_KVUP = (KVL / 64) * (1024 / 32);
    constexpr int I_DD = (D / 64) * (D / 32);
    constexpr int I_PLE = (PLE / 64) * (D / 32);
    constexpr int NITEMS = 4 * I_FIN + 2 * I_FDN + I_IN + I_QUP + I_KVUP + 2 * I_DD + I_PLE;
    for (int it = gw; it < NITEMS; it += NGW) {
        int r = it;
        if (r < I_FIN) { tr_matrix_item(fg, D, FF, WB + WE_FIN_A, 1, r, scr, lane); continue; } r -= I_FIN;
        if (r < I_FIN) { tr_matrix_item(fu, D, FF, WB + WE_FIN_A, 2, r, scr, lane); continue; } r -= I_FIN;
        if (r < I_FIN) { tr_matrix_item(fg + (size_t)D * FF, D, FF, WB + WE_FIN_B, 1, r, scr, lane); continue; } r -= I_FIN;
        if (r < I_FIN) { tr_matrix_item(fu + (size_t)D * FF, D, FF, WB + WE_FIN_B, 2, r, scr, lane); continue; } r -= I_FIN;
        if (r < I_FDN) { tr_matrix_item(fd, FF, D, WB + WE_FDN_A, 0, r, scr, lane); continue; } r -= I_FDN;
        if (r < I_FDN) { tr_matrix_item(fd + (size_t)FF * D, FF, D, WB + WE_FDN_B, 0, r, scr, lane); continue; } r -= I_FDN;
        if (r < I_IN) { tr_matrix_item(w_in, D, NIN, WB + WE_IN, 0, r, scr, lane); continue; } r -= I_IN;
        if (r < I_QUP) { tr_matrix_item(w_qup, QL, 768, WB + WE_QUP, 0, r, scr, lane, 384, 0); continue; } r -= I_QUP;
        if (r < I_KVUP) { tr_matrix_item(w_kvup, KVL, 1024, WB + WE_QUP + (size_t)768 * 384, 0, r, scr, lane, 384, 256); continue; } r -= I_KVUP;
        if (r < I_DD) { tr_matrix_item(w_out, D, D, WB + WE_OUT, 0, r, scr, lane); continue; } r -= I_DD;
        if (r < I_PLE) { tr_matrix_item(w_ple, PLE, D, WB + WE_PLE, 0, r, scr, lane); continue; } r -= I_PLE;
        tr_matrix_item(w_pg, D, D, WB + WE_PG, 0, r, scr, lane);
    }
    {
        v4u* qk = (v4u*)(WB + WE_QUP); unsigned z0_ = 0u; asm volatile("" : "+v"(z0_)); const v4u z = {z0_, z0_, z0_, z0_};
        const int gt = gw * 64 + lane, NTT = NGW * 64;
        for (int i = gt; i < 768 * 16; i += NTT) { const int row = i >> 4, ch = i & 15; qk[(size_t)row * 48 + 32 + ch] = z; }
        for (int i = gt; i < 1024 * 32; i += NTT) { const int row = 768 + (i >> 5), ch = i & 31; qk[(size_t)row * 48 + ch] = z; }
    }
}

__device__ __forceinline__ void rope_tables(const Params& P, unsigned char* ws, int gtid, int NT) {
    const int* pos = (const int*)P.in[2];
    float* cosM = (float*)(ws + OFF_TAB); float* sinM = cosM + (size_t)T * 16; float* cosD = sinM + (size_t)T * 16; float* sinD = cosD + (size_t)T * 32;
    for (int e = gtid; e < T * 48; e += NT) {
        const int tok = e / 48, i = e % 48;
        const float inv = (i < 16) ? INV_M[i] : INV_D[i - 16];
        const float ang = (float)pos[tok] * inv;
        double tt = (double)ang * 0.15915494309189535; tt -= __builtin_rint(tt);
        const float rev = (float)tt;
        const float c = __builtin_amdgcn_cosf(rev), s = __builtin_amdgcn_sinf(rev);
        if (i < 16) { cosM[(size_t)tok * 16 + i] = c; sinM[(size_t)tok * 16 + i] = s; }
        else { cosD[(size_t)tok * 32 + i - 16] = c; sinD[(size_t)tok * 32 + i - 16] = s; }
    }
}

template <bool HAS_F, bool HIN_BF, bool HOUT_BF>
__device__ __forceinline__ void resnorm_rows(const void* hin, void* hout, const bf16* f, float alpha, const float* ga, const float* gb, bf16* xn, int gw, int NGW, int lane) {
  if constexpr (HAS_F && HIN_BF) {
    int m = gw; if (m >= T) return;
    v2u ch[4], cf[4];
    { const v2u* hr = (const v2u*)((const bf16*)hin + (size_t)m * 2048) + lane; const v2u* fr = (const v2u*)(f + (size_t)m * D) + lane;
#pragma unroll
      for (int j = 0; j < 4; ++j) { ch[j] = hr[64 * j]; cf[j] = fr[64 * j]; } }
    fx4 g1[4], g2[4];
#pragma unroll
    for (int j = 0; j < 4; ++j) { g1[j] = ((const fx4*)ga)[lane + 64 * j]; g2[j] = ((const fx4*)gb)[lane + 64 * j]; }
    for (; m < T; m += NGW) {
        const int mn = m + NGW; v2u nh[4], nf[4];
        if (mn < T) { const v2u* hr = (const v2u*)((const bf16*)hin + (size_t)mn * 2048) + lane; const v2u* fr = (const v2u*)(f + (size_t)mn * D) + lane;
#pragma unroll
            for (int j = 0; j < 4; ++j) { nh[j] = hr[64 * j]; nf[j] = fr[64 * j]; } }
        fx4 hv[4], fv[4]; float ss = 0.f;
#pragma unroll
        for (int j = 0; j < 4; ++j) { hv[j] = (fx4){bflo(ch[j].x), bfhi(ch[j].x), bflo(ch[j].y), bfhi(ch[j].y)}; fv[j] = (fx4){bflo(cf[j].x), bfhi(cf[j].x), bflo(cf[j].y), bfhi(cf[j].y)};
            ss += (fv[j].x * fv[j].x + fv[j].y * fv[j].y) + (fv[j].z * fv[j].z + fv[j].w * fv[j].w); }
        const float rstd = fast_rsq(wave_sum(ss) * (1.0f / D) + EPS) * alpha;
#pragma unroll
        for (int j = 0; j < 4; ++j) hv[j] = hv[j] + fv[j] * g1[j] * rstd;
        if (HOUT_BF) { v2u* ho = (v2u*)((bf16*)hout + (size_t)m * 2048) + lane;
#pragma unroll
            for (int j = 0; j < 4; ++j) ho[64 * j] = (v2u){pk2(hv[j].x, hv[j].y), pk2(hv[j].z, hv[j].w)};
        } else { fx4* ho = (fx4*)((float*)hout + (size_t)m * D) + lane;
#pragma unroll
            for (int j = 0; j < 4; ++j) ho[64 * j] = hv[j]; }
        float s2 = 0.f;
#pragma unroll
        for (int j = 0; j < 4; ++j) s2 += (hv[j].x * hv[j].x + hv[j].y * hv[j].y) + (hv[j].z * hv[j].z + hv[j].w * hv[j].w);
        const float rstd2 = fast_rsq(wave_sum(s2) * (1.0f / D) + EPS);
        v2u* xo = (v2u*)(xn + (size_t)m * D) + lane;
#pragma unroll
        for (int j = 0; j < 4; ++j) { const fx4 y = hv[j] * g2[j] * rstd2; xo[64 * j] = (v2u){pk2(y.x, y.y), pk2(y.z, y.w)}; }
#pragma unroll
        for (int j = 0; j < 4; ++j) { ch[j] = nh[j]; cf[j] = nf[j]; }
    }
  } else {
    for (int m = gw; m < T; m += NGW) {
        fx4 hv[4];
        if (HIN_BF) {
            const v2u* hr = (const v2u*)((const bf16*)hin + (size_t)m * 2048) + lane;
#pragma unroll
            for (int j = 0; j < 4; ++j) { const v2u w = hr[64 * j]; hv[j] = (fx4){bflo(w.x), bfhi(w.x), bflo(w.y), bfhi(w.y)}; }
        } else {
            const fx4* hr = (const fx4*)((const float*)hin + (size_t)m * D) + lane;
#pragma unroll
            for (int j = 0; j < 4; ++j) hv[j] = hr[64 * j];
        }
        if (HAS_F) {
            const v2u* fr = (const v2u*)(f + (size_t)m * D) + lane;
            fx4 fv[4]; float ss = 0.f;
#pragma unroll
            for (int j = 0; j < 4; ++j) { const v2u w = fr[64 * j]; fv[j] = (fx4){bflo(w.x), bfhi(w.x), bflo(w.y), bfhi(w.y)}; ss += (fv[j].x * fv[j].x + fv[j].y * fv[j].y) + (fv[j].z * fv[j].z + fv[j].w * fv[j].w); }
            const float rstd = fast_rsq(wave_sum(ss) * (1.0f / D) + EPS) * alpha;
#pragma unroll
            for (int j = 0; j < 4; ++j) { const fx4 g = ((const fx4*)ga)[lane + 64 * j]; hv[j] = hv[j] + fv[j] * g * rstd; }
        }
        if (HOUT_BF) {
            v2u* ho = (v2u*)((bf16*)hout + (size_t)m * 2048) + lane;
#pragma unroll
            for (int j = 0; j < 4; ++j) ho[64 * j] = (v2u){pk2(hv[j].x, hv[j].y), pk2(hv[j].z, hv[j].w)};
        } else {
            fx4* ho = (fx4*)((float*)hout + (size_t)m * D) + lane;
#pragma unroll
            for (int j = 0; j < 4; ++j) ho[64 * j] = hv[j];
        }
        float s2 = 0.f;
#pragma unroll
        for (int j = 0; j < 4; ++j) s2 += (hv[j].x * hv[j].x + hv[j].y * hv[j].y) + (hv[j].z * hv[j].z + hv[j].w * hv[j].w);
        const float rstd2 = fast_rsq(wave_sum(s2) * (1.0f / D) + EPS);
        v2u* xo = (v2u*)(xn + (size_t)m * D) + lane;
#pragma unroll
        for (int j = 0; j < 4; ++j) { const fx4 g = ((const fx4*)gb)[lane + 64 * j]; const fx4 y = hv[j] * g * rstd2; xo[64 * j] = (v2u){pk2(y.x, y.y), pk2(y.z, y.w)}; }
    }
  }
}

__device__ __forceinline__ void mixer_prep_rows(const Params& P, unsigned char* ws, int layer, int gw, int NGW, int lane) {
    bf16* Z = (bf16*)(ws + OFF_HID); bf16* qkv = (bf16*)(ws + OFF_QLN); bf16* Kc = (bf16*)(ws + OFF_KCAT);
    const float* cosM = (const float*)(ws + OFF_TAB); const float* sinM = cosM + (size_t)T * 16; const float* cosD = sinM + (size_t)T * 16; const float* sinD = cosD + (size_t)T * 32;
    const float* qn = P.in[5] + (size_t)layer * QL; const float* kvn = P.in[7] + (size_t)layer * KVL;
    for (int m = gw; m < T; m += NGW) {
        bf16* z = Z + (size_t)m * NINP;
        {
            const v2u w = ((const v2u*)z)[lane]; const fx4 v = {bflo(w.x), bfhi(w.x), bflo(w.y), bfhi(w.y)};
            const float ss = (v.x * v.x + v.y * v.y) + (v.z * v.z + v.w * v.w);
            const float rstd = fast_rsq(wave_sum(ss) * (1.0f / QL) + EPS);
            const fx4 g = ((const fx4*)qn)[lane]; const fx4 y = v * g * rstd;
            ((v2u*)(qkv + (size_t)m * 384))[lane] = (v2u){pk2(y.x, y.y), pk2(y.z, y.w)};
        }
        {
            const unsigned w = ((const unsigned*)(z + 256))[lane]; const float a = bflo(w), b = bfhi(w);
            const float rstd = fast_rsq(wave_sum(a * a + b * b) * (1.0f / KVL) + EPS);
            const fx2 g = ((const fx2*)kvn)[lane];
            ((unsigned*)(qkv + (size_t)m * 384 + 256))[lane] = pk2(a * g.x * rstd, b * g.y * rstd);
        }
        if (lane < 16) {
            const float x1 = __uint_as_float((unsigned)z[384 + lane] << 16), x2 = __uint_as_float((unsigned)z[400 + lane] << 16);
            const float c = cosM[(size_t)m * 16 + lane], s = sinM[(size_t)m * 16 + lane];
            const unsigned o = pk2(x1 * c - x2 * s, x2 * c + x1 * s);
            bf16* kr = Kc + (size_t)m * 768 + 64 + lane;
#pragma unroll
            for (int h = 0; h < 8; ++h) { kr[h * 96] = (bf16)(o & 0xffffu); kr[h * 96 + 16] = (bf16)(o >> 16); }
        }
        {
            const int head = lane >> 3, c4 = lane & 7;
            const fx4 cs = ((const fx4*)(cosD + (size_t)m * 32))[c4], sn = ((const fx4*)(sinD + (size_t)m * 32))[c4];
#pragma unroll
            for (int w = 0; w < 2; ++w) {
                bf16* base = z + (w == 0 ? 416 : 928) + head * 64 + 4 * c4;
                const v2u a = *(const v2u*)base, b = *(const v2u*)(base + 32);
                const fx4 x1 = {bflo(a.x), bfhi(a.x), bflo(a.y), bfhi(a.y)}, x2 = {bflo(b.x), bfhi(b.x), bflo(b.y), bfhi(b.y)};
                const fx4 o1 = x1 * cs - x2 * sn, o2 = x2 * cs + x1 * sn;
                *(v2u*)base = (v2u){pk2(o1.x, o1.y), pk2(o1.z, o1.w)};
                *(v2u*)(base + 32) = (v2u){pk2(o2.x, o2.y), pk2(o2.z, o2.w)};
            }
        }
    }
}

__device__ __forceinline__ void merge_rows(const Params& P, unsigned char* ws, int layer, int gw, int NGW, int lane) {
    bf16* XN = (bf16*)(ws + OFF_XN); const bf16* Fb = (const bf16*)(ws + OFF_F); const float* LSE = (const float*)(ws + OFF_LSE);
    const float* gg = P.in[9] + (size_t)layer * D;
    const int head = lane >> 3;
    for (int m = gw; m < T; m += NGW) {
        const v4u wm = *(const v4u*)(XN + (size_t)m * D + 8 * lane);
        const v4u w2 = *(const v4u*)(XN + (size_t)m * D + 512 + 8 * lane);
        const v4u w0 = *(const v4u*)(Fb + (size_t)m * 512 + 8 * lane);
        const v4u w1 = *(const v4u*)(Fb + (size_t)T * 512 + (size_t)m * 512 + 8 * lane);
        const float L0 = LSE[(size_t)m * 8 + head], L1 = LSE[(size_t)T * 8 + (size_t)m * 8 + head], L2 = LSE[(size_t)2 * T * 8 + (size_t)m * 8 + head];
        const float mx = fmaxf(L0, fmaxf(L1, L2));
        float e0 = fast_exp2(L0 - mx), e1 = fast_exp2(L1 - mx), e2 = fast_exp2(L2 - mx);
        const float inv = fast_rcp(e0 + e1 + e2); e0 *= inv; e1 *= inv; e2 *= inv;
        float om[8] = {bflo(wm.x), bfhi(wm.x), bflo(wm.y), bfhi(wm.y), bflo(wm.z), bfhi(wm.z), bflo(wm.w), bfhi(wm.w)};
        float a0[8] = {bflo(w0.x), bfhi(w0.x), bflo(w0.y), bfhi(w0.y), bflo(w0.z), bfhi(w0.z), bflo(w0.w), bfhi(w0.w)};
        float a1[8] = {bflo(w1.x), bfhi(w1.x), bflo(w1.y), bfhi(w1.y), bflo(w1.z), bfhi(w1.z), bflo(w1.w), bfhi(w1.w)};
        float a2[8] = {bflo(w2.x), bfhi(w2.x), bflo(w2.y), bfhi(w2.y), bflo(w2.z), bfhi(w2.z), bflo(w2.w), bfhi(w2.w)};
        float od[8]; float ssm = 0.f, ssd = 0.f;
#pragma unroll
        for (int e = 0; e < 8; ++e) { od[e] = e0 * a0[e] + e1 * a1[e] + e2 * a2[e]; ssm += om[e] * om[e]; ssd += od[e] * od[e]; }
        const float rm = fast_rsq(wave_sum(ssm) * (1.0f / 512) + EPS), rd = fast_rsq(wave_sum(ssd) * (1.0f / 512) + EPS);
        const fx4 gm0 = ((const fx4*)gg)[2 * lane], gm1 = ((const fx4*)gg)[2 * lane + 1], gd0 = ((const fx4*)(gg + 512))[2 * lane], gd1 = ((const fx4*)(gg + 512))[2 * lane + 1];
        v4u o;
        o.x = pk2(om[0] * gm0.x * rm, om[1] * gm0.y * rm); o.y = pk2(om[2] * gm0.z * rm, om[3] * gm0.w * rm); o.z = pk2(om[4] * gm1.x * rm, om[5] * gm1.y * rm); o.w = pk2(om[6] * gm1.z * rm, om[7] * gm1.w * rm);
        *(v4u*)(XN + (size_t)m * D + 8 * lane) = o;
        o.x = pk2(od[0] * gd0.x * rd, od[1] * gd0.y * rd); o.y = pk2(od[2] * gd0.z * rd, od[3] * gd0.w * rd); o.z = pk2(od[4] * gd1.x * rd, od[5] * gd1.y * rd); o.w = pk2(od[6] * gd1.z * rd, od[7] * gd1.w * rd);
        *(v4u*)(XN + (size_t)m * D + 512 + 8 * lane) = o;
    }
}

__device__ __forceinline__ void convert_p(const Params& P, unsigned char* ws, int layer, int gtid, int NT) {
    const fx4* src = (const fx4*)(P.in[1] + (size_t)layer * T * PLE); v4u* dst = (v4u*)(ws + OFF_QLN);
    for (int i = gtid; i < T * PLE / 8; i += NT) { const fx4 a = src[2 * i], b = src[2 * i + 1]; dst[i] = (v4u){pk2(a.x, a.y), pk2(a.z, a.w), pk2(b.x, b.y), pk2(b.z, b.w)}; }
}

struct AttnArgs {
    const bf16* Q; int qs;
    const bf16* K; int ks;
    const bf16* V; int vs;
    bf16* O; int os;
    float* L; int ls;
    const float* cosT; const float* sinT;
    int q0; float c;
};
template <int DQK, bool WIN>
__device__ __forceinline__ void attn_unit(LAS unsigned char* lds, const AttnArgs& a) {
    constexpr int KCH = DQK / 8, NKC = 64 * KCH, NC = NKC + 512, NIT = (NC + 511) / 512;
    constexpr int KRS = DQK * 2 + 16, KBYTES = 64 * KRS, BUFB = KBYTES + 8192;
    constexpr int NDS = DQK / 16;
    int tid_ = threadIdx.x; asm volatile("" : "+v"(tid_));
    const int tid = tid_, lane = tid & 63, wid = __builtin_amdgcn_readfirstlane(tid >> 6), r32 = lane & 31, hi = lane >> 5;
    const int qw0 = a.q0 + 32 * wid, qpos = qw0 + r32;
    const int t_hi = (a.q0 + 256) >> 6;
    const int t_lo = WIN ? (a.q0 >= 128 ? ((a.q0 - 128) >> 6) : 0) : 0;
    v4u st[NIT];
#pragma unroll
    for (int it = 0; it < NIT; ++it) { const int c = tid + 512 * it;
        if (c < NC) { if (c < NKC) { const int row = c / KCH, ch = c % KCH; st[it] = *(const v4u*)(a.K + (long)(64 * t_lo + row) * a.ks + ch * 8); }
                      else { const int c2 = c - NKC, row = c2 >> 3, ch = c2 & 7; st[it] = *(const v4u*)(a.V + (long)(64 * t_lo + row) * a.vs + ch * 8); } } }
    hx8 qf[NDS];
    { const bf16* qrow = a.Q + (long)qpos * a.qs + 8 * hi;
#pragma unroll
      for (int ds = 0; ds < NDS; ++ds) qf[ds] = *(const hx8*)(qrow + 16 * ds);
      if (DQK == 96) {
          const fx4* cp = (const fx4*)(a.cosT + (long)qpos * 16 + 8 * hi); const fx4* sp = (const fx4*)(a.sinT + (long)qpos * 16 + 8 * hi);
          const fx4 c0 = cp[0], c1 = cp[1], s0 = sp[0], s1 = sp[1];
          const float cc[8] = {c0.x, c0.y, c0.z, c0.w, c1.x, c1.y, c1.z, c1.w}, sn[8] = {s0.x, s0.y, s0.z, s0.w, s1.x, s1.y, s1.z, s1.w};
          float n1[8], n2[8];
#pragma unroll
          for (int j = 0; j < 8; ++j) { const float x1 = __uint_as_float((unsigned)(unsigned short)qf[NDS - 2][j] << 16), x2 = __uint_as_float((unsigned)(unsigned short)qf[NDS - 1][j] << 16);
              n1[j] = x1 * cc[j] - x2 * sn[j]; n2[j] = x2 * cc[j] + x1 * sn[j]; }
          qf[NDS - 2] = __builtin_bit_cast(hx8, (v4u){pk2(n1[0], n1[1]), pk2(n1[2], n1[3]), pk2(n1[4], n1[5]), pk2(n1[6], n1[7])});
          qf[NDS - 1] = __builtin_bit_cast(hx8, (v4u){pk2(n2[0], n2[1]), pk2(n2[2], n2[3]), pk2(n2[4], n2[5]), pk2(n2[6], n2[7])});
      } }
#pragma unroll
    for (int it = 0; it < NIT; ++it) { const int c = tid + 512 * it;
        if (c < NC) { if (c < NKC) { const int row = c / KCH, ch = c % KCH; *(LAS v4u*)(lds + row * KRS + ch * 16) = st[it]; }
                      else { const int c2 = c - NKC, row = c2 >> 3, ch = c2 & 7; *(LAS v4u*)(lds + KBYTES + (ch >> 2) * 4096 + row * 64 + (ch & 3) * 16) = st[it]; } } }
    __syncthreads();
    float m_run = -INFINITY, l_run = 0.f;
    fx16 o[2];
#pragma unroll
    for (int r = 0; r < 16; ++r) { o[0][r] = 0.f; o[1][r] = 0.f; }
    const int vlane = ((lane >> 4) & 1) * 32 + (lane & 3) * 8 + (4 * hi + ((lane & 15) >> 2)) * 64;
    int cur = 0;
    for (int t = t_lo; t < t_hi; ++t) {
        const bool more = (t + 1 < t_hi);
        if (more) {
#pragma unroll
            for (int it = 0; it < NIT; ++it) { const int c = tid + 512 * it;
                if (c < NC) { if (c < NKC) { const int row = c / KCH, ch = c % KCH; st[it] = *(const v4u*)(a.K + (long)(64 * (t + 1) + row) * a.ks + ch * 8); }
                              else { const int c2 = c - NKC, row = c2 >> 3, ch = c2 & 7; st[it] = *(const v4u*)(a.V + (long)(64 * (t + 1) + row) * a.vs + ch * 8); } } }
        }
        const bool need = (64 * t <= qw0 + 31) && (!WIN || (64 * t + 63 >= qw0 - 128));
        if (need) {
            const LAS unsigned char* kb_ = lds + cur * BUFB; const LAS unsigned char* vb_ = kb_ + KBYTES + vlane;
            fx16 p[2];
#pragma unroll
            for (int kb = 0; kb < 2; ++kb) {
#pragma unroll
                for (int r = 0; r < 16; ++r) p[kb][r] = 0.f;
#pragma unroll
                for (int ds = 0; ds < NDS; ++ds) {
                    const hx8 kf = *(const LAS hx8*)(kb_ + (32 * kb + r32) * KRS + (16 * ds + 8 * hi) * 2);
                    p[kb] = __builtin_amdgcn_mfma_f32_32x32x16_bf16(kf, qf[ds], p[kb], 0, 0, 0);
                }
            }
            const bool domask = WIN || (64 * t + 63 > qw0);
            float mx = -INFINITY;
            if (domask) {
#pragma unroll
                for (int kb = 0; kb < 2; ++kb)
#pragma unroll
                    for (int r = 0; r < 16; ++r) {
                        const int kv = 64 * t + 32 * kb + (r & 3) + 8 * (r >> 2) + 4 * hi;
                        const bool ok = (kv <= qpos) && (!WIN || (qpos - kv <= 128));
                        const float v = ok ? p[kb][r] : -INFINITY; p[kb][r] = v; mx = fmaxf(mx, v);
                    }
            } else {
#pragma unroll
                for (int kb = 0; kb < 2; ++kb)
#pragma unroll
                    for (int r = 0; r < 16; ++r) mx = fmaxf(mx, p[kb][r]);
            }
            mx = fmaxf(mx, __shfl_xor(mx, 32));
            const float mnew = fmaxf(m_run, mx * a.c);
            const float muse = (mnew == -INFINITY) ? 0.f : mnew;
            const float alpha = fast_exp2(m_run - muse);
            m_run = mnew;
            float rs = 0.f;
#pragma unroll
            for (int kb = 0; kb < 2; ++kb)
#pragma unroll
                for (int r = 0; r < 16; ++r) { const float e = fast_exp2(__builtin_fmaf(p[kb][r], a.c, -muse)); p[kb][r] = e; rs += e; }
            l_run = l_run * alpha + rs;
#pragma unroll
            for (int r = 0; r < 16; ++r) { o[0][r] *= alpha; o[1][r] *= alpha; }
            hx8 pb[4];
#pragma unroll
            for (int ks = 0; ks < 4; ++ks) { const int kb = ks >> 1, s8 = (ks & 1) * 8;
                pb[ks] = __builtin_bit_cast(hx8, (v4u){pk2(p[kb][s8 + 0], p[kb][s8 + 1]), pk2(p[kb][s8 + 2], p[kb][s8 + 3]), pk2(p[kb][s8 + 4], p[kb][s8 + 5]), pk2(p[kb][s8 + 6], p[kb][s8 + 7])}); }
#pragma unroll
            for (int db = 0; db < 2; ++db)
#pragma unroll
                for (int ks = 0; ks < 4; ++ks) {
                    const hx4 lo = __builtin_bit_cast(hx4, __builtin_amdgcn_ds_read_tr16_b64_v4i16((LAS hx4*)(vb_ + db * 4096 + ks * 1024)));
                    const hx4 hh = __builtin_bit_cast(hx4, __builtin_amdgcn_ds_read_tr16_b64_v4i16((LAS hx4*)(vb_ + db * 4096 + ks * 1024 + 512)));
                    const hx8 vf = {lo[0], lo[1], lo[2], lo[3], hh[0], hh[1], hh[2], hh[3]};
                    o[db] = __builtin_amdgcn_mfma_f32_32x32x16_bf16(vf, pb[ks], o[db], 0, 0, 0);
                }
        }
        if (more) {
            LAS unsigned char* nb_ = lds + (cur ^ 1) * BUFB;
#pragma unroll
            for (int it = 0; it < NIT; ++it) { const int c = tid + 512 * it;
                if (c < NC) { if (c < NKC) { const int row = c / KCH, ch = c % KCH; *(LAS v4u*)(nb_ + row * KRS + ch * 16) = st[it]; }
                              else { const int c2 = c - NKC, row = c2 >> 3, ch = c2 & 7; *(LAS v4u*)(nb_ + KBYTES + (ch >> 2) * 4096 + row * 64 + (ch & 3) * 16) = st[it]; } } }
        }
        __syncthreads();
        cur ^= 1;
    }
    const float lt = l_run + __shfl_xor(l_run, 32);
    const float inv = fast_rcp(lt);
    bf16* orow = a.O + (long)qpos * a.os;
#pragma unroll
    for (int db = 0; db < 2; ++db)
#pragma unroll
        for (int g = 0; g < 4; ++g) {
            const v2u w = {pk2(o[db][4 * g] * inv, o[db][4 * g + 1] * inv), pk2(o[db][4 * g + 2] * inv, o[db][4 * g + 3] * inv)};
            *(v2u*)(orow + 32 * db + 8 * g + 4 * hi) = w;
        }
    if (WIN) { if (hi == 0) a.L[(long)qpos * a.ls] = m_run + __builtin_amdgcn_logf(lt); }
}

__device__ __forceinline__ void win_load(const AttnArgs& a, v4u (&st)[6][2]) {
    int tid_ = threadIdx.x; asm volatile("" : "+v"(tid_));
    const int srow = tid_ >> 3, sch = tid_ & 7;
    const int t_hi = (a.q0 + 256) >> 6, t_lo = a.q0 >= 128 ? ((a.q0 - 128) >> 6) : 0, nt = t_hi - t_lo;
#pragma unroll
    for (int s = 0; s < 6; ++s) if (s < nt) {
        st[s][0] = *(const v4u*)(a.K + (long)(64 * (t_lo + s) + srow) * a.ks + sch * 8);
        st[s][1] = *(const v4u*)(a.V + (long)(64 * (t_lo + s) + srow) * a.vs + sch * 8);
    }
}
__device__ __forceinline__ void attn_unit_win(LAS unsigned char* lds, const AttnArgs& a, v4u (&st)[6][2], bool has_next, const AttnArgs& an) {
    constexpr int DQK = 64; constexpr bool WIN = true;
    constexpr int KRS = DQK * 2 + 16, KBYTES = 64 * KRS, BUFB = KBYTES + 8192, NDS = DQK / 16;
    int tid_ = threadIdx.x; asm volatile("" : "+v"(tid_));
    const int tid = tid_, lane = tid & 63, wid = __builtin_amdgcn_readfirstlane(tid >> 6), r32 = lane & 31, hi = lane >> 5;
    const int qw0 = a.q0 + 32 * wid, qpos = qw0 + r32;
    const int t_hi = (a.q0 + 256) >> 6;
    const int t_lo = a.q0 >= 128 ? ((a.q0 - 128) >> 6) : 0;
    const int nt = t_hi - t_lo;
    const int srow = tid >> 3, sch = tid & 7;
    hx8 qf[NDS];
    { const bf16* qrow = a.Q + (long)qpos * a.qs + 8 * hi;
#pragma unroll
      for (int ds = 0; ds < NDS; ++ds) qf[ds] = *(const hx8*)(qrow + 16 * ds); }
#pragma unroll
    for (int s = 0; s < 6; ++s) if (s < nt) {
        *(LAS v4u*)(lds + s * BUFB + srow * KRS + sch * 16) = st[s][0];
        *(LAS v4u*)(lds + s * BUFB + KBYTES + (sch >> 2) * 4096 + srow * 64 + (sch & 3) * 16) = st[s][1];
    }
    __syncthreads();
    if (has_next) win_load(an, st);
    float m_run = -INFINITY, l_run = 0.f;
    fx16 o[2];
#pragma unroll
    for (int r = 0; r < 16; ++r) { o[0][r] = 0.f; o[1][r] = 0.f; }
    const int vlane = ((lane >> 4) & 1) * 32 + (lane & 3) * 8 + (4 * hi + ((lane & 15) >> 2)) * 64;
    for (int t = t_lo; t < t_hi; ++t) {
        const bool need = (64 * t <= qw0 + 31) && (64 * t + 63 >= qw0 - 128);
        if (need) {
            const LAS unsigned char* kb_ = lds + (t - t_lo) * BUFB; const LAS unsigned char* vb_ = kb_ + KBYTES + vlane;
            fx16 p[2];
#pragma unroll
            for (int kb = 0; kb < 2; ++kb) {
#pragma unroll
                for (int r = 0; r < 16; ++r) p[kb][r] = 0.f;
#pragma unroll
                for (int ds = 0; ds < NDS; ++ds) {
                    const hx8 kf = *(const LAS hx8*)(kb_ + (32 * kb + r32) * KRS + (16 * ds + 8 * hi) * 2);
                    p[kb] = __builtin_amdgcn_mfma_f32_32x32x16_bf16(kf, qf[ds], p[kb], 0, 0, 0);
                }
            }
            const bool domask = WIN || (64 * t + 63 > qw0);
            float mx = -INFINITY;
            if (domask) {
#pragma unroll
                for (int kb = 0; kb < 2; ++kb)
#pragma unroll
                    for (int r = 0; r < 16; ++r) {
                        const int kv = 64 * t + 32 * kb + (r & 3) + 8 * (r >> 2) + 4 * hi;
                        const bool ok = (kv <= qpos) && (!WIN || (qpos - kv <= 128));
                        const float v = ok ? p[kb][r] : -INFINITY; p[kb][r] = v; mx = fmaxf(mx, v);
                    }
            } else {
#pragma unroll
                for (int kb = 0; kb < 2; ++kb)
#pragma unroll
                    for (int r = 0; r < 16; ++r) mx = fmaxf(mx, p[kb][r]);
            }
            mx = fmaxf(mx, __shfl_xor(mx, 32));
            const float mnew = fmaxf(m_run, mx * a.c);
            const float muse = (mnew == -INFINITY) ? 0.f : mnew;
            const float alpha = fast_exp2(m_run - muse);
            m_run = mnew;
            float rs = 0.f;
#pragma unroll
            for (int kb = 0; kb < 2; ++kb)
#pragma unroll
                for (int r = 0; r < 16; ++r) { const float e = fast_exp2(__builtin_fmaf(p[kb][r], a.c, -muse)); p[kb][r] = e; rs += e; }
            l_run = l_run * alpha + rs;
#pragma unroll
            for (int r = 0; r < 16; ++r) { o[0][r] *= alpha; o[1][r] *= alpha; }
            hx8 pb[4];
#pragma unroll
            for (int ks = 0; ks < 4; ++ks) { const int kb = ks >> 1, s8 = (ks & 1) * 8;
                pb[ks] = __builtin_bit_cast(hx8, (v4u){pk2(p[kb][s8 + 0], p[kb][s8 + 1]), pk2(p[kb][s8 + 2], p[kb][s8 + 3]), pk2(p[kb][s8 + 4], p[kb][s8 + 5]), pk2(p[kb][s8 + 6], p[kb][s8 + 7])}); }
#pragma unroll
            for (int db = 0; db < 2; ++db)
#pragma unroll
                for (int ks = 0; ks < 4; ++ks) {
                    const hx4 lo = __builtin_bit_cast(hx4, __builtin_amdgcn_ds_read_tr16_b64_v4i16((LAS hx4*)(vb_ + db * 4096 + ks * 1024)));
                    const hx4 hh = __builtin_bit_cast(hx4, __builtin_amdgcn_ds_read_tr16_b64_v4i16((LAS hx4*)(vb_ + db * 4096 + ks * 1024 + 512)));
                    const hx8 vf = {lo[0], lo[1], lo[2], lo[3], hh[0], hh[1], hh[2], hh[3]};
                    o[db] = __builtin_amdgcn_mfma_f32_32x32x16_bf16(vf, pb[ks], o[db], 0, 0, 0);
                }
        }
    }
    const float lt = l_run + __shfl_xor(l_run, 32);
    const float inv = fast_rcp(lt);
    bf16* orow = a.O + (long)qpos * a.os;
#pragma unroll
    for (int db = 0; db < 2; ++db)
#pragma unroll
        for (int g = 0; g < 4; ++g) {
            const v2u w = {pk2(o[db][4 * g] * inv, o[db][4 * g + 1] * inv), pk2(o[db][4 * g + 2] * inv, o[db][4 * g + 3] * inv)};
            *(v2u*)(orow + 32 * db + 8 * g + 4 * hi) = w;
        }
    if (WIN) { if (hi == 0) a.L[(long)qpos * a.ls] = m_run + __builtin_amdgcn_logf(lt); }
    __syncthreads();
}

__device__ __forceinline__ void attention_phase(unsigned char* ws, LAS unsigned char* lds) {
    int bx_ = blockIdx.x; asm volatile("" : "+s"(bx_));
    const int G = gridDim.x, c = bx_;
    const float* cosM = (const float*)(ws + OFF_TAB); const float* sinM = cosM + (size_t)T * 16;
    bf16* XN = (bf16*)(ws + OFF_XN); bf16* Fb = (bf16*)(ws + OFF_F); float* LSE = (float*)(ws + OFF_LSE);
    const bf16* Z = (const bf16*)(ws + OFF_HID); const bf16* Qb = (const bf16*)(ws + OFF_Q);
    const bf16* Kc = (const bf16*)(ws + OFF_KCAT); const bf16* Vm = (const bf16*)(ws + OFF_V);
#ifdef EXP_MLA2
    for (int rep_ = 0; rep_ < 2; ++rep_)
#endif
    for (int pi0 = c, rnd = 0; pi0 < 512; pi0 += G, ++rnd) {
        int pi = pi0;
        if (G == 256) { const int xcd = c & 7, j = c >> 3; pi = ((4 * xcd + 2 * rnd + (j >> 4)) << 4) | (j & 15); }
        const int bh = pi >> 4, s = pi & 15, b = bh >> 3, h = bh & 7;
        const size_t tok0 = (size_t)b * SEQ;
        AttnArgs a;
        a.Q = Qb + tok0 * 768 + h * 96; a.qs = 768; a.K = Kc + tok0 * 768 + h * 96; a.ks = 768; a.V = Vm + tok0 * 512 + h * 64; a.vs = 512;
        a.O = XN + tok0 * D + h * 64; a.os = D; a.L = nullptr; a.ls = 0; a.cosT = cosM + tok0 * 16; a.sinT = sinM + tok0 * 16;
        a.c = 0.10206207261596577f * 1.4426950408889634f;
        for (int half = 0; half < 2; ++half) { a.q0 = half ? 256 * s : 256 * (31 - s); attn_unit<96, false>(lds, a); }
    }
#ifdef EXP_DIL2
    for (int rep_ = 0; rep_ < 2; ++rep_)
#endif
    {
        v4u st[6][2]; AttnArgs a, an;
#define WIN_ARGS(u_, A_) do { const int br = (u_) >> 10, rem = (u_) & 1023, b = rem >> 8, h = (rem >> 5) & 7, idx = rem & 31; \
        const int dil = (br == 0) ? 1 : (br == 1 ? 4 : 16); const int nsub = 32 / dil; const int r = idx / nsub, n = idx % nsub; \
        const size_t tok0 = (size_t)b * SEQ + r; \
        A_.Q = Z + tok0 * NINP + 416 + h * 64; A_.qs = NINP * dil; A_.K = Z + tok0 * NINP + 928 + h * 64; A_.ks = A_.qs; A_.V = Z + tok0 * NINP + 1440 + h * 64; A_.vs = A_.qs; \
        if (br < 2) { A_.O = Fb + (size_t)br * T * 512 + tok0 * 512 + h * 64; A_.os = 512 * dil; } \
        else { A_.O = XN + tok0 * D + 512 + h * 64; A_.os = D * dil; } \
        A_.L = LSE + (size_t)br * T * 8 + tok0 * 8 + h; A_.ls = 8 * dil; A_.cosT = nullptr; A_.sinT = nullptr; \
        A_.c = 0.125f * 1.4426950408889634f; A_.q0 = 256 * n; } while (0)
        int u = c;
        if (u < 3072) { WIN_ARGS(u, a); win_load(a, st); }
        for (; u < 3072; u += G) {
            const bool hn = (u + G) < 3072;
            if (hn) WIN_ARGS(u + G, an); else an = a;
            attn_unit_win(lds, a, st, hn, an);
            a = an;
        }
#undef WIN_ARGS
    }
}

#define XB_TMO      128
#define XB_XCNT(j)  (256  + 64 * (j))
#define XB_XSUB(j)  (1280 + 64 * (j))
#define XB_XGEN(j)  (2304 + 64 * (j))
#define XB_TOP      3328
#define XB_TOPGEN   3392
#define XCD_BAR_WORDS 3456
#define XB_SPIN_CAP (1u << 18)

__device__ __forceinline__ unsigned xb_ld(unsigned* p)              { return __hip_atomic_load(p, __ATOMIC_RELAXED, __HIP_MEMORY_SCOPE_AGENT); }
__device__ __forceinline__ unsigned xb_add(unsigned* p, unsigned v) { return __hip_atomic_fetch_add(p, v, __ATOMIC_RELAXED, __HIP_MEMORY_SCOPE_AGENT); }
__device__ __forceinline__ unsigned xb_xcc_id() { return (unsigned)__builtin_amdgcn_s_getreg((3 << 11) | 20) & 0xFu; }
#define XB_SPIN(cond, bar) do { unsigned _sp = 0; while (cond) { __builtin_amdgcn_s_sleep(1); \
    if ((++_sp & 255u) == 0u) { if (xb_ld(&(bar)[XB_TMO])) break; if (_sp > XB_SPIN_CAP) { atomicAdd(&(bar)[XB_TMO], 1u); break; } } } } while (0)

struct XcdBarrier {
    unsigned* bar; unsigned x;
    volatile LAS unsigned* st;
};

__device__ __forceinline__ XcdBarrier xcd_barrier_post(unsigned* bar, volatile LAS unsigned* st) {
    XcdBarrier b; b.bar = bar; b.x = xb_xcc_id(); b.st = st;
    if (threadIdx.x == 0) (void)xb_add(&bar[XB_XCNT(b.x)], 1u);
    return b;
}
__device__ __forceinline__ void xcd_barrier_complete(unsigned* bar, unsigned x, unsigned& nloc, unsigned& nx) {
    const unsigned G = gridDim.x * gridDim.y * gridDim.z;
    unsigned sum, cnt, mine, sp = 0u;
    for (;;) {
        sum = 0u; cnt = 0u; mine = 0u;
#pragma unroll
        for (unsigned j = 0; j < 16; ++j) { const unsigned c = xb_ld(&bar[XB_XCNT(j)]); sum += c; cnt += (c > 0u) ? 1u : 0u; mine = (j == x) ? c : mine; }
        if (sum == G) break;
        __builtin_amdgcn_s_sleep(1);
        if ((++sp & 255u) == 0u) { if (xb_ld(&bar[XB_TMO])) break; if (sp > XB_SPIN_CAP) { atomicAdd(&bar[XB_TMO], 1u); break; } }
    }
    nloc = mine > 0u ? mine : 1u; nx = cnt > 0u ? cnt : 1u;
}

__device__ __forceinline__ void xcd_barrier(const XcdBarrier& b) {
    asm volatile("s_waitcnt vmcnt(0)" ::: "memory");
    __syncthreads();
    if (threadIdx.x == 0) {
        unsigned* bar = b.bar;
        __builtin_amdgcn_s_waitcnt(0);
        unsigned nloc = b.st[0], nx = b.st[1];
        if (nloc == 0u) { xcd_barrier_complete(bar, b.x, nloc, nx); b.st[0] = nloc; b.st[1] = nx; }
        const unsigned old = xb_add(&bar[XB_XSUB(b.x)], 1u);
        const unsigned gen = old / nloc;
        if (old + 1u == (gen + 1u) * nloc) {
            __builtin_amdgcn_fence(__ATOMIC_RELEASE, "agent");
            asm volatile("s_waitcnt vmcnt(0)" ::: "memory");
            const unsigned og = xb_add(&bar[XB_TOP], 1u);
            const unsigned tg = og / nx;
            if (og + 1u == (tg + 1u) * nx) xb_add(&bar[XB_TOPGEN], 1u);
            else XB_SPIN(xb_ld(&bar[XB_TOPGEN]) == tg, bar);
            __builtin_amdgcn_fence(__ATOMIC_ACQUIRE, "agent");
            xb_add(&bar[XB_XGEN(b.x)], 1u);
            asm volatile("s_waitcnt vmcnt(0)" ::: "memory");
        } else {
            XB_SPIN(xb_ld(&bar[XB_XGEN(b.x)]) == gen, bar);
            __builtin_amdgcn_fence(__ATOMIC_ACQUIRE, "agent");
            asm volatile("s_waitcnt vmcnt(0)" ::: "memory");
        }
    }
    __syncthreads();
}


#ifdef NO_GEMM
#define GEMM_PHASE(EPI, Aptr, Bptr, Nn, Kk, Eobj) do { (void)(Eobj); } while (0)
#else
#define GEMM_PHASE(EPI, Aptr, Bptr, Nn, Kk, Eobj) do { int bx_ = blockIdx.x; asm volatile("" : "+s"(bx_)); pg8::Gemm g_{(const pg8::bf16_t*)(Aptr), (const pg8::bf16_t*)(Bptr), T, (Nn), (Kk)}; pg8::StaticOrder S_; S_.init(T, (Nn), (int)gridDim.x, bx_); \
    pg8::gemm_phase<EPI, pg8::StaticOrder, true, true>(lds, g_, S_, (Eobj)); } while (0)
#endif
#define PH_IDS int tid = threadIdx.x; asm volatile("" : "+v"(tid)); const int lane = tid & 63, wave = __builtin_amdgcn_readfirstlane(tid >> 6); int bxp = blockIdx.x; asm volatile("" : "+s"(bxp)); \
    const int gw = bxp * 8 + wave, NGW = gridDim.x * 8, gtid = bxp * NTHREADS + tid, NT = gridDim.x * NTHREADS; (void)lane; (void)gw; (void)NGW; (void)gtid; (void)NT;
#define GASP(T_, p_) ((T_*)(__attribute__((address_space(1))) T_*)(p_))
#define PH_WS unsigned char* ws = P.ws;
#define WP(off) ((bf16*)(ws + (off)))
#define WBP(eoff) ((bf16*)(ws + OFF_WB) + (eoff))

__global__ void __launch_bounds__(NTHREADS, 2) mega_fwd(Params Pk) {
    Params P;
#pragma unroll
    for (int i = 0; i < 16; ++i) P.in[i] = GASP(const float, Pk.in[i]);
    P.out = GASP(float, Pk.out); P.ws = GASP(unsigned char, Pk.ws);
    extern __shared__ __attribute__((aligned(16))) unsigned char lds_raw[];
    LAS unsigned char* lds = (LAS unsigned char*)lds_raw;
    cg::grid_group grid = cg::this_grid();
    volatile LAS unsigned* bst = (volatile LAS unsigned*)(lds + 131072);
    if (threadIdx.x < 2) bst[threadIdx.x] = 0u;
    __syncthreads();
    const XcdBarrier bar = xcd_barrier_post((unsigned*)(P.ws + OFF_BAR), bst);
#define GSYNC() xcd_barrier(bar)

    { PH_IDS PH_WS
      convert_weights(P, ws, 0, lds, gw, NGW, wave, lane);
      rope_tables(P, ws, gtid, NT);
      resnorm_rows<false, false, true>(P.in[0], P.out, nullptr, 0.f, nullptr, P.in[3], WP(OFF_XN), gw, NGW, lane); }
    grid.sync();

    { const int layer = 0;
        { PH_WS pg8::EpiSwiglu E{WP(OFF_HID), FF}; GEMM_PHASE(pg8::EpiSwiglu, WP(OFF_XN), WBP(WE_FIN_A), 2 * FF, D, E); }
        GSYNC();
        { PH_WS pg8::EpiBf16<0> E{WP(OFF_F), D, nullptr, 0, 0, 1.f}; GEMM_PHASE(pg8::EpiBf16<0>, WP(OFF_HID), WBP(WE_FDN_A), D, FF, E); }
        GSYNC();
        { PH_IDS PH_WS const float* gains = P.in[3] + (size_t)layer * 8 * D;
          resnorm_rows<true, true, true>(P.out, P.out, WP(OFF_F), 0.5f, gains + 1 * D, gains + 2 * D, WP(OFF_XN), gw, NGW, lane); }
        GSYNC();
        { PH_WS pg8::EpiBf16<0> E{WP(OFF_HID), NINP, nullptr, 0, 0, 1.f}; GEMM_PHASE(pg8::EpiBf16<0>, WP(OFF_XN), WBP(WE_IN), NINP, D, E); }
        GSYNC();
        { PH_IDS PH_WS mixer_prep_rows(P, ws, layer, gw, NGW, lane); }
        GSYNC();
        { PH_WS pg8::EpiQKV E{WP(OFF_Q), WP(OFF_KCAT), WP(OFF_V)}; int kq_ = 384; asm volatile("" : "+s"(kq_)); GEMM_PHASE(pg8::EpiQKV, WP(OFF_QLN), WBP(WE_QUP), 1792, kq_, E); }
        GSYNC();
#ifndef NO_ATTN
        { PH_WS attention_phase(ws, lds); }
#endif
        GSYNC();
#ifdef EXP_SYNC
        for (int rep_ = 0; rep_ < 16; ++rep_) GSYNC();
#endif
        { PH_IDS PH_WS merge_rows(P, ws, layer, gw, NGW, lane); }
        GSYNC();
        { PH_WS pg8::EpiBf16<0> E{WP(OFF_F), D, nullptr, 0, 0, 1.f}; GEMM_PHASE(pg8::EpiBf16<0>, WP(OFF_XN), WBP(WE_OUT), D, D, E); }
        GSYNC();
        { PH_IDS PH_WS const float* gains = P.in[3] + (size_t)layer * 8 * D;
          resnorm_rows<true, true, true>(P.out, P.out, WP(OFF_F), 1.0f, gains + 3 * D, gains + 4 * D, WP(OFF_XN), gw, NGW, lane);
          convert_p(P, ws, layer, gtid, NT); }
        GSYNC();
        { PH_WS pg8::EpiSwiglu E{WP(OFF_HID), FF}; GEMM_PHASE(pg8::EpiSwiglu, WP(OFF_XN), WBP(WE_FIN_B), 2 * FF, D, E); }
        GSYNC();
        { PH_WS pg8::EpiBf16<0> E{WP(OFF_F), D, nullptr, 0, 0, 1.f}; GEMM_PHASE(pg8::EpiBf16<0>, WP(OFF_HID), WBP(WE_FDN_B), D, FF, E); }
        GSYNC();
        { PH_IDS PH_WS const float* gains = P.in[3] + (size_t)layer * 8 * D;
          resnorm_rows<true, true, true>(P.out, P.out, WP(OFF_F), 0.5f, gains + 5 * D, gains + 6 * D, WP(OFF_XN), gw, NGW, lane); }
        { PH_WS pg8::EpiBf16<0> E{WP(OFF_HID), D, nullptr, 0, 0, 1.f}; GEMM_PHASE(pg8::EpiBf16<0>, WP(OFF_QLN), WBP(WE_PLE), D, PLE, E); }
        GSYNC();
        { PH_WS pg8::EpiGate E{WP(OFF_F), WP(OFF_HID), D}; GEMM_PHASE(pg8::EpiGate, WP(OFF_XN), WBP(WE_PG), D, D, E); }
        GSYNC();
        { PH_IDS PH_WS const float* gains = P.in[3] + (size_t)layer * 8 * D;
          if (layer == 1) resnorm_rows<true, true, false>(P.out, P.out, WP(OFF_F), 1.0f, gains + 7 * D, P.in[3], WP(OFF_XN), gw, NGW, lane);
          else resnorm_rows<true, true, true>(P.out, P.out, WP(OFF_F), 1.0f, gains + 7 * D, P.in[3] + (size_t)8 * D, WP(OFF_XN), gw, NGW, lane);
          if (layer == 0) convert_weights(P, ws, 1, lds, gw, NGW, wave, lane); }
        if (layer == 0) GSYNC();
    }
    { const int layer = 1;
        { PH_WS pg8::EpiSwiglu E{WP(OFF_HID), FF}; GEMM_PHASE(pg8::EpiSwiglu, WP(OFF_XN), WBP(WE_FIN_A), 2 * FF, D, E); }
        GSYNC();
        { PH_WS pg8::EpiBf16<0> E{WP(OFF_F), D, nullptr, 0, 0, 1.f}; GEMM_PHASE(pg8::EpiBf16<0>, WP(OFF_HID), WBP(WE_FDN_A), D, FF, E); }
        GSYNC();
        { PH_IDS PH_WS const float* gains = P.in[3] + (size_t)layer * 8 * D;
          resnorm_rows<true, true, true>(P.out, P.out, WP(OFF_F), 0.5f, gains + 1 * D, gains + 2 * D, WP(OFF_XN), gw, NGW, lane); }
        GSYNC();
        { PH_WS pg8::EpiBf16<0> E{WP(OFF_HID), NINP, nullptr, 0, 0, 1.f}; GEMM_PHASE(pg8::EpiBf16<0>, WP(OFF_XN), WBP(WE_IN), NINP, D, E); }
        GSYNC();
        { PH_IDS PH_WS mixer_prep_rows(P, ws, layer, gw, NGW, lane); }
        GSYNC();
        { PH_WS pg8::EpiQKV E{WP(OFF_Q), WP(OFF_KCAT), WP(OFF_V)}; int kq_ = 384; asm volatile("" : "+s"(kq_)); GEMM_PHASE(pg8::EpiQKV, WP(OFF_QLN), WBP(WE_QUP), 1792, kq_, E); }
        GSYNC();
#ifndef NO_ATTN
        { PH_WS attention_phase(ws, lds); }
#endif
        GSYNC();
#ifdef EXP_SYNC
        for (int rep_ = 0; rep_ < 16; ++rep_) GSYNC();
#endif
        { PH_IDS PH_WS merge_rows(P, ws, layer, gw, NGW, lane); }
        GSYNC();
        { PH_WS pg8::EpiBf16<0> E{WP(OFF_F), D, nullptr, 0, 0, 1.f}; GEMM_PHASE(pg8::EpiBf16<0>, WP(OFF_XN), WBP(WE_OUT), D, D, E); }
        GSYNC();
        { PH_IDS PH_WS const float* gains = P.in[3] + (size_t)layer * 8 * D;
          resnorm_rows<true, true, true>(P.out, P.out, WP(OFF_F), 1.0f, gains + 3 * D, gains + 4 * D, WP(OFF_XN), gw, NGW, lane);
          convert_p(P, ws, layer, gtid, NT); }
        GSYNC();
        { PH_WS pg8::EpiSwiglu E{WP(OFF_HID), FF}; GEMM_PHASE(pg8::EpiSwiglu, WP(OFF_XN), WBP(WE_FIN_B), 2 * FF, D, E); }
        GSYNC();
        { PH_WS pg8::EpiBf16<0> E{WP(OFF_F), D, nullptr, 0, 0, 1.f}; GEMM_PHASE(pg8::EpiBf16<0>, WP(OFF_HID), WBP(WE_FDN_B), D, FF, E); }
        GSYNC();
        { PH_IDS PH_WS const float* gains = P.in[3] + (size_t)layer * 8 * D;
          resnorm_rows<true, true, true>(P.out, P.out, WP(OFF_F), 0.5f, gains + 5 * D, gains + 6 * D, WP(OFF_XN), gw, NGW, lane); }
        { PH_WS pg8::EpiBf16<0> E{WP(OFF_HID), D, nullptr, 0, 0, 1.f}; GEMM_PHASE(pg8::EpiBf16<0>, WP(OFF_QLN), WBP(WE_PLE), D, PLE, E); }
        GSYNC();
        { PH_WS pg8::EpiGate E{WP(OFF_F), WP(OFF_HID), D}; GEMM_PHASE(pg8::EpiGate, WP(OFF_XN), WBP(WE_PG), D, D, E); }
        GSYNC();
        { PH_IDS PH_WS const float* gains = P.in[3] + (size_t)layer * 8 * D;
          if (layer == 1) resnorm_rows<true, true, false>(P.out, P.out, WP(OFF_F), 1.0f, gains + 7 * D, P.in[3], WP(OFF_XN), gw, NGW, lane);
          else resnorm_rows<true, true, true>(P.out, P.out, WP(OFF_F), 1.0f, gains + 7 * D, P.in[3] + (size_t)8 * D, WP(OFF_XN), gw, NGW, lane);
          if (layer == 0) convert_weights(P, ws, 1, lds, gw, NGW, wave, lane); }
        if (layer == 0) GSYNC();
    }
}

extern "C" void kernel_launch(void* const* d_in, const int* in_sizes, int n_in, void* d_out, int out_size, void* d_ws, size_t ws_size, hipStream_t stream) {
    static int grid = 0;
    if (grid == 0) {
        if (n_in != 16 || out_size != T * D || ws_size < WS_NEED) { fprintf(stderr, "kernel_launch: unexpected shapes (n_in %d out %d ws %zu)\n", n_in, out_size, ws_size); grid = -1; return; }
        int dev = 0, cus = 0, per_cu = 0;
        hipGetDevice(&dev); hipDeviceGetAttribute(&cus, hipDeviceAttributeMultiprocessorCount, dev);
        hipFuncSetAttribute((const void*)mega_fwd, hipFuncAttributeMaxDynamicSharedMemorySize, LDS_BYTES);
        hipOccupancyMaxActiveBlocksPerMultiprocessor(&per_cu, (const void*)mega_fwd, NTHREADS, LDS_BYTES);
        (void)hipGetLastError();
        if (per_cu < 1) fprintf(stderr, "kernel_launch: occupancy query says %d\n", per_cu);
        grid = cus;
    }
    if (grid < 0) return;
    if (hipMemsetAsync((char*)d_ws + OFF_BAR, 0, BAR_BYTES, stream) != hipSuccess) { fprintf(stderr, "kernel_launch: memset failed\n"); return; }
    Params p{};
    for (int i = 0; i < 16; ++i) p.in[i] = (const float*)d_in[i];
    p.out = (float*)d_out; p.ws = (unsigned char*)d_ws;
    void* args[] = {&p};
    hipError_t e = hipLaunchCooperativeKernel((const void*)mega_fwd, dim3(grid), dim3(NTHREADS), args, LDS_BYTES, stream);
    if (e != hipSuccess) fprintf(stderr, "cooperative launch failed: %s (grid %d)\n", hipGetErrorString(e), grid);
}
```

```cpp
#include <hip/hip_runtime.h>
#include <hip/hip_cooperative_groups.h>
#include <cstdio>
#include <cstdint>
#include <cmath>
namespace cg = cooperative_groups;
namespace pg8 {
#define PG8_LAS __attribute__((address_space(3)))
typedef unsigned short bf16_t;
typedef short bf16x8 __attribute__((ext_vector_type(8)));
typedef float f32x4 __attribute__((ext_vector_type(4)));
typedef unsigned u32x4 __attribute__((ext_vector_type(4)));
constexpr int BM = 256, BK = 64, HALF = 128, HTB = HALF * BK * 2  , STAGE_BYTES = 8 * HTB, NXCD = 8, WGM = 8;

__host__ __device__ __forceinline__ int lds_byte(int r, int c) { const int st = (r >> 4) * 2 + (c >> 5), rr = r & 15, cc = c & 31, ob = rr * 64 + cc * 2; return st * 1024 + (ob ^ (((ob >> 9) & 1) << 5)); }
__host__ __device__ __forceinline__ void stage_rc(int b, int& R, int& C) { const int st = b / 1024, sb = b % 1024, swz = sb ^ (((sb >> 9) & 1) << 5); R = (st >> 1) * 16 + swz / 64; C = (st & 1) * 32 + (swz % 64) / 2; }
__host__ __device__ __forceinline__ int perm32(int rho) { const int n = rho >> 4, i = rho & 15; return 8 * (i >> 2) + 4 * n + (i & 3); }

struct Unit { int pm, pn; };
struct Gemm { const bf16_t* A; const bf16_t* Bt; int M, N, K; };

struct StaticOrder {
    int nM, nN, nwg, G, c;
    __host__ __device__ void init(int M, int N, int G_, int c_) { nM = M / BM; nN = N / BM; nwg = nM * nN; G = G_; c = c_; }
    __host__ __device__ bool next(int i, Unit& u) const {
        const long L = (long)i * G + c; if (L >= nwg) return false;
        int wgid = (int)L; { const int q = nwg / NXCD, r = nwg % NXCD, xcd = wgid % NXCD, off = wgid / NXCD; wgid = (xcd < r ? xcd * (q + 1) : r * (q + 1) + (xcd - r) * q) + off; }
        const int nig = WGM * nN, gid = wgid / nig, fm = gid * WGM, gsz = (nM - fm) < WGM ? (nM - fm) : WGM;
        u.pm = fm + ((wgid % nig) % gsz); u.pn = (wgid % nig) / gsz; return true;
    }
    __device__ __forceinline__ void a_ready(const Unit&) const {}
    __device__ __forceinline__ void done(const Unit&) const {}
};

__device__ __forceinline__ unsigned cvt_pk_bf16(float lo, float hi) { unsigned r; asm volatile("v_cvt_pk_bf16_f32 %0, %1, %2" : "=v"(r) : "v"(lo), "v"(hi)); return r; }
typedef float f32x2 __attribute__((ext_vector_type(2)));
__device__ __forceinline__ f32x2 gelu_pk(f32x2 v) {
    const f32x2 av = __builtin_elementwise_abs(v), d = av * 0.2316418882f + 1.0f;
    f32x2 t; t.x = __builtin_amdgcn_rcpf(d.x); t.y = __builtin_amdgcn_rcpf(d.y);
    f32x2 q = t * 0.5307027145f + (-0.7265760135f); q = q * t + 0.7107068705f; q = q * t + (-0.142248368f); q = q * t + 0.127414796f; q = q * t;
    const f32x2 s = (v * v) * (-0.72134752044f);
    f32x2 e; e.x = __builtin_amdgcn_exp2f(s.x); e.y = __builtin_amdgcn_exp2f(s.y);
    const f32x2 m = v * (q * e), r = v - m;
    f32x2 o; o.x = v.x < 0.f ? m.x : r.x; o.y = v.y < 0.f ? m.y : r.y; return o;
}

template <int ACT  > struct EpiBf16 {
    static constexpr bool PERM = true, AFTER_DRAIN = false; static_assert(ACT == 0 || ACT == 1, "EpiBf16: ACT is 0 (none) or 1 (gelu_pk)");
    bf16_t* O; int ldc; const float* bias; int split_cols; size_t split_stride; float scale0;
    __device__ __forceinline__ void operator()(const f32x4 (&acc)[2][2][4][2], const Unit& u, int wr, int wc, int fr, int fq) const {
        const int row0 = u.pm * BM + wr * 64 + fr; int colt = u.pn * BM; bf16_t* base = O;
        float sc = 1.f; if (split_cols) { const int t = colt / split_cols; base += (size_t)t * split_stride; colt -= t * split_cols; if (t == 0) sc = scale0; }
        const int col0 = colt + wc * 32 + 8 * fq, bcol0 = u.pn * BM + wc * 32 + 8 * fq;
        f32x4 bv[2][2];
#pragma unroll
        for (int bj = 0; bj < 2; ++bj)
#pragma unroll
            for (int n = 0; n < 2; ++n) bv[bj][n] = bias ? *(const f32x4*)(bias + bcol0 + bj * HALF + 4 * n) : (f32x4){0.f, 0.f, 0.f, 0.f};
#pragma unroll
        for (int ai = 0; ai < 2; ++ai)
#pragma unroll
            for (int m = 0; m < 4; ++m) { bf16_t* rowp = base + (size_t)(row0 + ai * HALF + m * 16) * ldc + col0;
#pragma unroll
                for (int bj = 0; bj < 2; ++bj) { f32x4 v0 = acc[ai][bj][m][0] + bv[bj][0], v1 = acc[ai][bj][m][1] + bv[bj][1];
                    if (ACT == 1) { f32x2 a = gelu_pk((f32x2){v0[0], v0[1]}), b = gelu_pk((f32x2){v0[2], v0[3]}), c = gelu_pk((f32x2){v1[0], v1[1]}), d = gelu_pk((f32x2){v1[2], v1[3]});
                        v0 = (f32x4){a.x, a.y, b.x, b.y}; v1 = (f32x4){c.x, c.y, d.x, d.y}; }
                    v0 = v0 * sc; v1 = v1 * sc; u32x4 w; w.x = cvt_pk_bf16(v0[0], v0[1]); w.y = cvt_pk_bf16(v0[2], v0[3]); w.z = cvt_pk_bf16(v1[0], v1[1]); w.w = cvt_pk_bf16(v1[2], v1[3]);
                    *(u32x4*)(rowp + bj * HALF) = w; } }
    }
};

template <class Epi, class Sched, bool ALIGN_EPI = false, bool SP2 = false>
__device__ __forceinline__ void gemm_phase(PG8_LAS unsigned char* lds, const Gemm g, const Sched& S, const Epi& E) {
    int tid_ = threadIdx.x; asm volatile("" : "+v"(tid_));
    const int tid = tid_, wid = __builtin_amdgcn_readfirstlane(tid >> 6), lane = tid & 63, wr = wid >> 2, wc = wid & 3, fr = lane & 15, fq = lane >> 4;
    const int K = g.K, nt = K / BK;
    unsigned voffA[2], voffB[2];
#pragma unroll
    for (int i = 0; i < 2; ++i) { int R, C; stage_rc(tid * 16 + i * 8192, R, C); const int Rb = Epi::PERM ? ((R & ~31) + perm32(R & 31)) : R;
        voffA[i] = (unsigned)(R * K + C) * 2u; voffB[i] = (unsigned)(Rb * K + C) * 2u; }
    const size_t kstep = (size_t)(BK * 2);
    const size_t hstep = (size_t)HALF * K * 2;
    const size_t tstep = 2 * hstep;
    const unsigned ldsw = (unsigned)wid * 1024u;
    const int aoff = lds_byte(wr * 64 + fr, fq * 8), boff = lds_byte(wc * 32 + fr, fq * 8);
#define PG8_SA(b, h) (((b) * 2 + (h)) * HTB)
#define PG8_SB(b, h) ((4 + (b) * 2 + (h)) * HTB)
#define PG8_STAGE(bufoff, gbase, voff) do { _Pragma("unroll") for (int _i = 0; _i < 2; ++_i) \
        __builtin_amdgcn_global_load_lds((const unsigned*)((const char*)(gbase) + (voff)[_i]), (PG8_LAS unsigned*)(lds + (bufoff) + ldsw + _i * 8192), 16, 0, 0); } while (0)
#define PG8_LDA(dst, b, h) do { _Pragma("unroll") for (int m = 0; m < 4; ++m) _Pragma("unroll") for (int k = 0; k < 2; ++k) dst[m][k] = *(const PG8_LAS bf16x8*)(lds + PG8_SA(b, h) + aoff + m * 2048 + k * 1024); } while (0)
#define PG8_LDB(dst, b, h) do { _Pragma("unroll") for (int n = 0; n < 2; ++n) _Pragma("unroll") for (int k = 0; k < 2; ++k) dst[n][k] = *(const PG8_LAS bf16x8*)(lds + PG8_SB(b, h) + boff + n * 2048 + k * 1024); } while (0)
#define PG8_MMA(ai, bj, At, Bt) do { __builtin_amdgcn_s_setprio(1); _Pragma("unroll") for (int m = 0; m < 4; ++m) _Pragma("unroll") for (int n = 0; n < 2; ++n) _Pragma("unroll") for (int k = 0; k < 2; ++k) \
        acc[ai][bj][m][n] = __builtin_amdgcn_mfma_f32_16x16x32_bf16(Bt[n][k], At[m][k], acc[ai][bj][m][n], 0, 0, 0); __builtin_amdgcn_s_setprio(0); } while (0)
#define PG8_WAIT_V(n) asm volatile("s_waitcnt vmcnt(" #n ")" ::: "memory")
#define PG8_WAIT_L(n) asm volatile("s_waitcnt lgkmcnt(" #n ")" ::: "memory")
#define PG8_BAR __builtin_amdgcn_s_barrier()
#define PG8_SCHED __builtin_amdgcn_sched_barrier(0)
    float zf_ = 0.f; asm volatile("" : "+v"(zf_)); const f32x4 zero4_ = {zf_, zf_, zf_, zf_};
    Unit cur, nxt; int ui = 0;
    if (!S.next(0, cur)) return;
    f32x4 acc[2][2][4][2];
#pragma unroll
    for (int a = 0; a < 2; ++a)
#pragma unroll
        for (int b = 0; b < 2; ++b)
#pragma unroll
            for (int m = 0; m < 4; ++m)
#pragma unroll
                for (int n = 0; n < 2; ++n) acc[a][b][m][n] = zero4_;
    bf16x8 At[4][2], B0[2][2], B1[2][2];
    const char* cA = (const char*)g.A + (size_t)cur.pm * tstep; const char* cB = (const char*)g.Bt + (size_t)cur.pn * tstep;
    S.a_ready(cur);
    if constexpr (SP2) {
        PG8_STAGE(PG8_SB(0, 0), cB, voffB); PG8_STAGE(PG8_SB(0, 1), cB + hstep, voffB); PG8_STAGE(PG8_SA(0, 0), cA, voffA); PG8_STAGE(PG8_SA(0, 1), cA + hstep, voffA);
        if (wr == 1) PG8_BAR;
        PG8_WAIT_V(2); PG8_BAR;
        PG8_STAGE(PG8_SB(1, 0), cB + kstep, voffB); PG8_STAGE(PG8_SA(1, 0), cA + kstep, voffA); PG8_STAGE(PG8_SB(1, 1), cB + hstep + kstep, voffB);
        PG8_WAIT_V(6); PG8_BAR;
    } else {
        PG8_STAGE(PG8_SB(0, 0), cB, voffB); PG8_STAGE(PG8_SA(0, 0), cA, voffA); PG8_STAGE(PG8_SB(0, 1), cB + hstep, voffB); PG8_STAGE(PG8_SA(0, 1), cA + hstep, voffA);
        if (wr == 1) PG8_BAR;
        PG8_WAIT_V(4); PG8_BAR;
        PG8_STAGE(PG8_SB(1, 0), cB + kstep, voffB); PG8_STAGE(PG8_SA(1, 0), cA + kstep, voffA); PG8_STAGE(PG8_SB(1, 1), cB + hstep + kstep, voffB);
        PG8_WAIT_V(6); PG8_BAR;
    }
    for (;;) {
        const bool has_next = S.next(ui + 1, nxt);
        const char* nA = has_next ? (const char*)g.A + (size_t)nxt.pm * tstep : cA; const char* nB = has_next ? (const char*)g.Bt + (size_t)nxt.pn * tstep : cB;
        for (int t = 0; t < nt; t += 2) {
            const bool last = (t == nt - 2);
            const char* a1 = cA + (size_t)(t + 1) * kstep;
            const char* a2 = last ? nA : cA + (size_t)(t + 2) * kstep; const char* b2 = last ? nB : cB + (size_t)(t + 2) * kstep;
            const char* a3 = a2 + kstep; const char* b3 = b2 + kstep;
            if (last && has_next) S.a_ready(nxt);
            if constexpr (SP2) {
            PG8_LDB(B0, 0, 0); PG8_LDB(B1, 0, 1); PG8_SCHED; PG8_LDA(At, 0, 0); PG8_STAGE(PG8_SA(1, 1), a1 + hstep, voffA);
            PG8_WAIT_V(8); PG8_WAIT_L(0); PG8_BAR; PG8_MMA(0, 0, At, B0); PG8_MMA(0, 1, At, B1); PG8_BAR; PG8_SCHED;
            PG8_LDA(At, 0, 1); PG8_STAGE(PG8_SB(0, 0), b2, voffB); PG8_STAGE(PG8_SB(0, 1), b2 + hstep, voffB); PG8_STAGE(PG8_SA(0, 0), a2, voffA);
            PG8_WAIT_V(8); PG8_WAIT_L(0); PG8_BAR; PG8_MMA(1, 0, At, B0); PG8_MMA(1, 1, At, B1); PG8_BAR; PG8_SCHED;
            PG8_LDB(B0, 1, 0); PG8_LDB(B1, 1, 1); PG8_SCHED; PG8_LDA(At, 1, 0); PG8_STAGE(PG8_SA(0, 1), a2 + hstep, voffA);
            PG8_WAIT_V(8); PG8_WAIT_L(0); PG8_BAR; PG8_MMA(0, 0, At, B0); PG8_MMA(0, 1, At, B1); PG8_BAR; PG8_SCHED;
            PG8_LDA(At, 1, 1); PG8_STAGE(PG8_SB(1, 0), b3, voffB); PG8_STAGE(PG8_SB(1, 1), b3 + hstep, voffB); PG8_STAGE(PG8_SA(1, 0), a3, voffA);
            PG8_WAIT_V(8); PG8_WAIT_L(0); PG8_BAR; PG8_MMA(1, 0, At, B0); PG8_MMA(1, 1, At, B1); PG8_BAR; PG8_SCHED;
            } else {
            PG8_LDB(B0, 0, 0); PG8_SCHED; PG8_LDA(At, 0, 0); PG8_STAGE(PG8_SA(1, 1), a1 + hstep, voffA);
            PG8_WAIT_L(8); PG8_BAR; PG8_WAIT_L(0); PG8_MMA(0, 0, At, B0); PG8_BAR; PG8_SCHED;
            PG8_LDB(B1, 0, 1); PG8_STAGE(PG8_SB(0, 0), b2, voffB);
            PG8_BAR; PG8_WAIT_L(0); PG8_MMA(0, 1, At, B1); PG8_BAR;
            PG8_LDA(At, 0, 1); PG8_STAGE(PG8_SA(0, 0), a2, voffA);
            PG8_BAR; PG8_WAIT_L(0); PG8_MMA(1, 0, At, B0); PG8_BAR; PG8_SCHED;
            PG8_STAGE(PG8_SB(0, 1), b2 + hstep, voffB);
            PG8_WAIT_V(6); PG8_BAR; PG8_MMA(1, 1, At, B1); PG8_BAR;
            PG8_LDB(B0, 1, 0); PG8_SCHED; PG8_LDA(At, 1, 0); PG8_STAGE(PG8_SA(0, 1), a2 + hstep, voffA);
            PG8_WAIT_L(8); PG8_BAR; PG8_WAIT_L(0); PG8_MMA(0, 0, At, B0); PG8_BAR; PG8_SCHED;
            PG8_LDB(B1, 1, 1); PG8_STAGE(PG8_SB(1, 0), b3, voffB);
            PG8_BAR; PG8_WAIT_L(0); PG8_MMA(0, 1, At, B1); PG8_BAR;
            PG8_LDA(At, 1, 1); PG8_STAGE(PG8_SA(1, 0), a3, voffA);
            PG8_BAR; PG8_WAIT_L(0); PG8_MMA(1, 0, At, B0); PG8_BAR; PG8_SCHED;
            PG8_STAGE(PG8_SB(1, 1), b3 + hstep, voffB);
            PG8_WAIT_V(6); PG8_BAR; PG8_MMA(1, 1, At, B1); PG8_BAR;
            }
        }
        if constexpr (ALIGN_EPI) { if (wr == 0) PG8_BAR; }
        if constexpr (!Epi::AFTER_DRAIN) { E(acc, cur, wr, wc, fr, fq); S.done(cur); }
        if (!has_next) break;
#pragma unroll
        for (int a = 0; a < 2; ++a)
#pragma unroll
            for (int b = 0; b < 2; ++b)
#pragma unroll
                for (int m = 0; m < 4; ++m)
#pragma unroll
                    for (int n = 0; n < 2; ++n) acc[a][b][m][n] = zero4_;
        cur = nxt; cA = nA; cB = nB; ++ui;
        if constexpr (ALIGN_EPI) { if (wr == 1) PG8_BAR; }
    }
    PG8_WAIT_V(0);
    if constexpr (!ALIGN_EPI) { if (wr == 0) PG8_BAR; }
    PG8_BAR;
    if constexpr (Epi::AFTER_DRAIN) { E.fused(acc, cur, wr, wc, fr, fq, lds, wid, lane); S.done(cur); }
#undef PG8_SA
#undef PG8_SB
#undef PG8_STAGE
#undef PG8_LDA
#undef PG8_LDB
#undef PG8_MMA
#undef PG8_WAIT_V
#undef PG8_WAIT_L
#undef PG8_BAR
#undef PG8_SCHED
}
}

#define LAS __attribute__((address_space(3)))
typedef unsigned short bf16;
typedef unsigned v4u __attribute__((ext_vector_type(4)));
typedef unsigned v2u __attribute__((ext_vector_type(2)));
typedef float fx4 __attribute__((ext_vector_type(4)));
typedef float fx2 __attribute__((ext_vector_type(2)));
typedef float fx16 __attribute__((ext_vector_type(16)));
typedef short hx8 __attribute__((ext_vector_type(8)));
typedef short hx4 __attribute__((ext_vector_type(4)));
typedef __bf16 bfx2_t __attribute__((ext_vector_type(2)));

constexpr int NB = 4, SEQ = 8192, T = NB * SEQ, D = 1024, FF = 2816, NIN = 1952, NINP = 2048, PLE = 256;
constexpr int QL = 256, KVL = 128;
constexpr float EPS = 1e-6f;
constexpr int NTHREADS = 512;
constexpr int LDS_BYTES = 131072 + 1024;

constexpr size_t MiB = 1u << 20;
constexpr size_t OFF_WB = 0;
constexpr size_t OFF_TAB = 48 * MiB;
constexpr size_t OFF_LSE = 60 * MiB;
constexpr size_t OFF_XN = 64 * MiB;
constexpr size_t OFF_F = 128 * MiB;
constexpr size_t OFF_HID = 192 * MiB;
constexpr size_t OFF_Q = OFF_HID + 128 * MiB;
constexpr size_t OFF_KCAT = 368 * MiB;
constexpr size_t OFF_V = 416 * MiB;
constexpr size_t OFF_QLN = 448 * MiB;
constexpr size_t OFF_KVLN = 464 * MiB;
constexpr size_t OFF_BAR = 472 * MiB;
constexpr size_t BAR_BYTES = 16384;
constexpr size_t WS_NEED = 473 * MiB;
constexpr size_t WE_FIN_A = 0;
constexpr size_t WE_FDN_A = WE_FIN_A + (size_t)2 * FF * D;
constexpr size_t WE_FIN_B = WE_FDN_A + (size_t)D * FF;
constexpr size_t WE_FDN_B = WE_FIN_B + (size_t)2 * FF * D;
constexpr size_t WE_IN = WE_FDN_B + (size_t)D * FF;
constexpr size_t WE_QUP = WE_IN + (size_t)NINP * D;
constexpr size_t WE_OUT = WE_QUP + (size_t)1792 * 384;
constexpr size_t WE_PLE = WE_OUT + (size_t)D * D;
constexpr size_t WE_PG = WE_PLE + (size_t)D * PLE;
constexpr size_t WE_END = WE_PG + (size_t)D * D;
static_assert(WE_END * 2 <= 48 * MiB, "weights fit");

__device__ const float INV_M[16] = {1.000000000e+00f, 5.623413324e-01f, 3.162277639e-01f, 1.778279394e-01f, 1.000000015e-01f, 5.623413250e-02f, 3.162277490e-02f, 1.778279431e-02f, 9.999999776e-03f, 5.623413250e-03f, 3.162277630e-03f, 1.778279431e-03f, 1.000000047e-03f, 5.623413017e-04f, 3.162277571e-04f, 1.778279402e-04f};
__device__ const float INV_D[32] = {1.000000000e+00f, 7.498942614e-01f, 5.623413324e-01f, 4.216965139e-01f, 3.162277639e-01f, 2.371373773e-01f, 1.778279394e-01f, 1.333521307e-01f, 1.000000015e-01f, 7.498941571e-02f, 5.623413250e-02f, 4.216965288e-02f, 3.162277490e-02f, 2.371373773e-02f, 1.778279431e-02f, 1.333521493e-02f, 9.999999776e-03f, 7.498941850e-03f, 5.623413250e-03f, 4.216964822e-03f, 3.162277630e-03f, 2.371373586e-03f, 1.778279431e-03f, 1.333521446e-03f, 1.000000047e-03f, 7.498942432e-04f, 5.623413017e-04f, 4.216965172e-04f, 3.162277571e-04f, 2.371373703e-04f, 1.778279402e-04f, 1.333521504e-04f};

struct Params { const float* in[16]; float* out; unsigned char* ws; };

__device__ __forceinline__ unsigned pk2(float lo, float hi) { fx2 v = {lo, hi}; bfx2_t b = __builtin_convertvector(v, bfx2_t); return __builtin_bit_cast(unsigned, b); }
__device__ __forceinline__ float bflo(unsigned u) { return __uint_as_float(u << 16); }
__device__ __forceinline__ float bfhi(unsigned u) { return __uint_as_float(u & 0xffff0000u); }
__device__ __forceinline__ float wave_sum(float v) {
#pragma unroll
    for (int o = 1; o < 64; o <<= 1) v += __shfl_xor(v, o);
    return v;
}
__device__ __forceinline__ float fast_rcp(float x) { return __builtin_amdgcn_rcpf(x); }
__device__ __forceinline__ float fast_exp2(float x) { return __builtin_amdgcn_exp2f(x); }
__device__ __forceinline__ float fast_rsq(float x) { return __builtin_amdgcn_rsqf(x); }

namespace pg8 {
struct EpiSwiglu {
    static constexpr bool PERM = true, AFTER_DRAIN = false;
    bf16_t* O; int ldc;
    __device__ __forceinline__ void operator()(const f32x4 (&acc)[2][2][4][2], const Unit& u, int wr, int wc, int fr, int fq) const {
        const int row0 = u.pm * BM + wr * 64 + fr; const int col0 = u.pn * 128 + wc * 32 + 8 * fq;
#pragma unroll
        for (int ai = 0; ai < 2; ++ai)
#pragma unroll
            for (int m = 0; m < 4; ++m) {
                bf16_t* rowp = O + (size_t)(row0 + ai * HALF + m * 16) * ldc + col0;
                float h[8];
#pragma unroll
                for (int n = 0; n < 2; ++n)
#pragma unroll
                    for (int e = 0; e < 4; ++e) {
                        const float g = acc[ai][0][m][n][e], up = acc[ai][1][m][n][e];
                        const float sg = g * __builtin_amdgcn_rcpf(1.0f + __builtin_amdgcn_exp2f(-1.4426950408889634f * g));
                        h[n * 4 + e] = sg * up;
                    }
                u32x4 w; w.x = ::pk2(h[0], h[1]); w.y = ::pk2(h[2], h[3]); w.z = ::pk2(h[4], h[5]); w.w = ::pk2(h[6], h[7]);
                *(u32x4*)rowp = w;
            }
    }
};
struct EpiQKV {
    static constexpr bool PERM = true, AFTER_DRAIN = false;
    bf16_t* Q; bf16_t* Kc; bf16_t* V;
    __device__ __forceinline__ void operator()(const f32x4 (&acc)[2][2][4][2], const Unit& u, int wr, int wc, int fr, int fq) const {
        const int row0 = u.pm * BM + wr * 64 + fr;
#pragma unroll
        for (int bj = 0; bj < 2; ++bj) {
            bf16_t* ub; int rs;
            if (u.pn < 3) { ub = Q + u.pn * 256 + bj * 128 + wc * 32; rs = 768; }
            else { const int head = 2 * (u.pn - 3) + bj; if (wc < 2) { ub = Kc + head * 96 + wc * 32; rs = 768; } else { ub = V + head * 64 + (wc * 32 - 64); rs = 512; } }
            const unsigned loff = (unsigned)row0 * (unsigned)rs + 8u * (unsigned)fq;
#pragma unroll
            for (int ai = 0; ai < 2; ++ai)
#pragma unroll
                for (int m = 0; m < 4; ++m) {
                    bf16_t* dst = ub + (loff + (unsigned)((ai * HALF + m * 16) * rs));
                    const f32x4 v0 = acc[ai][bj][m][0], v1 = acc[ai][bj][m][1];
                    u32x4 w; w.x = ::pk2(v0[0], v0[1]); w.y = ::pk2(v0[2], v0[3]); w.z = ::pk2(v1[0], v1[1]); w.w = ::pk2(v1[2], v1[3]);
                    *(u32x4*)dst = w;
                }
        }
    }
};
struct EpiGate {
    static constexpr bool PERM = true, AFTER_DRAIN = false;
    bf16_t* O; const bf16_t* PP; int ldc;
    __device__ __forceinline__ void operator()(const f32x4 (&acc)[2][2][4][2], const Unit& u, int wr, int wc, int fr, int fq) const {
        const int row0 = u.pm * BM + wr * 64 + fr; const int col0 = u.pn * BM + wc * 32 + 8 * fq;
#pragma unroll
        for (int ai = 0; ai < 2; ++ai)
#pragma unroll
            for (int m = 0; m < 4; ++m)
#pragma unroll
                for (int bj = 0; bj < 2; ++bj) {
                    const size_t off = (size_t)(row0 + ai * HALF + m * 16) * ldc + col0 + bj * HALF;
                    const u32x4 pv = *(const u32x4*)(PP + off);
                    float pp[8] = {::bflo(pv.x), ::bfhi(pv.x), ::bflo(pv.y), ::bfhi(pv.y), ::bflo(pv.z), ::bfhi(pv.z), ::bflo(pv.w), ::bfhi(pv.w)};
                    float o[8];
#pragma unroll
                    for (int n = 0; n < 2; ++n)
#pragma unroll
                        for (int e = 0; e < 4; ++e) {
                            const float g = acc[ai][bj][m][n][e];
                            o[n * 4 + e] = pp[n * 4 + e] * __builtin_amdgcn_rcpf(1.0f + __builtin_amdgcn_exp2f(-1.4426950408889634f * g));
                        }
                    u32x4 w; w.x = ::pk2(o[0], o[1]); w.y = ::pk2(o[2], o[3]); w.z = ::pk2(o[4], o[5]); w.w = ::pk2(o[6], o[7]);
                    *(u32x4*)(O + off) = w;
                }
    }
};
}

__device__ __forceinline__ void tr_item(const float* W, int K, int N, int k0, int n0, bf16* WT, int drow0, int ldk, int dk, LAS float* scr, int lane) {
#pragma unroll 8
    for (int i = 0; i < 32; ++i) { const int kk = 2 * i + (lane >> 5); scr[kk * 33 + (lane & 31)] = W[(size_t)(k0 + kk) * N + n0 + (lane & 31)]; }
    asm volatile("s_waitcnt lgkmcnt(0)" ::: "memory");
    const int c = lane & 7;
#pragma unroll
    for (int j = 0; j < 4; ++j) { const int n = (lane >> 3) + 8 * j; const LAS float* s = scr + (8 * c) * 33 + n;
        v4u o; o.x = pk2(s[0 * 33], s[1 * 33]); o.y = pk2(s[2 * 33], s[3 * 33]); o.z = pk2(s[4 * 33], s[5 * 33]); o.w = pk2(s[6 * 33], s[7 * 33]);
        *(v4u*)(WT + (size_t)(drow0 + n) * ldk + dk + k0 + 8 * c) = o; }
    asm volatile("s_waitcnt lgkmcnt(0)" ::: "memory");
}
__device__ __forceinline__ void tr_matrix_item(const float* W, int K, int N, bf16* WT, int mode, int item, LAS float* scr, int lane, int ldk = 0, int dk = 0) {
    const int nblk = N / 32, kb = item / nblk, nb = item % nblk, k0 = 64 * kb, n0 = 32 * nb;
    int drow0 = n0;
    if (mode != 0) drow0 = 256 * (n0 >> 7) + (n0 & 127) + (mode == 2 ? 128 : 0);
    tr_item(W, K, N, k0, n0, WT, drow0, ldk ? ldk : K, dk, scr, lane);
}
__device__ __forceinline__ void convert_weights(const Params& P, unsigned char* ws, int layer, LAS unsigned char* lds, int gw, int NGW, int wave, int lane) {
    LAS float* scr = (LAS float*)(lds + wave * 16384);
    bf16* WB = (bf16*)(ws + OFF_WB);
    const float* w_in = P.in[4] + (size_t)layer * D * NIN;
    const float* w_qup = P.in[6] + (size_t)layer * QL * 768;
    const float* w_kvup = P.in[8] + (size_t)layer * KVL * 1024;
    const float* w_out = P.in[10] + (size_t)layer * D * D;
    const float* fg = P.in[11] + (size_t)layer * 2 * D * FF;
    const float* fu = P.in[12] + (size_t)layer * 2 * D * FF;
    const float* fd = P.in[13] + (size_t)layer * 2 * FF * D;
    const float* w_ple = P.in[14] + (size_t)layer * PLE * D;
    const float* w_pg = P.in[15] + (size_t)layer * D * D;
    constexpr int I_FIN = (D / 64) * (FF / 32);
    constexpr int I_FDN = (FF / 64) * (D / 32);
    constexpr int I_IN = (D / 64) * (NIN / 32);
    constexpr int I_QUP = (QL / 64) * (768 / 32);
    constexpr int I_KVUP = (KVL / 64) * (1024 / 32);
    constexpr int I_DD = (D / 64) * (D / 32);
    constexpr int I_PLE = (PLE / 64) * (D / 32);
    constexpr int NITEMS = 4 * I_FIN + 2 * I_FDN + I_IN + I_QUP + I_KVUP + 2 * I_DD + I_PLE;
    for (int it = gw; it < NITEMS; it += NGW) {
        int r = it;
        if (r < I_FIN) { tr_matrix_item(fg, D, FF, WB + WE_FIN_A, 1, r, scr, lane); continue; } r -= I_FIN;
        if (r < I_FIN) { tr_matrix_item(fu, D, FF, WB + WE_FIN_A, 2, r, scr, lane); continue; } r -= I_FIN;
        if (r < I_FIN) { tr_matrix_item(fg + (size_t)D * FF, D, FF, WB + WE_FIN_B, 1, r, scr, lane); continue; } r -= I_FIN;
        if (r < I_FIN) { tr_matrix_item(fu + (size_t)D * FF, D, FF, WB + WE_FIN_B, 2, r, scr, lane); continue; } r -= I_FIN;
        if (r < I_FDN) { tr_matrix_item(fd, FF, D, WB + WE_FDN_A, 0, r, scr, lane); continue; } r -= I_FDN;
        if (r < I_FDN) { tr_matrix_item(fd + (size_t)FF * D, FF, D, WB + WE_FDN_B, 0, r, scr, lane); continue; } r -= I_FDN;
        if (r < I_IN) { tr_matrix_item(w_in, D, NIN, WB + WE_IN, 0, r, scr, lane); continue; } r -= I_IN;
        if (r < I_QUP) { tr_matrix_item(w_qup, QL, 768, WB + WE_QUP, 0, r, scr, lane, 384, 0); continue; } r -= I_QUP;
        if (r < I_KVUP) { tr_matrix_item(w_kvup, KVL, 1024, WB + WE_QUP + (size_t)768 * 384, 0, r, scr, lane, 384, 256); continue; } r -= I_KVUP;
        if (r < I_DD) { tr_matrix_item(w_out, D, D, WB + WE_OUT, 0, r, scr, lane); continue; } r -= I_DD;
        if (r < I_PLE) { tr_matrix_item(w_ple, PLE, D, WB + WE_PLE, 0, r, scr, lane); continue; } r -= I_PLE;
        tr_matrix_item(w_pg, D, D, WB + WE_PG, 0, r, scr, lane);
    }
    {
        v4u* qk = (v4u*)(WB + WE_QUP); unsigned z0_ = 0u; asm volatile("" : "+v"(z0_)); const v4u z = {z0_, z0_, z0_, z0_};
        const int gt = gw * 64 + lane, NTT = NGW * 64;
        for (int i = gt; i < 768 * 16; i += NTT) { const int row = i >> 4, ch = i & 15; qk[(size_t)row * 48 + 32 + ch] = z; }
        for (int i = gt; i < 1024 * 32; i += NTT) { const int row = 768 + (i >> 5), ch = i & 31; qk[(size_t)row * 48 + ch] = z; }
    }
}

__device__ __forceinline__ void rope_tables(const Params& P, unsigned char* ws, int gtid, int NT) {
    const int* pos = (const int*)P.in[2];
    float* cosM = (float*)(ws + OFF_TAB); float* sinM = cosM + (size_t)T * 16; float* cosD = sinM + (size_t)T * 16; float* sinD = cosD + (size_t)T * 32;
    for (int e = gtid; e < T * 48; e += NT) {
        const int tok = e / 48, i = e % 48;
        const float inv = (i < 16) ? INV_M[i] : INV_D[i - 16];
        const float ang = (float)pos[tok] * inv;
        double tt = (double)ang * 0.15915494309189535; tt -= __builtin_rint(tt);
        const float rev = (float)tt;
        const float c = __builtin_amdgcn_cosf(rev), s = __builtin_amdgcn_sinf(rev);
        if (i < 16) { cosM[(size_t)tok * 16 + i] = c; sinM[(size_t)tok * 16 + i] = s; }
        else { cosD[(size_t)tok * 32 + i - 16] = c; sinD[(size_t)tok * 32 + i - 16] = s; }
    }
}

template <bool HAS_F, bool HIN_BF, bool HOUT_BF>
__device__ __forceinline__ void resnorm_rows(const void* hin, void* hout, const bf16* f, float alpha, const float* ga, const float* gb, bf16* xn, int gw, int NGW, int lane) {
  if constexpr (HAS_F && HIN_BF) {
    int m = gw; if (m >= T) return;
    v2u ch[4], cf[4];
    { const v2u* hr = (const v2u*)((const bf16*)hin + (size_t)m * 2048) + lane; const v2u* fr = (const v2u*)(f + (size_t)m * D) + lane;
#pragma unroll
      for (int j = 0; j < 4; ++j) { ch[j] = hr[64 * j]; cf[j] = fr[64 * j]; } }
    fx4 g1[4], g2[4];
#pragma unroll
    for (int j = 0; j < 4; ++j) { g1[j] = ((const fx4*)ga)[lane + 64 * j]; g2[j] = ((const fx4*)gb)[lane + 64 * j]; }
    for (; m < T; m += NGW) {
        const int mn = m + NGW; v2u nh[4], nf[4];
        if (mn < T) { const v2u* hr = (const v2u*)((const bf16*)hin + (size_t)mn * 2048) + lane; const v2u* fr = (const v2u*)(f + (size_t)mn * D) + lane;
#pragma unroll
            for (int j = 0; j < 4; ++j) { nh[j] = hr[64 * j]; nf[j] = fr[64 * j]; } }
        fx4 hv[4], fv[4]; float ss = 0.f;
#pragma unroll
        for (int j = 0; j < 4; ++j) { hv[j] = (fx4){bflo(ch[j].x), bfhi(ch[j].x), bflo(ch[j].y), bfhi(ch[j].y)}; fv[j] = (fx4){bflo(cf[j].x), bfhi(cf[j].x), bflo(cf[j].y), bfhi(cf[j].y)};
            ss += (fv[j].x * fv[j].x + fv[j].y * fv[j].y) + (fv[j].z * fv[j].z + fv[j].w * fv[j].w); }
        const float rstd = fast_rsq(wave_sum(ss) * (1.0f / D) + EPS) * alpha;
#pragma unroll
        for (int j = 0; j < 4; ++j) hv[j] = hv[j] + fv[j] * g1[j] * rstd;
        if (HOUT_BF) { v2u* ho = (v2u*)((bf16*)hout + (size_t)m * 2048) + lane;
#pragma unroll
            for (int j = 0; j < 4; ++j) ho[64 * j] = (v2u){pk2(hv[j].x, hv[j].y), pk2(hv[j].z, hv[j].w)};
        } else { fx4* ho = (fx4*)((float*)hout + (size_t)m * D) + lane;
#pragma unroll
            for (int j = 0; j < 4; ++j) ho[64 * j] = hv[j]; }
        float s2 = 0.f;
#pragma unroll
        for (int j = 0; j < 4; ++j) s2 += (hv[j].x * hv[j].x + hv[j].y * hv[j].y) + (hv[j].z * hv[j].z + hv[j].w * hv[j].w);
        const float rstd2 = fast_rsq(wave_sum(s2) * (1.0f / D) + EPS);
        v2u* xo = (v2u*)(xn + (size_t)m * D) + lane;
#pragma unroll
        for (int j = 0; j < 4; ++j) { const fx4 y = hv[j] * g2[j] * rstd2; xo[64 * j] = (v2u){pk2(y.x, y.y), pk2(y.z, y.w)}; }
#pragma unroll
        for (int j = 0; j < 4; ++j) { ch[j] = nh[j]; cf[j] = nf[j]; }
    }
  } else {
    for (int m = gw; m < T; m += NGW) {
        fx4 hv[4];
        if (HIN_BF) {
            const v2u* hr = (const v2u*)((const bf16*)hin + (size_t)m * 2048) + lane;
#pragma unroll
            for (int j = 0; j < 4; ++j) { const v2u w = hr[64 * j]; hv[j] = (fx4){bflo(w.x), bfhi(w.x), bflo(w.y), bfhi(w.y)}; }
        } else {
            const fx4* hr = (const fx4*)((const float*)hin + (size_t)m * D) + lane;
#pragma unroll
            for (int j = 0; j < 4; ++j) hv[j] = hr[64 * j];
        }
        if (HAS_F) {
            const v2u* fr = (const v2u*)(f + (size_t)m * D) + lane;
            fx4 fv[4]; float ss = 0.f;
#pragma unroll
            for (int j = 0; j < 4; ++j) { const v2u w = fr[64 * j]; fv[j] = (fx4){bflo(w.x), bfhi(w.x), bflo(w.y), bfhi(w.y)}; ss += (fv[j].x * fv[j].x + fv[j].y * fv[j].y) + (fv[j].z * fv[j].z + fv[j].w * fv[j].w); }
            const float rstd = fast_rsq(wave_sum(ss) * (1.0f / D) + EPS) * alpha;
#pragma unroll
            for (int j = 0; j < 4; ++j) { const fx4 g = ((const fx4*)ga)[lane + 64 * j]; hv[j] = hv[j] + fv[j] * g * rstd; }
        }
        if (HOUT_BF) {
            v2u* ho = (v2u*)((bf16*)hout + (size_t)m * 2048) + lane;
#pragma unroll
            for (int j = 0; j < 4; ++j) ho[64 * j] = (v2u){pk2(hv[j].x, hv[j].y), pk2(hv[j].z, hv[j].w)};
        } else {
            fx4* ho = (fx4*)((float*)hout + (size_t)m * D) + lane;
#pragma unroll
            for (int j = 0; j < 4; ++j) ho[64 * j] = hv[j];
        }
        float s2 = 0.f;
#pragma unroll
        for (int j = 0; j < 4; ++j) s2 += (hv[j].x * hv[j].x + hv[j].y * hv[j].y) + (hv[j].z * hv[j].z + hv[j].w * hv[j].w);
        const float rstd2 = fast_rsq(wave_sum(s2) * (1.0f / D) + EPS);
        v2u* xo = (v2u*)(xn + (size_t)m * D) + lane;
#pragma unroll
        for (int j = 0; j < 4; ++j) { const fx4 g = ((const fx4*)gb)[lane + 64 * j]; const fx4 y = hv[j] * g * rstd2; xo[64 * j] = (v2u){pk2(y.x, y.y), pk2(y.z, y.w)}; }
    }
  }
}

struct PrepRow { v2u q; unsigned kv; unsigned short x1, x2; float c, s; fx4 cs, sn; v2u a0, b0, a1, b1; };
__device__ __forceinline__ void mixer_prep_rows(const Params& P, unsigned char* ws, int layer, int gw, int NGW, int lane) {
    bf16* Z = (bf16*)(ws + OFF_HID); bf16* qkv = (bf16*)(ws + OFF_QLN); bf16* Kc = (bf16*)(ws + OFF_KCAT);
    const float* cosM = (const float*)(ws + OFF_TAB); const float* sinM = cosM + (size_t)T * 16; const float* cosD = sinM + (size_t)T * 16; const float* sinD = cosD + (size_t)T * 32;
    const float* qn = P.in[5] + (size_t)layer * QL; const float* kvn = P.in[7] + (size_t)layer * KVL;
    const int head = lane >> 3, c4 = lane & 7;
    const fx4 gq = ((const fx4*)qn)[lane]; const fx2 gkv = ((const fx2*)kvn)[lane];
#define PREP_LOAD(R_, m_) do { const bf16* z_ = Z + (size_t)(m_) * NINP; R_.q = ((const v2u*)z_)[lane]; R_.kv = ((const unsigned*)(z_ + 256))[lane]; \
        R_.x1 = z_[384 + (lane & 15)]; R_.x2 = z_[400 + (lane & 15)]; R_.c = cosM[(size_t)(m_) * 16 + (lane & 15)]; R_.s = sinM[(size_t)(m_) * 16 + (lane & 15)]; \
        R_.cs = ((const fx4*)(cosD + (size_t)(m_) * 32))[c4]; R_.sn = ((const fx4*)(sinD + (size_t)(m_) * 32))[c4]; \
        const bf16* b0_ = z_ + 416 + head * 64 + 4 * c4; const bf16* b1_ = z_ + 928 + head * 64 + 4 * c4; \
        R_.a0 = *(const v2u*)b0_; R_.b0 = *(const v2u*)(b0_ + 32); R_.a1 = *(const v2u*)b1_; R_.b1 = *(const v2u*)(b1_ + 32); } while (0)
    int m = gw; if (m >= T) return;
    PrepRow cur; PREP_LOAD(cur, m);
    for (; m < T; m += NGW) {
        const int mn = m + NGW; PrepRow nxt = cur;
        if (mn < T) PREP_LOAD(nxt, mn);
        bf16* z = Z + (size_t)m * NINP;
        {
            const v2u w = cur.q; const fx4 v = {bflo(w.x), bfhi(w.x), bflo(w.y), bfhi(w.y)};
            const float ss = (v.x * v.x + v.y * v.y) + (v.z * v.z + v.w * v.w);
            const float rstd = fast_rsq(wave_sum(ss) * (1.0f / QL) + EPS);
            const fx4 y = v * gq * rstd;
            ((v2u*)(qkv + (size_t)m * 384))[lane] = (v2u){pk2(y.x, y.y), pk2(y.z, y.w)};
        }
        {
            const unsigned w = cur.kv; const float a = bflo(w), b = bfhi(w);
            const float rstd = fast_rsq(wave_sum(a * a + b * b) * (1.0f / KVL) + EPS);
            ((unsigned*)(qkv + (size_t)m * 384 + 256))[lane] = pk2(a * gkv.x * rstd, b * gkv.y * rstd);
        }
        if (lane < 16) {
            const float x1 = __uint_as_float((unsigned)cur.x1 << 16), x2 = __uint_as_float((unsigned)cur.x2 << 16);
            const unsigned o = pk2(x1 * cur.c - x2 * cur.s, x2 * cur.c + x1 * cur.s);
            bf16* kr = Kc + (size_t)m * 768 + 64 + lane;
#pragma unroll
            for (int h = 0; h < 8; ++h) { kr[h * 96] = (bf16)(o & 0xffffu); kr[h * 96 + 16] = (bf16)(o >> 16); }
        }
        {
#pragma unroll
            for (int w = 0; w < 2; ++w) {
                bf16* base = z + (w == 0 ? 416 : 928) + head * 64 + 4 * c4;
                const v2u a = (w == 0) ? cur.a0 : cur.a1, b = (w == 0) ? cur.b0 : cur.b1;
                const fx4 x1 = {bflo(a.x), bfhi(a.x), bflo(a.y), bfhi(a.y)}, x2 = {bflo(b.x), bfhi(b.x), bflo(b.y), bfhi(b.y)};
                const fx4 o1 = x1 * cur.cs - x2 * cur.sn, o2 = x2 * cur.cs + x1 * cur.sn;
                *(v2u*)base = (v2u){pk2(o1.x, o1.y), pk2(o1.z, o1.w)};
                *(v2u*)(base + 32) = (v2u){pk2(o2.x, o2.y), pk2(o2.z, o2.w)};
            }
        }
        cur = nxt;
    }
#undef PREP_LOAD
}

struct MergeRow { v4u wm, w2, w0, w1; float L0, L1, L2; };
__device__ __forceinline__ void merge_rows(const Params& P, unsigned char* ws, int layer, int gw, int NGW, int lane) {
    bf16* XN = (bf16*)(ws + OFF_XN); const bf16* Fb = (const bf16*)(ws + OFF_F); const float* LSE = (const float*)(ws + OFF_LSE);
    const float* gg = P.in[9] + (size_t)layer * D;
    const int head = lane >> 3;
    const fx4 gm0 = ((const fx4*)gg)[2 * lane], gm1 = ((const fx4*)gg)[2 * lane + 1], gd0 = ((const fx4*)(gg + 512))[2 * lane], gd1 = ((const fx4*)(gg + 512))[2 * lane + 1];
#define MERGE_LOAD(R_, m_) do { R_.wm = *(const v4u*)(XN + (size_t)(m_) * D + 8 * lane); R_.w2 = *(const v4u*)(XN + (size_t)(m_) * D + 512 + 8 * lane); \
        R_.w0 = *(const v4u*)(Fb + (size_t)(m_) * 512 + 8 * lane); R_.w1 = *(const v4u*)(Fb + (size_t)T * 512 + (size_t)(m_) * 512 + 8 * lane); \
        R_.L0 = LSE[(size_t)(m_) * 8 + head]; R_.L1 = LSE[(size_t)T * 8 + (size_t)(m_) * 8 + head]; R_.L2 = LSE[(size_t)2 * T * 8 + (size_t)(m_) * 8 + head]; } while (0)
    int m = gw; if (m >= T) return;
    MergeRow cur; MERGE_LOAD(cur, m);
    for (; m < T; m += NGW) {
        const int mn = m + NGW; MergeRow nxt = cur;
        if (mn < T) MERGE_LOAD(nxt, mn);
        const v4u wm = cur.wm, w2 = cur.w2, w0 = cur.w0, w1 = cur.w1;
        const float L0 = cur.L0, L1 = cur.L1, L2 = cur.L2;
        const float mx = fmaxf(L0, fmaxf(L1, L2));
        float e0 = fast_exp2(L0 - mx), e1 = fast_exp2(L1 - mx), e2 = fast_exp2(L2 - mx);
        const float inv = fast_rcp(e0 + e1 + e2); e0 *= inv; e1 *= inv; e2 *= inv;
        float om[8] = {bflo(wm.x), bfhi(wm.x), bflo(wm.y), bfhi(wm.y), bflo(wm.z), bfhi(wm.z), bflo(wm.w), bfhi(wm.w)};
        float a0[8] = {bflo(w0.x), bfhi(w0.x), bflo(w0.y), bfhi(w0.y), bflo(w0.z), bfhi(w0.z), bflo(w0.w), bfhi(w0.w)};
        float a1[8] = {bflo(w1.x), bfhi(w1.x), bflo(w1.y), bfhi(w1.y), bflo(w1.z), bfhi(w1.z), bflo(w1.w), bfhi(w1.w)};
        float a2[8] = {bflo(w2.x), bfhi(w2.x), bflo(w2.y), bfhi(w2.y), bflo(w2.z), bfhi(w2.z), bflo(w2.w), bfhi(w2.w)};
        float od[8]; float ssm = 0.f, ssd = 0.f;
#pragma unroll
        for (int e = 0; e < 8; ++e) { od[e] = e0 * a0[e] + e1 * a1[e] + e2 * a2[e]; ssm += om[e] * om[e]; ssd += od[e] * od[e]; }
        const float rm = fast_rsq(wave_sum(ssm) * (1.0f / 512) + EPS), rd = fast_rsq(wave_sum(ssd) * (1.0f / 512) + EPS);
        v4u o;
        o.x = pk2(om[0] * gm0.x * rm, om[1] * gm0.y * rm); o.y = pk2(om[2] * gm0.z * rm, om[3] * gm0.w * rm); o.z = pk2(om[4] * gm1.x * rm, om[5] * gm1.y * rm); o.w = pk2(om[6] * gm1.z * rm, om[7] * gm1.w * rm);
        *(v4u*)(XN + (size_t)m * D + 8 * lane) = o;
        o.x = pk2(od[0] * gd0.x * rd, od[1] * gd0.y * rd); o.y = pk2(od[2] * gd0.z * rd, od[3] * gd0.w * rd); o.z = pk2(od[4] * gd1.x * rd, od[5] * gd1.y * rd); o.w = pk2(od[6] * gd1.z * rd, od[7] * gd1.w * rd);
        *(v4u*)(XN + (size_t)m * D + 512 + 8 * lane) = o;
        cur = nxt;
    }
#undef MERGE_LOAD
}

__device__ __forceinline__ void convert_p(const Params& P, unsigned char* ws, int layer, int gtid, int NT) {
    const fx4* src = (const fx4*)(P.in[1] + (size_t)layer * T * PLE); v4u* dst = (v4u*)(ws + OFF_QLN);
    for (int i = gtid; i < T * PLE / 8; i += NT) { const fx4 a = src[2 * i], b = src[2 * i + 1]; dst[i] = (v4u){pk2(a.x, a.y), pk2(a.z, a.w), pk2(b.x, b.y), pk2(b.z, b.w)}; }
}

struct AttnArgs {
    const bf16* Q; int qs;
    const bf16* K; int ks;
    const bf16* V; int vs;
    bf16* O; int os;
    float* L; int ls;
    const float* cosT; const float* sinT;
    int q0; float c;
};
template <int DQK, bool WIN>
__device__ __forceinline__ void attn_unit(LAS unsigned char* lds, const AttnArgs& a) {
    constexpr int KCH = DQK / 8, NKC = 64 * KCH, NC = NKC + 512, NIT = (NC + 511) / 512;
    constexpr int KRS = DQK * 2 + 16, KBYTES = 64 * KRS, BUFB = KBYTES + 8192;
    constexpr int NDS = DQK / 16;
    int tid_ = threadIdx.x; asm volatile("" : "+v"(tid_));
    const int tid = tid_, lane = tid & 63, wid = __builtin_amdgcn_readfirstlane(tid >> 6), r32 = lane & 31, hi = lane >> 5;
    const int qw0 = a.q0 + 32 * wid, qpos = qw0 + r32;
    const int t_hi = (a.q0 + 256) >> 6;
    const int t_lo = WIN ? (a.q0 >= 128 ? ((a.q0 - 128) >> 6) : 0) : 0;
    v4u st[NIT];
#pragma unroll
    for (int it = 0; it < NIT; ++it) { const int c = tid + 512 * it;
        if (c < NC) { if (c < NKC) { const int row = c / KCH, ch = c % KCH; st[it] = *(const v4u*)(a.K + (long)(64 * t_lo + row) * a.ks + ch * 8); }
                      else { const int c2 = c - NKC, row = c2 >> 3, ch = c2 & 7; st[it] = *(const v4u*)(a.V + (long)(64 * t_lo + row) * a.vs + ch * 8); } } }
    hx8 qf[NDS];
    { const bf16* qrow = a.Q + (long)qpos * a.qs + 8 * hi;
#pragma unroll
      for (int ds = 0; ds < NDS; ++ds) qf[ds] = *(const hx8*)(qrow + 16 * ds);
      if (DQK == 96) {
          const fx4* cp = (const fx4*)(a.cosT + (long)qpos * 16 + 8 * hi); const fx4* sp = (const fx4*)(a.sinT + (long)qpos * 16 + 8 * hi);
          const fx4 c0 = cp[0], c1 = cp[1], s0 = sp[0], s1 = sp[1];
          const float cc[8] = {c0.x, c0.y, c0.z, c0.w, c1.x, c1.y, c1.z, c1.w}, sn[8] = {s0.x, s0.y, s0.z, s0.w, s1.x, s1.y, s1.z, s1.w};
          float n1[8], n2[8];
#pragma unroll
          for (int j = 0; j < 8; ++j) { const float x1 = __uint_as_float((unsigned)(unsigned short)qf[NDS - 2][j] << 16), x2 = __uint_as_float((unsigned)(unsigned short)qf[NDS - 1][j] << 16);
              n1[j] = x1 * cc[j] - x2 * sn[j]; n2[j] = x2 * cc[j] + x1 * sn[j]; }
          qf[NDS - 2] = __builtin_bit_cast(hx8, (v4u){pk2(n1[0], n1[1]), pk2(n1[2], n1[3]), pk2(n1[4], n1[5]), pk2(n1[6], n1[7])});
          qf[NDS - 1] = __builtin_bit_cast(hx8, (v4u){pk2(n2[0], n2[1]), pk2(n2[2], n2[3]), pk2(n2[4], n2[5]), pk2(n2[6], n2[7])});
      } }
#pragma unroll
    for (int it = 0; it < NIT; ++it) { const int c = tid + 512 * it;
        if (c < NC) { if (c < NKC) { const int row = c / KCH, ch = c % KCH; *(LAS v4u*)(lds + row * KRS + ch * 16) = st[it]; }
                      else { const int c2 = c - NKC, row = c2 >> 3, ch = c2 & 7; *(LAS v4u*)(lds + KBYTES + (ch >> 2) * 4096 + row * 64 + (ch & 3) * 16) = st[it]; } } }
    __syncthreads();
    float m_run = -INFINITY, l_run = 0.f;
    fx16 o[2];
#pragma unroll
    for (int r = 0; r < 16; ++r) { o[0][r] = 0.f; o[1][r] = 0.f; }
    const int vlane = ((lane >> 4) & 1) * 32 + (lane & 3) * 8 + (4 * hi + ((lane & 15) >> 2)) * 64;
    int cur = 0;
    for (int t = t_lo; t < t_hi; ++t) {
        const bool more = (t + 1 < t_hi);
        if (more) {
#pragma unroll
            for (int it = 0; it < NIT; ++it) { const int c = tid + 512 * it;
                if (c < NC) { if (c < NKC) { const int row = c / KCH, ch = c % KCH; st[it] = *(const v4u*)(a.K + (long)(64 * (t + 1) + row) * a.ks + ch * 8); }
                              else { const int c2 = c - NKC, row = c2 >> 3, ch = c2 & 7; st[it] = *(const v4u*)(a.V + (long)(64 * (t + 1) + row) * a.vs + ch * 8); } } }
        }
        const bool need = (64 * t <= qw0 + 31) && (!WIN || (64 * t + 63 >= qw0 - 128));
        if (need) {
            const LAS unsigned char* kb_ = lds + cur * BUFB; const LAS unsigned char* vb_ = kb_ + KBYTES + vlane;
            fx16 p[2];
#pragma unroll
            for (int kb = 0; kb < 2; ++kb) {
#pragma unroll
                for (int r = 0; r < 16; ++r) p[kb][r] = 0.f;
#pragma unroll
                for (int ds = 0; ds < NDS; ++ds) {
                    const hx8 kf = *(const LAS hx8*)(kb_ + (32 * kb + r32) * KRS + (16 * ds + 8 * hi) * 2);
                    p[kb] = __builtin_amdgcn_mfma_f32_32x32x16_bf16(kf, qf[ds], p[kb], 0, 0, 0);
                }
            }
            const bool domask = WIN || (64 * t + 63 > qw0);
            float mx = -INFINITY;
            if (domask) {
#pragma unroll
                for (int kb = 0; kb < 2; ++kb)
#pragma unroll
                    for (int r = 0; r < 16; ++r) {
                        const int kv = 64 * t + 32 * kb + (r & 3) + 8 * (r >> 2) + 4 * hi;
                        const bool ok = (kv <= qpos) && (!WIN || (qpos - kv <= 128));
                        const float v = ok ? p[kb][r] : -INFINITY; p[kb][r] = v; mx = fmaxf(mx, v);
                    }
            } else {
#pragma unroll
                for (int kb = 0; kb < 2; ++kb)
#pragma unroll
                    for (int r = 0; r < 16; ++r) mx = fmaxf(mx, p[kb][r]);
            }
            mx = fmaxf(mx, __shfl_xor(mx, 32));
            const float mnew = fmaxf(m_run, mx * a.c);
            const float muse = (mnew == -INFINITY) ? 0.f : mnew;
            const float alpha = fast_exp2(m_run - muse);
            m_run = mnew;
            float rs = 0.f;
#pragma unroll
            for (int kb = 0; kb < 2; ++kb)
#pragma unroll
                for (int r = 0; r < 16; ++r) { const float e = fast_exp2(__builtin_fmaf(p[kb][r], a.c, -muse)); p[kb][r] = e; rs += e; }
            l_run = l_run * alpha + rs;
#pragma unroll
            for (int r = 0; r < 16; ++r) { o[0][r] *= alpha; o[1][r] *= alpha; }
            hx8 pb[4];
#pragma unroll
            for (int ks = 0; ks < 4; ++ks) { const int kb = ks >> 1, s8 = (ks & 1) * 8;
                pb[ks] = __builtin_bit_cast(hx8, (v4u){pk2(p[kb][s8 + 0], p[kb][s8 + 1]), pk2(p[kb][s8 + 2], p[kb][s8 + 3]), pk2(p[kb][s8 + 4], p[kb][s8 + 5]), pk2(p[kb][s8 + 6], p[kb][s8 + 7])}); }
#pragma unroll
            for (int db = 0; db < 2; ++db)
#pragma unroll
                for (int ks = 0; ks < 4; ++ks) {
                    const hx4 lo = __builtin_bit_cast(hx4, __builtin_amdgcn_ds_read_tr16_b64_v4i16((LAS hx4*)(vb_ + db * 4096 + ks * 1024)));
                    const hx4 hh = __builtin_bit_cast(hx4, __builtin_amdgcn_ds_read_tr16_b64_v4i16((LAS hx4*)(vb_ + db * 4096 + ks * 1024 + 512)));
                    const hx8 vf = {lo[0], lo[1], lo[2], lo[3], hh[0], hh[1], hh[2], hh[3]};
                    o[db] = __builtin_amdgcn_mfma_f32_32x32x16_bf16(vf, pb[ks], o[db], 0, 0, 0);
                }
        }
        if (more) {
            LAS unsigned char* nb_ = lds + (cur ^ 1) * BUFB;
#pragma unroll
            for (int it = 0; it < NIT; ++it) { const int c = tid + 512 * it;
                if (c < NC) { if (c < NKC) { const int row = c / KCH, ch = c % KCH; *(LAS v4u*)(nb_ + row * KRS + ch * 16) = st[it]; }
                              else { const int c2 = c - NKC, row = c2 >> 3, ch = c2 & 7; *(LAS v4u*)(nb_ + KBYTES + (ch >> 2) * 4096 + row * 64 + (ch & 3) * 16) = st[it]; } } }
        }
        __syncthreads();
        cur ^= 1;
    }
    const float lt = l_run + __shfl_xor(l_run, 32);
    const float inv = fast_rcp(lt);
    bf16* orow = a.O + (long)qpos * a.os;
#pragma unroll
    for (int db = 0; db < 2; ++db)
#pragma unroll
        for (int g = 0; g < 4; ++g) {
            const v2u w = {pk2(o[db][4 * g] * inv, o[db][4 * g + 1] * inv), pk2(o[db][4 * g + 2] * inv, o[db][4 * g + 3] * inv)};
            *(v2u*)(orow + 32 * db + 8 * g + 4 * hi) = w;
        }
    if (WIN) { if (hi == 0) a.L[(long)qpos * a.ls] = m_run + __builtin_amdgcn_logf(lt); }
}

__device__ __forceinline__ void attn_unit_mla2(LAS unsigned char* lds, const AttnArgs& a) {
    constexpr int DQK = 96; constexpr bool WIN = false;
    constexpr int KCH = DQK / 8, NKC = 64 * KCH, NC = NKC + 512, SUB = 2, NCT = SUB * NC, NIT = NCT / 512;
    constexpr int KRS = DQK * 2 + 16, KBYTES = 64 * KRS, BUFB = KBYTES + 8192, SBUF = SUB * BUFB;
    constexpr int NDS = DQK / 16;
    static_assert(NCT % 512 == 0, "staging chunks");
    int tid_ = threadIdx.x; asm volatile("" : "+v"(tid_));
    const int tid = tid_, lane = tid & 63, wid = __builtin_amdgcn_readfirstlane(tid >> 6), r32 = lane & 31, hi = lane >> 5;
    const int qw0 = a.q0 + 32 * wid, qpos = qw0 + r32;
    const int T_hi = (a.q0 + 256) >> 7;
    v4u st[NIT];
#define MLA2_GLOAD(TT_) do { _Pragma("unroll") for (int it = 0; it < NIT; ++it) { const int c0 = tid + 512 * it; const int sub = (c0 >= NC) ? 1 : 0; const int c = c0 - sub * NC; const int t64 = 2 * (TT_) + sub; \
        if (c < NKC) { const int row = c / KCH, ch = c % KCH; st[it] = *(const v4u*)(a.K + (long)(64 * t64 + row) * a.ks + ch * 8); } \
        else { const int c2 = c - NKC, row = c2 >> 3, ch = c2 & 7; st[it] = *(const v4u*)(a.V + (long)(64 * t64 + row) * a.vs + ch * 8); } } } while (0)
#define MLA2_LWRITE(BASE_) do { _Pragma("unroll") for (int it = 0; it < NIT; ++it) { const int c0 = tid + 512 * it; const int sub = (c0 >= NC) ? 1 : 0; const int c = c0 - sub * NC; LAS unsigned char* sb_ = (BASE_) + sub * BUFB; \
        if (c < NKC) { const int row = c / KCH, ch = c % KCH; *(LAS v4u*)(sb_ + row * KRS + ch * 16) = st[it]; } \
        else { const int c2 = c - NKC, row = c2 >> 3, ch = c2 & 7; *(LAS v4u*)(sb_ + KBYTES + (ch >> 2) * 4096 + row * 64 + (ch & 3) * 16) = st[it]; } } } while (0)
    MLA2_GLOAD(0);
    hx8 qf[NDS];
    { const bf16* qrow = a.Q + (long)qpos * a.qs + 8 * hi;
#pragma unroll
      for (int ds = 0; ds < NDS; ++ds) qf[ds] = *(const hx8*)(qrow + 16 * ds);
      if (DQK == 96) {
          const fx4* cp = (const fx4*)(a.cosT + (long)qpos * 16 + 8 * hi); const fx4* sp = (const fx4*)(a.sinT + (long)qpos * 16 + 8 * hi);
          const fx4 c0 = cp[0], c1 = cp[1], s0 = sp[0], s1 = sp[1];
          const float cc[8] = {c0.x, c0.y, c0.z, c0.w, c1.x, c1.y, c1.z, c1.w}, sn[8] = {s0.x, s0.y, s0.z, s0.w, s1.x, s1.y, s1.z, s1.w};
          float n1[8], n2[8];
#pragma unroll
          for (int j = 0; j < 8; ++j) { const float x1 = __uint_as_float((unsigned)(unsigned short)qf[NDS - 2][j] << 16), x2 = __uint_as_float((unsigned)(unsigned short)qf[NDS - 1][j] << 16);
              n1[j] = x1 * cc[j] - x2 * sn[j]; n2[j] = x2 * cc[j] + x1 * sn[j]; }
          qf[NDS - 2] = __builtin_bit_cast(hx8, (v4u){pk2(n1[0], n1[1]), pk2(n1[2], n1[3]), pk2(n1[4], n1[5]), pk2(n1[6], n1[7])});
          qf[NDS - 1] = __builtin_bit_cast(hx8, (v4u){pk2(n2[0], n2[1]), pk2(n2[2], n2[3]), pk2(n2[4], n2[5]), pk2(n2[6], n2[7])});
      } }
    MLA2_LWRITE(lds);
    __syncthreads();
    float m_run = -INFINITY, l_run = 0.f;
    fx16 o[2];
#pragma unroll
    for (int r = 0; r < 16; ++r) { o[0][r] = 0.f; o[1][r] = 0.f; }
    const int vlane = ((lane >> 4) & 1) * 32 + (lane & 3) * 8 + (4 * hi + ((lane & 15) >> 2)) * 64;
    int cur = 0;
    for (int TT = 0; TT < T_hi; ++TT) {
        const bool more = (TT + 1 < T_hi);
        if (more) MLA2_GLOAD(TT + 1);
#pragma unroll
        for (int sub = 0; sub < SUB; ++sub) {
            const int t = 2 * TT + sub;
            const bool need = (64 * t <= qw0 + 31);
            if (need) {
                const LAS unsigned char* kb_ = lds + cur * SBUF + sub * BUFB; const LAS unsigned char* vb_ = kb_ + KBYTES + vlane;
            fx16 p[2];
#pragma unroll
            for (int kb = 0; kb < 2; ++kb) {
#pragma unroll
                for (int r = 0; r < 16; ++r) p[kb][r] = 0.f;
#pragma unroll
                for (int ds = 0; ds < NDS; ++ds) {
                    const hx8 kf = *(const LAS hx8*)(kb_ + (32 * kb + r32) * KRS + (16 * ds + 8 * hi) * 2);
                    p[kb] = __builtin_amdgcn_mfma_f32_32x32x16_bf16(kf, qf[ds], p[kb], 0, 0, 0);
                }
            }
            const bool domask = WIN || (64 * t + 63 > qw0);
            float mx = -INFINITY;
            if (domask) {
#pragma unroll
                for (int kb = 0; kb < 2; ++kb)
#pragma unroll
                    for (int r = 0; r < 16; ++r) {
                        const int kv = 64 * t + 32 * kb + (r & 3) + 8 * (r >> 2) + 4 * hi;
                        const bool ok = (kv <= qpos) && (!WIN || (qpos - kv <= 128));
                        const float v = ok ? p[kb][r] : -INFINITY; p[kb][r] = v; mx = fmaxf(mx, v);
                    }
            } else {
#pragma unroll
                for (int kb = 0; kb < 2; ++kb)
#pragma unroll
                    for (int r = 0; r < 16; ++r) mx = fmaxf(mx, p[kb][r]);
            }
            mx = fmaxf(mx, __shfl_xor(mx, 32));
            const float mnew = fmaxf(m_run, mx * a.c);
            const float muse = (mnew == -INFINITY) ? 0.f : mnew;
            const float alpha = fast_exp2(m_run - muse);
            m_run = mnew;
            float rs = 0.f;
#pragma unroll
            for (int kb = 0; kb < 2; ++kb)
#pragma unroll
                for (int r = 0; r < 16; ++r) { const float e = fast_exp2(__builtin_fmaf(p[kb][r], a.c, -muse)); p[kb][r] = e; rs += e; }
            l_run = l_run * alpha + rs;
#pragma unroll
            for (int r = 0; r < 16; ++r) { o[0][r] *= alpha; o[1][r] *= alpha; }
            hx8 pb[4];
#pragma unroll
            for (int ks = 0; ks < 4; ++ks) { const int kb = ks >> 1, s8 = (ks & 1) * 8;
                pb[ks] = __builtin_bit_cast(hx8, (v4u){pk2(p[kb][s8 + 0], p[kb][s8 + 1]), pk2(p[kb][s8 + 2], p[kb][s8 + 3]), pk2(p[kb][s8 + 4], p[kb][s8 + 5]), pk2(p[kb][s8 + 6], p[kb][s8 + 7])}); }
#pragma unroll
            for (int db = 0; db < 2; ++db)
#pragma unroll
                for (int ks = 0; ks < 4; ++ks) {
                    const hx4 lo = __builtin_bit_cast(hx4, __builtin_amdgcn_ds_read_tr16_b64_v4i16((LAS hx4*)(vb_ + db * 4096 + ks * 1024)));
                    const hx4 hh = __builtin_bit_cast(hx4, __builtin_amdgcn_ds_read_tr16_b64_v4i16((LAS hx4*)(vb_ + db * 4096 + ks * 1024 + 512)));
                    const hx8 vf = {lo[0], lo[1], lo[2], lo[3], hh[0], hh[1], hh[2], hh[3]};
                    o[db] = __builtin_amdgcn_mfma_f32_32x32x16_bf16(vf, pb[ks], o[db], 0, 0, 0);
                }
            }
        }
        if (more) MLA2_LWRITE(lds + (cur ^ 1) * SBUF);
        __syncthreads();
        cur ^= 1;
    }
#undef MLA2_GLOAD
#undef MLA2_LWRITE
    const float lt = l_run + __shfl_xor(l_run, 32);
    const float inv = fast_rcp(lt);
    bf16* orow = a.O + (long)qpos * a.os;
#pragma unroll
    for (int db = 0; db < 2; ++db)
#pragma unroll
        for (int g = 0; g < 4; ++g) {
            const v2u w = {pk2(o[db][4 * g] * inv, o[db][4 * g + 1] * inv), pk2(o[db][4 * g + 2] * inv, o[db][4 * g + 3] * inv)};
            *(v2u*)(orow + 32 * db + 8 * g + 4 * hi) = w;
        }
    if (WIN) { if (hi == 0) a.L[(long)qpos * a.ls] = m_run + __builtin_amdgcn_logf(lt); }
}

__device__ __forceinline__ void win_load(const AttnArgs& a, v4u (&st)[6][2]) {
    int tid_ = threadIdx.x; asm volatile("" : "+v"(tid_));
    const int srow = tid_ >> 3, sch = tid_ & 7;
    const int t_hi = (a.q0 + 256) >> 6, t_lo = a.q0 >= 128 ? ((a.q0 - 128) >> 6) : 0, nt = t_hi - t_lo;
#pragma unroll
    for (int s = 0; s < 6; ++s) if (s < nt) {
        st[s][0] = *(const v4u*)(a.K + (long)(64 * (t_lo + s) + srow) * a.ks + sch * 8);
        st[s][1] = *(const v4u*)(a.V + (long)(64 * (t_lo + s) + srow) * a.vs + sch * 8);
    }
}
__device__ __forceinline__ void attn_unit_win(LAS unsigned char* lds, const AttnArgs& a, v4u (&st)[6][2], bool has_next, const AttnArgs& an) {
    constexpr int DQK = 64; constexpr bool WIN = true;
    constexpr int KRS = DQK * 2 + 16, KBYTES = 64 * KRS, BUFB = KBYTES + 8192, NDS = DQK / 16;
    int tid_ = threadIdx.x; asm volatile("" : "+v"(tid_));
    const int tid = tid_, lane = tid & 63, wid = __builtin_amdgcn_readfirstlane(tid >> 6), r32 = lane & 31, hi = lane >> 5;
    const int qw0 = a.q0 + 32 * wid, qpos = qw0 + r32;
    const int t_hi = (a.q0 + 256) >> 6;
    const int t_lo = a.q0 >= 128 ? ((a.q0 - 128) >> 6) : 0;
    const int nt = t_hi - t_lo;
    const int srow = tid >> 3, sch = tid & 7;
    hx8 qf[NDS];
    { const bf16* qrow = a.Q + (long)qpos * a.qs + 8 * hi;
#pragma unroll
      for (int ds = 0; ds < NDS; ++ds) qf[ds] = *(const hx8*)(qrow + 16 * ds); }
#pragma unroll
    for (int s = 0; s < 6; ++s) if (s < nt) {
        *(LAS v4u*)(lds + s * BUFB + srow * KRS + sch * 16) = st[s][0];
        *(LAS v4u*)(lds + s * BUFB + KBYTES + (sch >> 2) * 4096 + srow * 64 + (sch & 3) * 16) = st[s][1];
    }
    __syncthreads();
    if (has_next) win_load(an, st);
    float m_run = -INFINITY, l_run = 0.f;
    fx16 o[2];
#pragma unroll
    for (int r = 0; r < 16; ++r) { o[0][r] = 0.f; o[1][r] = 0.f; }
    const int vlane = ((lane >> 4) & 1) * 32 + (lane & 3) * 8 + (4 * hi + ((lane & 15) >> 2)) * 64;
    for (int t = t_lo; t < t_hi; ++t) {
        const bool need = (64 * t <= qw0 + 31) && (64 * t + 63 >= qw0 - 128);
        if (need) {
            const LAS unsigned char* kb_ = lds + (t - t_lo) * BUFB; const LAS unsigned char* vb_ = kb_ + KBYTES + vlane;
            fx16 p[2];
#pragma unroll
            for (int kb = 0; kb < 2; ++kb) {
#pragma unroll
                for (int r = 0; r < 16; ++r) p[kb][r] = 0.f;
#pragma unroll
                for (int ds = 0; ds < NDS; ++ds) {
                    const hx8 kf = *(const LAS hx8*)(kb_ + (32 * kb + r32) * KRS + (16 * ds + 8 * hi) * 2);
                    p[kb] = __builtin_amdgcn_mfma_f32_32x32x16_bf16(kf, qf[ds], p[kb], 0, 0, 0);
                }
            }
            const bool domask = WIN || (64 * t + 63 > qw0);
            float mx = -INFINITY;
            if (domask) {
#pragma unroll
                for (int kb = 0; kb < 2; ++kb)
#pragma unroll
                    for (int r = 0; r < 16; ++r) {
                        const int kv = 64 * t + 32 * kb + (r & 3) + 8 * (r >> 2) + 4 * hi;
                        const bool ok = (kv <= qpos) && (!WIN || (qpos - kv <= 128));
                        const float v = ok ? p[kb][r] : -INFINITY; p[kb][r] = v; mx = fmaxf(mx, v);
                    }
            } else {
#pragma unroll
                for (int kb = 0; kb < 2; ++kb)
#pragma unroll
                    for (int r = 0; r < 16; ++r) mx = fmaxf(mx, p[kb][r]);
            }
            mx = fmaxf(mx, __shfl_xor(mx, 32));
            const float mnew = fmaxf(m_run, mx * a.c);
            const float muse = (mnew == -INFINITY) ? 0.f : mnew;
            const float alpha = fast_exp2(m_run - muse);
            m_run = mnew;
            float rs = 0.f;
#pragma unroll
            for (int kb = 0; kb < 2; ++kb)
#pragma unroll
                for (int r = 0; r < 16; ++r) { const float e = fast_exp2(__builtin_fmaf(p[kb][r], a.c, -muse)); p[kb][r] = e; rs += e; }
            l_run = l_run * alpha + rs;
#pragma unroll
            for (int r = 0; r < 16; ++r) { o[0][r] *= alpha; o[1][r] *= alpha; }
            hx8 pb[4];
#pragma unroll
            for (int ks = 0; ks < 4; ++ks) { const int kb = ks >> 1, s8 = (ks & 1) * 8;
                pb[ks] = __builtin_bit_cast(hx8, (v4u){pk2(p[kb][s8 + 0], p[kb][s8 + 1]), pk2(p[kb][s8 + 2], p[kb][s8 + 3]), pk2(p[kb][s8 + 4], p[kb][s8 + 5]), pk2(p[kb][s8 + 6], p[kb][s8 + 7])}); }
#pragma unroll
            for (int db = 0; db < 2; ++db)
#pragma unroll
                for (int ks = 0; ks < 4; ++ks) {
                    const hx4 lo = __builtin_bit_cast(hx4, __builtin_amdgcn_ds_read_tr16_b64_v4i16((LAS hx4*)(vb_ + db * 4096 + ks * 1024)));
                    const hx4 hh = __builtin_bit_cast(hx4, __builtin_amdgcn_ds_read_tr16_b64_v4i16((LAS hx4*)(vb_ + db * 4096 + ks * 1024 + 512)));
                    const hx8 vf = {lo[0], lo[1], lo[2], lo[3], hh[0], hh[1], hh[2], hh[3]};
                    o[db] = __builtin_amdgcn_mfma_f32_32x32x16_bf16(vf, pb[ks], o[db], 0, 0, 0);
                }
        }
    }
    const float lt = l_run + __shfl_xor(l_run, 32);
    const float inv = fast_rcp(lt);
    bf16* orow = a.O + (long)qpos * a.os;
#pragma unroll
    for (int db = 0; db < 2; ++db)
#pragma unroll
        for (int g = 0; g < 4; ++g) {
            const v2u w = {pk2(o[db][4 * g] * inv, o[db][4 * g + 1] * inv), pk2(o[db][4 * g + 2] * inv, o[db][4 * g + 3] * inv)};
            *(v2u*)(orow + 32 * db + 8 * g + 4 * hi) = w;
        }
    if (WIN) { if (hi == 0) a.L[(long)qpos * a.ls] = m_run + __builtin_amdgcn_logf(lt); }
    __syncthreads();
}

__device__ __forceinline__ void attention_phase(unsigned char* ws, LAS unsigned char* lds) {
    int bx_ = blockIdx.x; asm volatile("" : "+s"(bx_));
    const int G = gridDim.x, c = bx_;
    const float* cosM = (const float*)(ws + OFF_TAB); const float* sinM = cosM + (size_t)T * 16;
    bf16* XN = (bf16*)(ws + OFF_XN); bf16* Fb = (bf16*)(ws + OFF_F); float* LSE = (float*)(ws + OFF_LSE);
    const bf16* Z = (const bf16*)(ws + OFF_HID); const bf16* Qb = (const bf16*)(ws + OFF_Q);
    const bf16* Kc = (const bf16*)(ws + OFF_KCAT); const bf16* Vm = (const bf16*)(ws + OFF_V);
#ifdef EXP_MLA2
    for (int rep_ = 0; rep_ < 2; ++rep_)
#endif
    for (int pi0 = c, rnd = 0; pi0 < 512; pi0 += G, ++rnd) {
        int pi = pi0;
        if (G == 256) { const int xcd = c & 7, j = c >> 3; pi = ((4 * xcd + 2 * rnd + (j >> 4)) << 4) | (j & 15); }
        const int bh = pi >> 4, s = pi & 15, b = bh >> 3, h = bh & 7;
        const size_t tok0 = (size_t)b * SEQ;
        AttnArgs a;
        a.Q = Qb + tok0 * 768 + h * 96; a.qs = 768; a.K = Kc + tok0 * 768 + h * 96; a.ks = 768; a.V = Vm + tok0 * 512 + h * 64; a.vs = 512;
        a.O = XN + tok0 * D + h * 64; a.os = D; a.L = nullptr; a.ls = 0; a.cosT = cosM + tok0 * 16; a.sinT = sinM + tok0 * 16;
        a.c = 0.10206207261596577f * 1.4426950408889634f;
        for (int half = 0; half < 2; ++half) { a.q0 = half ? 256 * s : 256 * (31 - s); attn_unit_mla2(lds, a); }
    }
#ifdef EXP_DIL2
    for (int rep_ = 0; rep_ < 2; ++rep_)
#endif
    {
        v4u st[6][2]; AttnArgs a, an;
#define WIN_ARGS(u_, A_) do { const int br = (u_) >> 10, rem = (u_) & 1023, b = rem >> 8, h = (rem >> 5) & 7, idx = rem & 31; \
        const int dil = (br == 0) ? 1 : (br == 1 ? 4 : 16); const int nsub = 32 / dil; const int r = idx / nsub, n = idx % nsub; \
        const size_t tok0 = (size_t)b * SEQ + r; \
        A_.Q = Z + tok0 * NINP + 416 + h * 64; A_.qs = NINP * dil; A_.K = Z + tok0 * NINP + 928 + h * 64; A_.ks = A_.qs; A_.V = Z + tok0 * NINP + 1440 + h * 64; A_.vs = A_.qs; \
        if (br < 2) { A_.O = Fb + (size_t)br * T * 512 + tok0 * 512 + h * 64; A_.os = 512 * dil; } \
        else { A_.O = XN + tok0 * D + 512 + h * 64; A_.os = D * dil; } \
        A_.L = LSE + (size_t)br * T * 8 + tok0 * 8 + h; A_.ls = 8 * dil; A_.cosT = nullptr; A_.sinT = nullptr; \
        A_.c = 0.125f * 1.4426950408889634f; A_.q0 = 256 * n; } while (0)
        int u = c;
        if (u < 3072) { WIN_ARGS(u, a); win_load(a, st); }
        for (; u < 3072; u += G) {
            const bool hn = (u + G) < 3072;
            if (hn) WIN_ARGS(u + G, an); else an = a;
            attn_unit_win(lds, a, st, hn, an);
            a = an;
        }
#undef WIN_ARGS
    }
}

#define XB_TMO      128
#define XB_XCNT(j)  (256  + 64 * (j))
#define XB_XSUB(j)  (1280 + 64 * (j))
#define XB_XGEN(j)  (2304 + 64 * (j))
#define XB_TOP      3328
#define XB_TOPGEN   3392
#define XCD_BAR_WORDS 3456
#define XB_SPIN_CAP (1u << 18)

__device__ __forceinline__ unsigned xb_ld(unsigned* p)              { return __hip_atomic_load(p, __ATOMIC_RELAXED, __HIP_MEMORY_SCOPE_AGENT); }
__device__ __forceinline__ unsigned xb_add(unsigned* p, unsigned v) { return __hip_atomic_fetch_add(p, v, __ATOMIC_RELAXED, __HIP_MEMORY_SCOPE_AGENT); }
__device__ __forceinline__ unsigned xb_xcc_id() { return (unsigned)__builtin_amdgcn_s_getreg((3 << 11) | 20) & 0xFu; }
#define XB_SPIN(cond, bar) do { unsigned _sp = 0; while (cond) { __builtin_amdgcn_s_sleep(1); \
    if ((++_sp & 255u) == 0u) { if (xb_ld(&(bar)[XB_TMO])) break; if (_sp > XB_SPIN_CAP) { atomicAdd(&(bar)[XB_TMO], 1u); break; } } } } while (0)

struct XcdBarrier {
    unsigned* bar; unsigned x;
    volatile LAS unsigned* st;
};

__device__ __forceinline__ XcdBarrier xcd_barrier_post(unsigned* bar, volatile LAS unsigned* st) {
    XcdBarrier b; b.bar = bar; b.x = xb_xcc_id(); b.st = st;
    if (threadIdx.x == 0) (void)xb_add(&bar[XB_XCNT(b.x)], 1u);
    return b;
}
__device__ __forceinline__ void xcd_barrier_complete(unsigned* bar, unsigned x, unsigned& nloc, unsigned& nx) {
    const unsigned G = gridDim.x * gridDim.y * gridDim.z;
    unsigned sum, cnt, mine, sp = 0u;
    for (;;) {
        sum = 0u; cnt = 0u; mine = 0u;
#pragma unroll
        for (unsigned j = 0; j < 16; ++j) { const unsigned c = xb_ld(&bar[XB_XCNT(j)]); sum += c; cnt += (c > 0u) ? 1u : 0u; mine = (j == x) ? c : mine; }
        if (sum == G) break;
        __builtin_amdgcn_s_sleep(1);
        if ((++sp & 255u) == 0u) { if (xb_ld(&bar[XB_TMO])) break; if (sp > XB_SPIN_CAP) { atomicAdd(&bar[XB_TMO], 1u); break; } }
    }
    nloc = mine > 0u ? mine : 1u; nx = cnt > 0u ? cnt : 1u;
}

__device__ __forceinline__ void xcd_barrier(const XcdBarrier& b) {
    asm volatile("s_waitcnt vmcnt(0)" ::: "memory");
    __syncthreads();
    if (threadIdx.x == 0) {
        unsigned* bar = b.bar;
        __builtin_amdgcn_s_waitcnt(0);
        unsigned nloc = b.st[0], nx = b.st[1];
        if (nloc == 0u) { xcd_barrier_complete(bar, b.x, nloc, nx); b.st[0] = nloc; b.st[1] = nx; }
        const unsigned old = xb_add(&bar[XB_XSUB(b.x)], 1u);
        const unsigned gen = old / nloc;
        if (old + 1u == (gen + 1u) * nloc) {
            __builtin_amdgcn_fence(__ATOMIC_RELEASE, "agent");
            asm volatile("s_waitcnt vmcnt(0)" ::: "memory");
            const unsigned og = xb_add(&bar[XB_TOP], 1u);
            const unsigned tg = og / nx;
            if (og + 1u == (tg + 1u) * nx) xb_add(&bar[XB_TOPGEN], 1u);
            else XB_SPIN(xb_ld(&bar[XB_TOPGEN]) == tg, bar);
            __builtin_amdgcn_fence(__ATOMIC_ACQUIRE, "agent");
            xb_add(&bar[XB_XGEN(b.x)], 1u);
            asm volatile("s_waitcnt vmcnt(0)" ::: "memory");
        } else {
            XB_SPIN(xb_ld(&bar[XB_XGEN(b.x)]) == gen, bar);
            __builtin_amdgcn_fence(__ATOMIC_ACQUIRE, "agent");
            asm volatile("s_waitcnt vmcnt(0)" ::: "memory");
        }
    }
    __syncthreads();
}


#ifdef NO_GEMM
#define GEMM_PHASE(EPI, Aptr, Bptr, Nn, Kk, Eobj) do { (void)(Eobj); } while (0)
#else
#define GEMM_PHASE(EPI, Aptr, Bptr, Nn, Kk, Eobj) do { int bx_ = blockIdx.x; asm volatile("" : "+s"(bx_)); pg8::Gemm g_{(const pg8::bf16_t*)(Aptr), (const pg8::bf16_t*)(Bptr), T, (Nn), (Kk)}; pg8::StaticOrder S_; S_.init(T, (Nn), (int)gridDim.x, bx_); \
    pg8::gemm_phase<EPI, pg8::StaticOrder, true, true>(lds, g_, S_, (Eobj)); } while (0)
#endif
#define PH_IDS int tid = threadIdx.x; asm volatile("" : "+v"(tid)); const int lane = tid & 63, wave = __builtin_amdgcn_readfirstlane(tid >> 6); int bxp = blockIdx.x; asm volatile("" : "+s"(bxp)); \
    const int gw = bxp * 8 + wave, NGW = gridDim.x * 8, gtid = bxp * NTHREADS + tid, NT = gridDim.x * NTHREADS; (void)lane; (void)gw; (void)NGW; (void)gtid; (void)NT;
#define GASP(T_, p_) ((T_*)(__attribute__((address_space(1))) T_*)(p_))
#define PH_WS unsigned char* ws = P.ws;
#define WP(off) ((bf16*)(ws + (off)))
#define WBP(eoff) ((bf16*)(ws + OFF_WB) + (eoff))

__global__ void __launch_bounds__(NTHREADS, 2) mega_fwd(Params Pk) {
    Params P;
#pragma unroll
    for (int i = 0; i < 16; ++i) P.in[i] = GASP(const float, Pk.in[i]);
    P.out = GASP(float, Pk.out); P.ws = GASP(unsigned char, Pk.ws);
    extern __shared__ __attribute__((aligned(16))) unsigned char lds_raw[];
    LAS unsigned char* lds = (LAS unsigned char*)lds_raw;
    cg::grid_group grid = cg::this_grid();
    volatile LAS unsigned* bst = (volatile LAS unsigned*)(lds + 131072);
    if (threadIdx.x < 2) bst[threadIdx.x] = 0u;
    __syncthreads();
    const XcdBarrier bar = xcd_barrier_post((unsigned*)(P.ws + OFF_BAR), bst);
#define GSYNC() xcd_barrier(bar)

    { PH_IDS PH_WS
      convert_weights(P, ws, 0, lds, gw, NGW, wave, lane);
      rope_tables(P, ws, gtid, NT);
      resnorm_rows<false, false, true>(P.in[0], P.out, nullptr, 0.f, nullptr, P.in[3], WP(OFF_XN), gw, NGW, lane); }
    grid.sync();

    { const int layer = 0;
        { PH_WS pg8::EpiSwiglu E{WP(OFF_HID), FF}; GEMM_PHASE(pg8::EpiSwiglu, WP(OFF_XN), WBP(WE_FIN_A), 2 * FF, D, E); }
        GSYNC();
        { PH_WS pg8::EpiBf16<0> E{WP(OFF_F), D, nullptr, 0, 0, 1.f}; GEMM_PHASE(pg8::EpiBf16<0>, WP(OFF_HID), WBP(WE_FDN_A), D, FF, E); }
        GSYNC();
        { PH_IDS PH_WS const float* gains = P.in[3] + (size_t)layer * 8 * D;
          resnorm_rows<true, true, true>(P.out, P.out, WP(OFF_F), 0.5f, gains + 1 * D, gains + 2 * D, WP(OFF_XN), gw, NGW, lane); }
        GSYNC();
        { PH_WS pg8::EpiBf16<0> E{WP(OFF_HID), NINP, nullptr, 0, 0, 1.f}; GEMM_PHASE(pg8::EpiBf16<0>, WP(OFF_XN), WBP(WE_IN), NINP, D, E); }
        GSYNC();
        { PH_IDS PH_WS mixer_prep_rows(P, ws, layer, gw, NGW, lane); }
        GSYNC();
        { PH_WS pg8::EpiQKV E{WP(OFF_Q), WP(OFF_KCAT), WP(OFF_V)}; int kq_ = 384; asm volatile("" : "+s"(kq_)); GEMM_PHASE(pg8::EpiQKV, WP(OFF_QLN), WBP(WE_QUP), 1792, kq_, E); }
        GSYNC();
#ifndef NO_ATTN
        { PH_WS attention_phase(ws, lds); }
#endif
        GSYNC();
#ifdef EXP_SYNC
        for (int rep_ = 0; rep_ < 16; ++rep_) GSYNC();
#endif
        { PH_IDS PH_WS merge_rows(P, ws, layer, gw, NGW, lane); }
        GSYNC();
        { PH_WS pg8::EpiBf16<0> E{WP(OFF_F), D, nullptr, 0, 0, 1.f}; GEMM_PHASE(pg8::EpiBf16<0>, WP(OFF_XN), WBP(WE_OUT), D, D, E); }
        GSYNC();
        { PH_IDS PH_WS const float* gains = P.in[3] + (size_t)layer * 8 * D;
          resnorm_rows<true, true, true>(P.out, P.out, WP(OFF_F), 1.0f, gains + 3 * D, gains + 4 * D, WP(OFF_XN), gw, NGW, lane);
          convert_p(P, ws, layer, gtid, NT); }
        GSYNC();
        { PH_WS pg8::EpiSwiglu E{WP(OFF_HID), FF}; GEMM_PHASE(pg8::EpiSwiglu, WP(OFF_XN), WBP(WE_FIN_B), 2 * FF, D, E); }
        GSYNC();
        { PH_WS pg8::EpiBf16<0> E{WP(OFF_F), D, nullptr, 0, 0, 1.f}; GEMM_PHASE(pg8::EpiBf16<0>, WP(OFF_HID), WBP(WE_FDN_B), D, FF, E); }
        GSYNC();
        { PH_IDS PH_WS const float* gains = P.in[3] + (size_t)layer * 8 * D;
          resnorm_rows<true, true, true>(P.out, P.out, WP(OFF_F), 0.5f, gains + 5 * D, gains + 6 * D, WP(OFF_XN), gw, NGW, lane); }
        { PH_WS pg8::EpiBf16<0> E{WP(OFF_HID), D, nullptr, 0, 0, 1.f}; GEMM_PHASE(pg8::EpiBf16<0>, WP(OFF_QLN), WBP(WE_PLE), D, PLE, E); }
        GSYNC();
        { PH_WS pg8::EpiGate E{WP(OFF_F), WP(OFF_HID), D}; GEMM_PHASE(pg8::EpiGate, WP(OFF_XN), WBP(WE_PG), D, D, E); }
        GSYNC();
        { PH_IDS PH_WS const float* gains = P.in[3] + (size_t)layer * 8 * D;
          if (layer == 1) resnorm_rows<true, true, false>(P.out, P.out, WP(OFF_F), 1.0f, gains + 7 * D, P.in[3], WP(OFF_XN), gw, NGW, lane);
          else resnorm_rows<true, true, true>(P.out, P.out, WP(OFF_F), 1.0f, gains + 7 * D, P.in[3] + (size_t)8 * D, WP(OFF_XN), gw, NGW, lane);
          if (layer == 0) convert_weights(P, ws, 1, lds, gw, NGW, wave, lane); }
        if (layer == 0) GSYNC();
    }
    { const int layer = 1;
        { PH_WS pg8::EpiSwiglu E{WP(OFF_HID), FF}; GEMM_PHASE(pg8::EpiSwiglu, WP(OFF_XN), WBP(WE_FIN_A), 2 * FF, D, E); }
        GSYNC();
        { PH_WS pg8::EpiBf16<0> E{WP(OFF_F), D, nullptr, 0, 0, 1.f}; GEMM_PHASE(pg8::EpiBf16<0>, WP(OFF_HID), WBP(WE_FDN_A), D, FF, E); }
        GSYNC();
        { PH_IDS PH_WS const float* gains = P.in[3] + (size_t)layer * 8 * D;
          resnorm_rows<true, true, true>(P.out, P.out, WP(OFF_F), 0.5f, gains + 1 * D, gains + 2 * D, WP(OFF_XN), gw, NGW, lane); }
        GSYNC();
        { PH_WS pg8::EpiBf16<0> E{WP(OFF_HID), NINP, nullptr, 0, 0, 1.f}; GEMM_PHASE(pg8::EpiBf16<0>, WP(OFF_XN), WBP(WE_IN), NINP, D, E); }
        GSYNC();
        { PH_IDS PH_WS mixer_prep_rows(P, ws, layer, gw, NGW, lane); }
        GSYNC();
        { PH_WS pg8::EpiQKV E{WP(OFF_Q), WP(OFF_KCAT), WP(OFF_V)}; int kq_ = 384; asm volatile("" : "+s"(kq_)); GEMM_PHASE(pg8::EpiQKV, WP(OFF_QLN), WBP(WE_QUP), 1792, kq_, E); }
        GSYNC();
#ifndef NO_ATTN
        { PH_WS attention_phase(ws, lds); }
#endif
        GSYNC();
#ifdef EXP_SYNC
        for (int rep_ = 0; rep_ < 16; ++rep_) GSYNC();
#endif
        { PH_IDS PH_WS merge_rows(P, ws, layer, gw, NGW, lane); }
        GSYNC();
        { PH_WS pg8::EpiBf16<0> E{WP(OFF_F), D, nullptr, 0, 0, 1.f}; GEMM_PHASE(pg8::EpiBf16<0>, WP(OFF_XN), WBP(WE_OUT), D, D, E); }
        GSYNC();
        { PH_IDS PH_WS const float* gains = P.in[3] + (size_t)layer * 8 * D;
          resnorm_rows<true, true, true>(P.out, P.out, WP(OFF_F), 1.0f, gains + 3 * D, gains + 4 * D, WP(OFF_XN), gw, NGW, lane);
          convert_p(P, ws, layer, gtid, NT); }
        GSYNC();
        { PH_WS pg8::EpiSwiglu E{WP(OFF_HID), FF}; GEMM_PHASE(pg8::EpiSwiglu, WP(OFF_XN), WBP(WE_FIN_B), 2 * FF, D, E); }
        GSYNC();
        { PH_WS pg8::EpiBf16<0> E{WP(OFF_F), D, nullptr, 0, 0, 1.f}; GEMM_PHASE(pg8::EpiBf16<0>, WP(OFF_HID), WBP(WE_FDN_B), D, FF, E); }
        GSYNC();
        { PH_IDS PH_WS const float* gains = P.in[3] + (size_t)layer * 8 * D;
          resnorm_rows<true, true, true>(P.out, P.out, WP(OFF_F), 0.5f, gains + 5 * D, gains + 6 * D, WP(OFF_XN), gw, NGW, lane); }
        { PH_WS pg8::EpiBf16<0> E{WP(OFF_HID), D, nullptr, 0, 0, 1.f}; GEMM_PHASE(pg8::EpiBf16<0>, WP(OFF_QLN), WBP(WE_PLE), D, PLE, E); }
        GSYNC();
        { PH_WS pg8::EpiGate E{WP(OFF_F), WP(OFF_HID), D}; GEMM_PHASE(pg8::EpiGate, WP(OFF_XN), WBP(WE_PG), D, D, E); }
        GSYNC();
        { PH_IDS PH_WS const float* gains = P.in[3] + (size_t)layer * 8 * D;
          if (layer == 1) resnorm_rows<true, true, false>(P.out, P.out, WP(OFF_F), 1.0f, gains + 7 * D, P.in[3], WP(OFF_XN), gw, NGW, lane);
          else resnorm_rows<true, true, true>(P.out, P.out, WP(OFF_F), 1.0f, gains + 7 * D, P.in[3] + (size_t)8 * D, WP(OFF_XN), gw, NGW, lane);
          if (layer == 0) convert_weights(P, ws, 1, lds, gw, NGW, wave, lane); }
        if (layer == 0) GSYNC();
    }
}

extern "C" void kernel_launch(void* const* d_in, const int* in_sizes, int n_in, void* d_out, int out_size, void* d_ws, size_t ws_size, hipStream_t stream) {
    static int grid = 0;
    if (grid == 0) {
        if (n_in != 16 || out_size != T * D || ws_size < WS_NEED) { fprintf(stderr, "kernel_launch: unexpected shapes (n_in %d out %d ws %zu)\n", n_in, out_size, ws_size); grid = -1; return; }
        int dev = 0, cus = 0, per_cu = 0;
        hipGetDevice(&dev); hipDeviceGetAttribute(&cus, hipDeviceAttributeMultiprocessorCount, dev);
        hipFuncSetAttribute((const void*)mega_fwd, hipFuncAttributeMaxDynamicSharedMemorySize, LDS_BYTES);
        hipOccupancyMaxActiveBlocksPerMultiprocessor(&per_cu, (const void*)mega_fwd, NTHREADS, LDS_BYTES);
        (void)hipGetLastError();
        if (per_cu < 1) fprintf(stderr, "kernel_launch: occupancy query says %d\n", per_cu);
        grid = cus;
    }
    if (grid < 0) return;
    if (hipMemsetAsync((char*)d_ws + OFF_BAR, 0, BAR_BYTES, stream) != hipSuccess) { fprintf(stderr, "kernel_launch: memset failed\n"); return; }
    Params p{};
    for (int i = 0; i < 16; ++i) p.in[i] = (const float*)d_in[i];
    p.out = (float*)d_out; p.ws = (unsigned char*)d_ws;
    void* args[] = {&p};
    hipError_t e = hipLaunchCooperativeKernel((const void*)mega_fwd, dim3(grid), dim3(NTHREADS), args, LDS_BYTES, stream);
    if (e != hipSuccess) fprintf(stderr, "cooperative launch failed: %s (grid %d)\n", hipGetErrorString(e), grid);
}
```
